# Optimizing an MI355X kernel written in HIP

```python
import math
import jax
import jax.numpy as jnp
from jax import lax
import numpy as np

D_MODEL = 1024
BATCH = 8
SEQ = 8192
DEPTH = 4

GRID_W = 64
CTX_LEN = 256

HEAD_DIM = 64
ATTN_SCALE = HEAD_DIM ** -0.5
ROPE_FREQS = HEAD_DIM // 4
ROPE_THETA = 10000.0
Q_BLOCK = 128
A_HEADS = 8
A_KV_HEADS = 2
B_HEADS = 8
B_KV_HEADS = 2
WINDOW = 128
C_HEADS = 4
C_VDIM = 2 * HEAD_DIM
A_QW = A_HEADS * HEAD_DIM
A_KVW = A_KV_HEADS * HEAD_DIM
B_QW = B_HEADS * HEAD_DIM
B_KVW = B_KV_HEADS * HEAD_DIM
C_QKW = 2 * C_HEADS * HEAD_DIM
C_VW = C_HEADS * C_VDIM
QKV_SIZES = (A_QW, A_KVW, A_KVW, B_QW, B_KVW, B_KVW, C_QKW, C_QKW, C_VW)
QKV_HEADS = (A_HEADS, A_KV_HEADS, A_KV_HEADS, B_HEADS, B_KV_HEADS, B_KV_HEADS, 2 * C_HEADS, 2 * C_HEADS, C_HEADS)
QKV_WIDTH = A_QW + 2 * A_KVW + B_QW + 2 * B_KVW + 2 * C_QKW + C_VW
N_BRANCHES = 3

N_EXPERTS = 128
TOP_K = 8
N_GROUPS = 8
TOPK_GROUPS = 4
D_EXPERT = 256
D_SHARED = 256
ROUTE_SCALE = 2.5
EXPERT_BLOCK = 128

N_MOD = 6
EPS = 1e-6

kernel_name = 'hybrid_gated_attn_moe_dit'


def _rmsnorm(x, g):
    xf = x.astype(jnp.float32)
    y = xf * lax.rsqrt(jnp.mean(xf * xf, axis=-1, keepdims=True) + EPS)
    return y.astype(x.dtype) * g


def _swiglu(x, w1, w3, w2):
    return (jax.nn.silu(x @ w1) * (x @ w3)) @ w2


def _rope_tables(n_lat):
    rows = n_lat // GRID_W
    t = jnp.arange(rows * GRID_W, dtype=jnp.int32)
    row_pos = (t // GRID_W).astype(jnp.float32)
    col_pos = (t % GRID_W).astype(jnp.float32)
    inv_freq = jnp.power(ROPE_THETA, -jnp.arange(ROPE_FREQS, dtype=jnp.float32) / ROPE_FREQS)
    ang = jnp.stack([row_pos[:, None] * inv_freq, col_pos[:, None] * inv_freq], axis=1)
    return jnp.cos(ang), jnp.sin(ang)


def _rope(x, cos, sin):
    xf = x.astype(jnp.float32).reshape(x.shape[:-1] + (2, 2, ROPE_FREQS))
    x1, x2 = xf[..., 0, :], xf[..., 1, :]
    out = jnp.stack([x1 * cos - x2 * sin, x1 * sin + x2 * cos], axis=-2)
    return out.reshape(x.shape).astype(x.dtype)


def _heads(t, n):
    b, s, _ = t.shape
    return t.reshape(b, s, n, -1).transpose(0, 2, 1, 3)


def _group(q, n_kv):
    b, h, s, d = q.shape
    return q.reshape(b, n_kv, h // n_kv, s, d)


def _merge_heads(y):
    b, hk, g, s, dv = y.shape
    return y.transpose(0, 3, 1, 2, 4).reshape(b, s, hk * g * dv)


def _qkv_heads(a, w_qkv):
    p = a @ w_qkv
    split_at = np.cumsum(QKV_SIZES)[:-1].tolist()
    pieces = jnp.split(p, split_at, axis=-1)
    return [_heads(t, n) for t, n in zip(pieces, QKV_HEADS)]


def _sweep_blocks(q, fn):
    b, hk, g, s, d = q.shape
    nb = s // Q_BLOCK
    qb = q.reshape(b, hk, g, nb, Q_BLOCK, d).transpose(3, 0, 1, 2, 4, 5)
    out = lax.map(lambda a: fn(a[0], a[1]), (qb, jnp.arange(nb, dtype=jnp.int32)))
    go, dv = out.shape[3], out.shape[-1]
    return out.transpose(1, 2, 3, 0, 4, 5).reshape(b, hk, go, s, dv)


def _gqa_block(qi, k, v):
    s = jnp.einsum('bhgqd,bhkd->bhgqk', qi, k, preferred_element_type=jnp.float32) * ATTN_SCALE
    p = jax.nn.softmax(s, axis=-1).astype(v.dtype)
    return jnp.einsum('bhgqk,bhkd->bhgqd', p, v)


def _sink_probs(s, sink):
    m = jnp.maximum(jnp.max(s, axis=-1, keepdims=True), sink)
    p = jnp.exp(s - m)
    return p / (jnp.sum(p, axis=-1, keepdims=True) + jnp.exp(sink - m))


def _sink_block(qi, k, v, sink):
    s = jnp.einsum('bhgqd,bhkd->bhgqk', qi, k, preferred_element_type=jnp.float32) * ATTN_SCALE
    p = _sink_probs(s, sink).astype(v.dtype)
    return jnp.einsum('bhgqk,bhkd->bhgqd', p, v)


def _window_sink_attention(q, k, v, k_ctx, v_ctx, sink):
    s_len = q.shape[3]
    t_len = k_ctx.shape[2]
    span = Q_BLOCK + 2 * WINDOW
    k_pad = jnp.pad(k, ((0, 0), (0, 0), (WINDOW, WINDOW), (0, 0)))
    v_pad = jnp.pad(v, ((0, 0), (0, 0), (WINDOW, WINDOW), (0, 0)))
    offs = jnp.arange(span, dtype=jnp.int32)
    band = jnp.abs(offs[None, :] - WINDOW - jnp.arange(Q_BLOCK, dtype=jnp.int32)[:, None]) <= WINDOW

    def blk(qi, i):
        start = i * Q_BLOCK
        kw = lax.dynamic_slice_in_dim(k_pad, start, span, axis=2)
        vw = lax.dynamic_slice_in_dim(v_pad, start, span, axis=2)
        kpos = start - WINDOW + offs
        mask = band & ((kpos >= 0) & (kpos < s_len))[None, :]
        s_win = jnp.einsum('bhgqd,bhkd->bhgqk', qi, kw, preferred_element_type=jnp.float32) * ATTN_SCALE
        s_win = jnp.where(mask, s_win, -jnp.inf)
        s_ctx = jnp.einsum('bhgqd,bhkd->bhgqk', qi, k_ctx, preferred_element_type=jnp.float32) * ATTN_SCALE
        p = _sink_probs(jnp.concatenate([s_ctx, s_win], axis=-1), sink).astype(v.dtype)
        return (jnp.einsum('bhgqk,bhkd->bhgqd', p[..., :t_len], v_ctx)
                + jnp.einsum('bhgqk,bhkd->bhgqd', p[..., t_len:], vw))

    return _sweep_blocks(q, blk)


def _diff_block(qi, k, v, lam):
    s = jnp.einsum('bhiqd,bhikd->bhiqk', qi, k, preferred_element_type=jnp.float32) * ATTN_SCALE
    p = jax.nn.softmax(s, axis=-1)
    pd = (p[:, :, :1] - lam * p[:, :, 1:]).astype(v.dtype)
    return jnp.einsum('bhiqk,bhkv->bhiqv', pd, v)


def _merge_branches(a, ya, yb, yc, w_gate, b_gate, w_br_a, w_br_b, w_br_c, w_out):
    ga, gb, gc = jnp.split(jax.nn.sigmoid(a @ w_gate + b_gate), N_BRANCHES, axis=-1)
    return (ga * (ya @ w_br_a) + gb * (yb @ w_br_b) + gc * (yc @ w_br_c)) @ w_out


def _token_mixers(a_lat, a_ctx, cos, sin, w_qkv, g_qa, g_ka, sink, lam, lam_init, g_sub,
                  w_br_a, w_br_b, w_br_c, w_gate, b_gate, w_out, with_ctx_out):
    qa, ka, va, qb, kb, vb, qc, kc, vc = _qkv_heads(a_lat, w_qkv)
    qa_x, ka_x, va_x, qb_x, kb_x, vb_x, qc_x, kc_x, vc_x = _qkv_heads(a_ctx, w_qkv)
    bsz, _, s_len, _ = qa.shape
    t_len = ka_x.shape[2]

    qa = _rope(_rmsnorm(qa, g_qa), cos, sin)
    ka = _rope(_rmsnorm(ka, g_ka), cos, sin)
    qa_x = _rmsnorm(qa_x, g_qa)
    ka_x = _rmsnorm(ka_x, g_ka)
    ka_all = jnp.concatenate([ka_x, ka], axis=2)
    va_all = jnp.concatenate([va_x, va], axis=2)
    ya = _sweep_blocks(_group(qa, A_KV_HEADS), lambda qi, i: _gqa_block(qi, ka_all, va_all))

    sink_g = sink.astype(jnp.float32).reshape(1, B_KV_HEADS, B_HEADS // B_KV_HEADS, 1, 1)
    qb = _rope(qb, cos, sin)
    kb = _rope(kb, cos, sin)
    yb = _window_sink_attention(_group(qb, B_KV_HEADS), kb, vb, kb_x, vb_x, sink_g)

    qc = _rope(qc, cos, sin)
    kc = _rope(kc, cos, sin)
    kc_all = jnp.concatenate([kc_x, kc], axis=2).reshape(bsz, C_HEADS, 2, t_len + s_len, HEAD_DIM)
    vc_all = jnp.concatenate([vc_x, vc], axis=2)
    yc = _sweep_blocks(qc.reshape(bsz, C_HEADS, 2, s_len, HEAD_DIM),
                       lambda qi, i: _diff_block(qi, kc_all, vc_all, lam))
    yc = _rmsnorm(yc, g_sub) * (1.0 - lam_init)

    mix_lat = _merge_branches(a_lat, _merge_heads(ya), _merge_heads(yb), _merge_heads(yc),
                              w_gate, b_gate, w_br_a, w_br_b, w_br_c, w_out)
    if not with_ctx_out:
        return mix_lat, None

    ya_x = _sweep_blocks(_group(qa_x, A_KV_HEADS), lambda qi, i: _gqa_block(qi, ka_x, va_x))
    yb_x = _sweep_blocks(_group(qb_x, B_KV_HEADS), lambda qi, i: _sink_block(qi, kb_x, vb_x, sink_g))
    kc_xp = kc_x.reshape(bsz, C_HEADS, 2, t_len, HEAD_DIM)
    yc_x = _sweep_blocks(qc_x.reshape(bsz, C_HEADS, 2, t_len, HEAD_DIM),
                         lambda qi, i: _diff_block(qi, kc_xp, vc_x, lam))
    yc_x = _rmsnorm(yc_x, g_sub) * (1.0 - lam_init)
    mix_ctx = _merge_branches(a_ctx, _merge_heads(ya_x), _merge_heads(yb_x), _merge_heads(yc_x),
                              w_gate, b_gate, w_br_a, w_br_b, w_br_c, w_out)
    return mix_lat, mix_ctx


def _moe_tokens(h, w_router, e_bias, w1, w3, w2, ws1, ws3, ws2):
    n, d = h.shape
    scores = jax.nn.sigmoid(jnp.dot(h, w_router, preferred_element_type=jnp.float32))
    choice = scores + e_bias.astype(jnp.float32)
    grouped = choice.reshape(n, N_GROUPS, N_EXPERTS // N_GROUPS)
    group_score = jnp.sum(lax.top_k(grouped, 2)[0], axis=-1)
    _, top_groups = lax.top_k(group_score, TOPK_GROUPS)
    group_mask = jnp.any(top_groups[:, :, None] == jnp.arange(N_GROUPS, dtype=jnp.int32)[None, None, :], axis=1)
    expert_mask = jnp.repeat(group_mask, N_EXPERTS // N_GROUPS, axis=1)
    _, idx = lax.top_k(jnp.where(expert_mask, choice, -jnp.inf), TOP_K)
    w = jnp.take_along_axis(scores, idx, axis=1)
    w = w / jnp.sum(w, axis=-1, keepdims=True) * ROUTE_SCALE

    n_assign = n * TOP_K
    flat_e = idx.reshape(-1).astype(jnp.int32)
    order = jnp.argsort(flat_e).astype(jnp.int32)
    e_sorted = flat_e[order]
    tok_sorted = order // TOP_K
    w_sorted = w.reshape(-1)[order].astype(h.dtype)
    counts = jnp.zeros((N_EXPERTS,), jnp.int32).at[flat_e].add(1)
    starts = jnp.cumsum(counts) - counts
    padded = (counts + EXPERT_BLOCK - 1) // EXPERT_BLOCK * EXPERT_BLOCK
    padded_end = jnp.cumsum(padded)
    padded_start = padded_end - padded
    dest = padded_start[e_sorted] + jnp.arange(n_assign, dtype=jnp.int32) - starts[e_sorted]
    n_blocks = -(-n_assign // EXPERT_BLOCK) + N_EXPERTS
    n_rows = n_blocks * EXPERT_BLOCK
    row_tok = jnp.full((n_rows,), n, jnp.int32).at[dest].set(tok_sorted)
    block_start = jnp.arange(n_blocks, dtype=jnp.int32) * EXPERT_BLOCK
    block_expert = jnp.minimum(jnp.searchsorted(padded_end, block_start, side='right'), N_EXPERTS - 1)
    h_pad = jnp.concatenate([h, jnp.zeros((1, d), h.dtype)], axis=0)
    xb = h_pad[row_tok].reshape(n_blocks, EXPERT_BLOCK, d)

    def expert_block(args):
        xblk, e = args
        return _swiglu(xblk, w1[e], w3[e], w2[e])

    y_rows = lax.map(expert_block, (xb, block_expert)).reshape(n_rows, d)
    routed = jnp.zeros((n, d), h.dtype).at[tok_sorted].add(y_rows[dest] * w_sorted[:, None])
    return _swiglu(h, ws1, ws3, ws2) + routed


def _moe(h, w_router, e_bias, w1, w3, w2, ws1, ws3, ws2):
    return lax.map(lambda hs: _moe_tokens(hs, w_router, e_bias, w1, w3, w2, ws1, ws3, ws2), h)


def setup_inputs(seed: int = 0) -> dict:
    key = jax.random.key(seed)
    ks = jax.random.split(key, 32)
    f32 = jnp.float32

    def nrm(k, shape, scale):
        return jax.random.normal(k, shape, f32) * scale

    dm = D_MODEL
    return {
        'x': nrm(ks[0], (BATCH, SEQ, dm), 1.0),
        'c': nrm(ks[1], (BATCH, dm), 1.0),
        'ctx': nrm(ks[2], (BATCH, CTX_LEN, dm), 1.0),
        'c_ctx': nrm(ks[3], (dm,), 1.0),
        'w_mod': nrm(ks[4], (DEPTH, dm, N_MOD * dm), 0.3 * dm ** -0.5),
        'b_mod': nrm(ks[5], (DEPTH, N_MOD * dm), 0.02),
        'g_norm1': 1.0 + nrm(ks[6], (DEPTH, dm), 0.02),
        'w_qkv': nrm(ks[7], (DEPTH, dm, QKV_WIDTH), dm ** -0.5),
        'g_qnorm_a': 1.0 + nrm(ks[8], (DEPTH, HEAD_DIM), 0.02),
        'g_knorm_a': 1.0 + nrm(ks[9], (DEPTH, HEAD_DIM), 0.02),
        'sink_b': nrm(ks[10], (DEPTH, B_HEADS), 0.5),
        'lam_q1': nrm(ks[11], (DEPTH, HEAD_DIM), 0.1),
        'lam_k1': nrm(ks[12], (DEPTH, HEAD_DIM), 0.1),
        'lam_q2': nrm(ks[13], (DEPTH, HEAD_DIM), 0.1),
        'lam_k2': nrm(ks[14], (DEPTH, HEAD_DIM), 0.1),
        'g_subln_c': 1.0 + nrm(ks[15], (DEPTH, C_VDIM), 0.02),
        'w_br_a': nrm(ks[16], (DEPTH, A_QW, dm), A_QW ** -0.5),
        'w_br_b': nrm(ks[17], (DEPTH, B_QW, dm), B_QW ** -0.5),
        'w_br_c': nrm(ks[18], (DEPTH, C_VW, dm), C_VW ** -0.5),
        'w_gate': nrm(ks[19], (DEPTH, dm, N_BRANCHES * dm), dm ** -0.5),
        'b_gate': nrm(ks[20], (DEPTH, N_BRANCHES * dm), 0.02),
        'w_out': nrm(ks[21], (DEPTH, dm, dm), dm ** -0.5),
        'g_norm2': 1.0 + nrm(ks[22], (DEPTH, dm), 0.02),
        'w_router': nrm(ks[23], (DEPTH, dm, N_EXPERTS), dm ** -0.5),
        'e_bias': nrm(ks[24], (DEPTH, N_EXPERTS), 0.01),
        'w1': nrm(ks[25], (DEPTH, N_EXPERTS, dm, D_EXPERT), dm ** -0.5),
        'w3': nrm(ks[26], (DEPTH, N_EXPERTS, dm, D_EXPERT), dm ** -0.5),
        'w2': nrm(ks[27], (DEPTH, N_EXPERTS, D_EXPERT, dm), D_EXPERT ** -0.5),
        'ws1': nrm(ks[28], (DEPTH, dm, D_SHARED), dm ** -0.5),
        'ws3': nrm(ks[29], (DEPTH, dm, D_SHARED), dm ** -0.5),
        'ws2': nrm(ks[30], (DEPTH, D_SHARED, dm), D_SHARED ** -0.5),
        'g_final': 1.0 + nrm(ks[31], (dm,), 0.02),
    }


def reference(x, c, ctx, c_ctx, w_mod, b_mod, g_norm1, w_qkv, g_qnorm_a, g_knorm_a, sink_b,
              lam_q1, lam_k1, lam_q2, lam_k2, g_subln_c, w_br_a, w_br_b, w_br_c, w_gate, b_gate,
              w_out, g_norm2, w_router, e_bias, w1, w3, w2, ws1, ws3, ws2, g_final):
    n_lat = x.shape[1]
    cos, sin = _rope_tables(n_lat)
    for l in range(DEPTH):
        last = l == DEPTH - 1
        lam_init = 0.8 - 0.6 * math.exp(-0.3 * l)
        lam = (jnp.exp(jnp.dot(lam_q1[l], lam_k1[l])) - jnp.exp(jnp.dot(lam_q2[l], lam_k2[l]))).astype(jnp.float32) + lam_init
        sh1, sc1, gt1, sh2, sc2, gt2 = jnp.split((jax.nn.silu(c) @ w_mod[l] + b_mod[l])[:, None, :], N_MOD, axis=-1)
        csh1, csc1, cgt1, csh2, csc2, cgt2 = jnp.split(jax.nn.silu(c_ctx) @ w_mod[l] + b_mod[l], N_MOD, axis=-1)

        a_lat = _rmsnorm(x, g_norm1[l]) * (1.0 + sc1) + sh1
        a_ctx = _rmsnorm(ctx, g_norm1[l]) * (1.0 + csc1) + csh1
        mix_lat, mix_ctx = _token_mixers(a_lat, a_ctx, cos, sin, w_qkv[l], g_qnorm_a[l], g_knorm_a[l],
                                         sink_b[l], lam, lam_init, g_subln_c[l], w_br_a[l], w_br_b[l],
                                         w_br_c[l], w_gate[l], b_gate[l], w_out[l], not last)
        x = x + gt1 * mix_lat
        f_lat = _rmsnorm(x, g_norm2[l]) * (1.0 + sc2) + sh2
        moe_args = (w_router[l], e_bias[l], w1[l], w3[l], w2[l], ws1[l], ws3[l], ws2[l])
        if last:
            x = x + gt2 * _moe(f_lat, *moe_args)
        else:
            ctx = ctx + cgt1 * mix_ctx
            f_ctx = _rmsnorm(ctx, g_norm2[l]) * (1.0 + csc2) + csh2
            n_ctx = ctx.shape[1]
            y = _moe(jnp.concatenate([f_ctx, f_lat], axis=1), *moe_args)
            ctx = ctx + cgt2 * y[:, :n_ctx]
            x = x + gt2 * y[:, n_ctx:]
    return _rmsnorm(x, g_final)
```

```cpp
#include <hip/hip_runtime.h>
#include <hip/hip_bf16.h>
#include <cstdio>
#include <cstdint>
#include <cmath>

#ifndef MK_MULTI
#define MK_MULTI 0
#endif
#ifndef MK_CHECK
#define MK_CHECK 0
#endif

namespace pg8 {
#define PG8_LAS __attribute__((address_space(3)))
typedef unsigned short bf16_t;
typedef short bf16x8 __attribute__((ext_vector_type(8)));
typedef float f32x4 __attribute__((ext_vector_type(4)));
typedef float f32x2 __attribute__((ext_vector_type(2)));
typedef unsigned u32x4 __attribute__((ext_vector_type(4)));
constexpr int BM = 256, BK = 64, HALF = 128, HTB = HALF * BK * 2  , STAGE_BYTES = 8 * HTB, NXCD = 8, WGM = 8;

__host__ __device__ __forceinline__ int lds_byte(int r, int c) { const int st = (r >> 4) * 2 + (c >> 5), rr = r & 15, cc = c & 31, ob = rr * 64 + cc * 2; return st * 1024 + (ob ^ (((ob >> 9) & 1) << 5)); }
__host__ __device__ __forceinline__ void stage_rc(int b, int& R, int& C) { const int st = b / 1024, sb = b % 1024, swz = sb ^ (((sb >> 9) & 1) << 5); R = (st >> 1) * 16 + swz / 64; C = (st & 1) * 32 + (swz % 64) / 2; }
__host__ __device__ __forceinline__ int perm32(int rho) { const int n = rho >> 4, i = rho & 15; return 8 * (i >> 2) + 4 * n + (i & 3); }

struct Unit { int pm, pn, om, on, aux; };
struct Gemm { const bf16_t* A; const bf16_t* Bt; int K; };

struct StaticOrder {
    int nM, nN, nwg, G, c;
    __device__ __forceinline__ void init(int nM_, int nN_, int G_, int c_) { nM = nM_; nN = nN_; nwg = nM * nN; G = G_; c = c_; }
    __device__ __forceinline__ bool next(int i, Unit& u) const {
        const long L = (long)i * G + c; if (L >= nwg) return false;
        int wgid = (int)L; { const int q = nwg / NXCD, r = nwg % NXCD, xcd = wgid % NXCD, off = wgid / NXCD; wgid = (xcd < r ? xcd * (q + 1) : r * (q + 1) + (xcd - r) * q) + off; }
        const int nig = WGM * nN, gid = wgid / nig, fm = gid * WGM, gsz = (nM - fm) < WGM ? (nM - fm) : WGM;
        u.pm = fm + ((wgid % nig) % gsz); u.pn = (wgid % nig) / gsz; u.om = u.pm; u.on = u.pn; u.aux = 0; return true;
    }
    __device__ __forceinline__ unsigned arow(const Unit&, int, int) const { return 0u; }
};

typedef __bf16 bf16x2_t __attribute__((ext_vector_type(2)));
__device__ __forceinline__ unsigned cvt_pk_bf16(float lo, float hi) { f32x2 v = {lo, hi}; bf16x2_t b = __builtin_convertvector(v, bf16x2_t); return __builtin_bit_cast(unsigned, b); }
__device__ __forceinline__ float bf_lo(unsigned w) { return __builtin_bit_cast(float, w << 16); }
__device__ __forceinline__ float bf_hi(unsigned w) { return __builtin_bit_cast(float, w & 0xffff0000u); }
__device__ __forceinline__ float sigmoidf_fast(float x) { return __builtin_amdgcn_rcpf(1.0f + __builtin_amdgcn_exp2f(-1.4426950408889634f * x)); }

template <int ACT> struct EpiBf16 {
    static constexpr bool PERM = true;
    bf16_t* O; int ldc; const float* bias;
    __device__ __forceinline__ void operator()(const f32x4 (&acc)[2][2][4][2], const Unit& u, int wr, int wc, int fr, int fq) const {
        const int row0 = u.om * BM + wr * 64 + fr; const int col0 = u.on * BM + wc * 32 + 8 * fq;
        f32x4 bv[2][2];
#pragma unroll
        for (int bj = 0; bj < 2; ++bj)
#pragma unroll
            for (int n = 0; n < 2; ++n) bv[bj][n] = (ACT == 1) ? *(const f32x4*)(bias + col0 + bj * HALF + 4 * n) : (f32x4){0.f, 0.f, 0.f, 0.f};
#pragma unroll
        for (int ai = 0; ai < 2; ++ai)
#pragma unroll
            for (int m = 0; m < 4; ++m) { bf16_t* rowp = O + (size_t)(row0 + ai * HALF + m * 16) * ldc + col0;
#pragma unroll
                for (int bj = 0; bj < 2; ++bj) { f32x4 v0 = acc[ai][bj][m][0] + bv[bj][0], v1 = acc[ai][bj][m][1] + bv[bj][1];
                    if (ACT == 1) {
#pragma unroll
                        for (int j = 0; j < 4; ++j) { v0[j] = sigmoidf_fast(v0[j]); v1[j] = sigmoidf_fast(v1[j]); } }
                    u32x4 w; w.x = cvt_pk_bf16(v0[0], v0[1]); w.y = cvt_pk_bf16(v0[2], v0[3]); w.z = cvt_pk_bf16(v1[0], v1[1]); w.w = cvt_pk_bf16(v1[2], v1[3]);
                    *(u32x4*)(rowp + bj * HALF) = w; } }
    }
};
template <int BR> struct EpiBranch {
    static constexpr bool PERM = true;
    const bf16_t* GATE; bf16_t* MG;
    __device__ __forceinline__ void operator()(const f32x4 (&acc)[2][2][4][2], const Unit& u, int wr, int wc, int fr, int fq) const {
        const int row0 = u.om * BM + wr * 64 + fr; const int col0 = u.on * BM + wc * 32 + 8 * fq;
#pragma unroll
        for (int ai = 0; ai < 2; ++ai)
#pragma unroll
            for (int m = 0; m < 4; ++m) { const size_t row = (size_t)(row0 + ai * HALF + m * 16);
#pragma unroll
                for (int bj = 0; bj < 2; ++bj) {
                    const u32x4 gw = *(const u32x4*)(GATE + row * 3072 + BR * 1024 + col0 + bj * HALF);
                    bf16_t* mp = MG + row * 1024 + col0 + bj * HALF;
                    u32x4 mw = (u32x4){0u, 0u, 0u, 0u}; if (BR > 0) mw = *(const u32x4*)mp;
                    const f32x4 a0 = acc[ai][bj][m][0], a1 = acc[ai][bj][m][1];
                    float o[8];
                    o[0] = bf_lo(gw.x) * a0[0]; o[1] = bf_hi(gw.x) * a0[1]; o[2] = bf_lo(gw.y) * a0[2]; o[3] = bf_hi(gw.y) * a0[3];
                    o[4] = bf_lo(gw.z) * a1[0]; o[5] = bf_hi(gw.z) * a1[1]; o[6] = bf_lo(gw.w) * a1[2]; o[7] = bf_hi(gw.w) * a1[3];
                    if (BR > 0) { o[0] += bf_lo(mw.x); o[1] += bf_hi(mw.x); o[2] += bf_lo(mw.y); o[3] += bf_hi(mw.y); o[4] += bf_lo(mw.z); o[5] += bf_hi(mw.z); o[6] += bf_lo(mw.w); o[7] += bf_hi(mw.w); }
                    u32x4 w; w.x = cvt_pk_bf16(o[0], o[1]); w.y = cvt_pk_bf16(o[2], o[3]); w.z = cvt_pk_bf16(o[4], o[5]); w.w = cvt_pk_bf16(o[6], o[7]);
                    *(u32x4*)mp = w; } }
    }
};
struct EpiResid {
    static constexpr bool PERM = false;
    float* XL; float* XC; const float* modl; int goff;
    __device__ __forceinline__ void operator()(const f32x4 (&acc)[2][2][4][2], const Unit& u, int wr, int wc, int fr, int fq) const {
        const int b = u.om / 33, pj = u.om % 33;
        float* base = (pj == 0) ? XC + (size_t)b * 256 * 1024 : XL + ((size_t)b * 8192 + (size_t)(pj - 1) * 256) * 1024;
        const float* gv = modl + (pj == 0 ? 8 : b) * 6144 + goff;
        const int row0 = wr * 64 + fr, col0 = u.on * BM + wc * 32 + 4 * fq;
#pragma unroll
        for (int bj = 0; bj < 2; ++bj)
#pragma unroll
            for (int n = 0; n < 2; ++n) { const f32x4 g4 = *(const f32x4*)(gv + col0 + bj * HALF + n * 16);
#pragma unroll
                for (int ai = 0; ai < 2; ++ai)
#pragma unroll
                    for (int m = 0; m < 4; ++m) { f32x4* p = (f32x4*)(base + (size_t)(row0 + ai * HALF + m * 16) * 1024 + col0 + bj * HALF + n * 16); *p = *p + g4 * acc[ai][bj][m][n]; } }
    }
};
struct EpiRouter {
    static constexpr bool PERM = false;
    float* LG;
    __device__ __forceinline__ void operator()(const f32x4 (&acc)[2][2][4][2], const Unit& u, int wr, int wc, int fr, int fq) const {
        const int row0 = u.om * BM + wr * 64 + fr, col0 = wc * 32 + 4 * fq;
#pragma unroll
        for (int ai = 0; ai < 2; ++ai)
#pragma unroll
            for (int m = 0; m < 4; ++m) { float* rowp = LG + (size_t)(row0 + ai * HALF + m * 16) * 128 + col0;
#pragma unroll
                for (int n = 0; n < 2; ++n) *(f32x4*)(rowp + n * 16) = acc[ai][0][m][n]; }
    }
};
struct EpiUp {
    static constexpr bool PERM = true;
    bf16_t* H;
    __device__ __forceinline__ void operator()(const f32x4 (&acc)[2][2][4][2], const Unit& u, int wr, int wc, int fr, int fq) const {
        const int row0 = u.om * BM + wr * 64 + fr; const int col0 = u.on * HALF + wc * 32 + 8 * fq;
#pragma unroll
        for (int ai = 0; ai < 2; ++ai)
#pragma unroll
            for (int m = 0; m < 4; ++m) { bf16_t* rowp = H + (size_t)(row0 + ai * HALF + m * 16) * 256 + col0;
                float o[8];
#pragma unroll
                for (int n = 0; n < 2; ++n)
#pragma unroll
                    for (int j = 0; j < 4; ++j) { const float a = acc[ai][0][m][n][j], c = acc[ai][1][m][n][j]; o[n * 4 + j] = a * sigmoidf_fast(a) * c; }
                u32x4 w; w.x = cvt_pk_bf16(o[0], o[1]); w.y = cvt_pk_bf16(o[2], o[3]); w.z = cvt_pk_bf16(o[4], o[5]); w.w = cvt_pk_bf16(o[6], o[7]);
                *(u32x4*)rowp = w; }
    }
};

template <class Epi, class Sched, bool ALIGN_EPI, bool GATHER>
__device__ __forceinline__ void gemm_phase(PG8_LAS unsigned char* lds, const Gemm g, const Sched& S, const Epi& E) {
    int tid = threadIdx.x; asm volatile("" : "+v"(tid));
    const int wid = __builtin_amdgcn_readfirstlane(tid >> 6), lane = tid & 63, wr = wid >> 2, wc = wid & 3, fr = lane & 15, fq = lane >> 4;
    int K = g.K; asm volatile("" : "+s"(K));
    const int nt = K / BK;
    unsigned voffA[2], voffB[2]; int RA[2]; unsigned CA2[2];
#pragma unroll
    for (int i = 0; i < 2; ++i) { int R, C; stage_rc(tid * 16 + i * 8192, R, C); const int Rb = Epi::PERM ? ((R & ~31) + perm32(R & 31)) : R;
        voffA[i] = (unsigned)(R * K + C) * 2u; voffB[i] = (unsigned)(Rb * K + C) * 2u; RA[i] = R; CA2[i] = (unsigned)C * 2u; }
    const size_t kstep = (size_t)(BK * 2);
    const size_t hstep = (size_t)HALF * K * 2;
    const size_t tstep = 2 * hstep;
    const unsigned rowb = (unsigned)K * 2u;
    const unsigned ldsw = (unsigned)wid * 1024u;
    const int aoff = lds_byte(wr * 64 + fr, fq * 8), boff = lds_byte(wc * 32 + fr, fq * 8);
#define PG8_SA(b, h) (((b) * 2 + (h)) * HTB)
#define PG8_SB(b, h) ((4 + (b) * 2 + (h)) * HTB)
#define PG8_STAGE(bufoff, gbase, voff) do { _Pragma("unroll") for (int _i = 0; _i < 2; ++_i) \
        __builtin_amdgcn_global_load_lds((const unsigned*)((const char*)(gbase) + (voff)[_i]), (PG8_LAS unsigned*)(lds + (bufoff) + ldsw + _i * 8192), 16, 0, 0); } while (0)
#define PG8_STAGE_A(bufoff, gb, h, VO) do { if constexpr (GATHER) { PG8_STAGE(bufoff, gb, VO[h]); } else { PG8_STAGE(bufoff, (gb) + (h) * hstep, voffA); } } while (0)
#define PG8_LDA(dst, b, h) do { _Pragma("unroll") for (int m = 0; m < 4; ++m) _Pragma("unroll") for (int k = 0; k < 2; ++k) dst[m][k] = *(const PG8_LAS bf16x8*)(lds + PG8_SA(b, h) + aoff + m * 2048 + k * 1024); } while (0)
#define PG8_LDB(dst, b, h) do { _Pragma("unroll") for (int n = 0; n < 2; ++n) _Pragma("unroll") for (int k = 0; k < 2; ++k) dst[n][k] = *(const PG8_LAS bf16x8*)(lds + PG8_SB(b, h) + boff + n * 2048 + k * 1024); } while (0)
#define PG8_MMA(ai, bj, At, Bt) do { __builtin_amdgcn_s_setprio(1); _Pragma("unroll") for (int m = 0; m < 4; ++m) _Pragma("unroll") for (int n = 0; n < 2; ++n) _Pragma("unroll") for (int k = 0; k < 2; ++k) \
        acc[ai][bj][m][n] = __builtin_amdgcn_mfma_f32_16x16x32_bf16(Bt[n][k], At[m][k], acc[ai][bj][m][n], 0, 0, 0); __builtin_amdgcn_s_setprio(0); } while (0)
#define PG8_WAIT_V(n) asm volatile("s_waitcnt vmcnt(" #n ")" ::: "memory")
#define PG8_WAIT_L(n) asm volatile("s_waitcnt lgkmcnt(" #n ")" ::: "memory")
#define PG8_BAR __builtin_amdgcn_s_barrier()
#define PG8_SCHED __builtin_amdgcn_sched_barrier(0)
    Unit cur, nxt, nx2; int ui = 0;
    if (!S.next(0, cur)) return;
    f32x4 acc[2][2][4][2];
#pragma unroll
    for (int a = 0; a < 2; ++a)
#pragma unroll
        for (int b = 0; b < 2; ++b)
#pragma unroll
            for (int m = 0; m < 4; ++m)
#pragma unroll
                for (int n = 0; n < 2; ++n) acc[a][b][m][n] = (f32x4){0.f, 0.f, 0.f, 0.f};
    bf16x8 At[4][2], B0[2][2], B1[2][2];
    unsigned cvo[2][2], nvo[2][2], n2vo[2][2];
    bool has_next = S.next(1, nxt);
    if constexpr (GATHER) {
#pragma unroll
        for (int h = 0; h < 2; ++h)
#pragma unroll
            for (int i = 0; i < 2; ++i) { cvo[h][i] = S.arow(cur, h, RA[i]) * rowb + CA2[i]; nvo[h][i] = has_next ? S.arow(nxt, h, RA[i]) * rowb + CA2[i] : cvo[h][i]; n2vo[h][i] = nvo[h][i]; }
    }
    const char* cA = GATHER ? (const char*)g.A : (const char*)g.A + (size_t)cur.pm * tstep; const char* cB = (const char*)g.Bt + (size_t)cur.pn * tstep;
    PG8_STAGE(PG8_SB(0, 0), cB, voffB); PG8_STAGE(PG8_SB(0, 1), cB + hstep, voffB); PG8_STAGE_A(PG8_SA(0, 0), cA, 0, cvo); PG8_STAGE_A(PG8_SA(0, 1), cA, 1, cvo);
    if (wr == 1) PG8_BAR;
    PG8_WAIT_V(2); PG8_BAR;
    PG8_STAGE(PG8_SB(1, 0), cB + kstep, voffB); PG8_STAGE_A(PG8_SA(1, 0), cA + kstep, 0, cvo); PG8_STAGE(PG8_SB(1, 1), cB + hstep + kstep, voffB);
    PG8_WAIT_V(6); PG8_BAR;
    for (;;) {
        bool has_n2 = false;
        if constexpr (GATHER) { if (has_next) { has_n2 = S.next(ui + 2, nx2); if (has_n2) {
#pragma unroll
            for (int h = 0; h < 2; ++h)
#pragma unroll
                for (int i = 0; i < 2; ++i) n2vo[h][i] = S.arow(nx2, h, RA[i]) * rowb + CA2[i]; } } }
        const char* nA = GATHER ? (const char*)g.A : (has_next ? (const char*)g.A + (size_t)nxt.pm * tstep : cA); const char* nB = has_next ? (const char*)g.Bt + (size_t)nxt.pn * tstep : cB;
        for (int t = 0; t < nt; t += 2) {
            const bool last = (t == nt - 2);
            const char* a1 = cA + (size_t)(t + 1) * kstep;
            const char* a2 = last ? nA : cA + (size_t)(t + 2) * kstep; const char* b2 = last ? nB : cB + (size_t)(t + 2) * kstep;
            const char* a3 = a2 + kstep; const char* b3 = b2 + kstep;
            unsigned xvo[2][2];
            if constexpr (GATHER) {
#pragma unroll
                for (int h = 0; h < 2; ++h)
#pragma unroll
                    for (int i = 0; i < 2; ++i) xvo[h][i] = last ? nvo[h][i] : cvo[h][i];
            }
            PG8_LDB(B0, 0, 0); PG8_LDB(B1, 0, 1); PG8_SCHED; PG8_LDA(At, 0, 0); PG8_STAGE_A(PG8_SA(1, 1), a1, 1, cvo);
            PG8_WAIT_V(8); PG8_WAIT_L(0); PG8_BAR; PG8_MMA(0, 0, At, B0); PG8_MMA(0, 1, At, B1); PG8_BAR; PG8_SCHED;
            PG8_LDA(At, 0, 1); PG8_STAGE(PG8_SB(0, 0), b2, voffB); PG8_STAGE(PG8_SB(0, 1), b2 + hstep, voffB); PG8_STAGE_A(PG8_SA(0, 0), a2, 0, xvo);
            PG8_WAIT_V(8); PG8_WAIT_L(0); PG8_BAR; PG8_MMA(1, 0, At, B0); PG8_MMA(1, 1, At, B1); PG8_BAR; PG8_SCHED;
            PG8_LDB(B0, 1, 0); PG8_LDB(B1, 1, 1); PG8_SCHED; PG8_LDA(At, 1, 0); PG8_STAGE_A(PG8_SA(0, 1), a2, 1, xvo);
            PG8_WAIT_V(8); PG8_WAIT_L(0); PG8_BAR; PG8_MMA(0, 0, At, B0); PG8_MMA(0, 1, At, B1); PG8_BAR; PG8_SCHED;
            PG8_LDA(At, 1, 1); PG8_STAGE(PG8_SB(1, 0), b3, voffB); PG8_STAGE(PG8_SB(1, 1), b3 + hstep, voffB); PG8_STAGE_A(PG8_SA(1, 0), a3, 0, xvo);
            PG8_WAIT_V(8); PG8_WAIT_L(0); PG8_BAR; PG8_MMA(1, 0, At, B0); PG8_MMA(1, 1, At, B1); PG8_BAR; PG8_SCHED;
        }
        if constexpr (ALIGN_EPI) { if (wr == 0) PG8_BAR; }
        E(acc, cur, wr, wc, fr, fq);
        if (!has_next) break;
#pragma unroll
        for (int a = 0; a < 2; ++a)
#pragma unroll
            for (int b = 0; b < 2; ++b)
#pragma unroll
                for (int m = 0; m < 4; ++m)
#pragma unroll
                    for (int n = 0; n < 2; ++n) acc[a][b][m][n] = (f32x4){0.f, 0.f, 0.f, 0.f};
        cur = nxt; cA = nA; cB = nB; ++ui;
        if constexpr (GATHER) {
#pragma unroll
            for (int h = 0; h < 2; ++h)
#pragma unroll
                for (int i = 0; i < 2; ++i) { cvo[h][i] = nvo[h][i]; nvo[h][i] = n2vo[h][i]; }
            has_next = has_n2; nxt = nx2;
        } else { has_next = S.next(ui + 1, nxt); }
        if constexpr (ALIGN_EPI) { if (wr == 1) PG8_BAR; }
    }
    PG8_WAIT_V(0);
    if constexpr (!ALIGN_EPI) { if (wr == 0) PG8_BAR; }
    PG8_BAR;
#undef PG8_SA
#undef PG8_SB
#undef PG8_STAGE
#undef PG8_STAGE_A
#undef PG8_LDA
#undef PG8_LDB
#undef PG8_MMA
#undef PG8_WAIT_V
#undef PG8_WAIT_L
#undef PG8_BAR
#undef PG8_SCHED
}
}
namespace attn_body {
using bf16=__hip_bfloat16;
using bf16x8=__attribute__((ext_vector_type(8)))short;
using s16x4=__attribute__((ext_vector_type(4)))short;
using f32x16=__attribute__((ext_vector_type(16)))float;
using u32x4=__attribute__((ext_vector_type(4)))unsigned;
constexpr int D=64, P=3072;
constexpr int NW=8,QBLK=32,QB=QBLK*NW,KVBLK=64;
__device__ __forceinline__ int crow(int r,int hi){return (r&3)+8*(r>>2)+4*hi;}
#define SBAR() __builtin_amdgcn_sched_barrier(0)
__device__ __forceinline__ void wmask(f32x16&p0,f32x16&p1,int dbase){
  const float NEG=-INFINITY;
  #pragma unroll
  for(int r=0;r<16;++r){const int d=dbase+(r&3)+8*(r>>2); if(d>128||d<-128)p0[r]=NEG; if(d+32>128||d+32<-128)p1[r]=NEG;}
}
constexpr int NSLOT=3, SLOTB=8192;
constexpr int LDS_K=0, LDS_V=NSLOT*SLOTB, LDS_WS=2*NSLOT*SLOTB, LDS_OST=LDS_WS+NW*64*4, LDS_BYTES=LDS_OST+NW*4096;
constexpr float C2=0.125f*1.4426950408889634f;
__device__ __forceinline__ void glds16(const void*gsrc,unsigned lds_dst){unsigned keep;
  asm volatile("s_mov_b32 %0, m0\n\ts_mov_b32 m0, %2\n\ts_nop 0\n\tglobal_load_lds_dwordx4 %1, off\n\ts_mov_b32 m0, %0":"=&s"(keep):"v"(gsrc),"s"(lds_dst):"memory");}
__device__ __forceinline__ float max3f(float a,float b,float c){float r;asm("v_max3_f32 %0, %1, %2, %3":"=v"(r):"v"(a),"v"(b),"v"(c));return r;}
__device__ __forceinline__ float max2f(float a,float b){float r;asm("v_max_f32_e32 %0, %1, %2":"=v"(r):"v"(a),"v"(b));return r;}
__device__ __forceinline__ float fadd_s(float a,float b){float r;asm("v_add_f32_e32 %0, %1, %2":"=v"(r):"v"(a),"v"(b));return r;}
__device__ __forceinline__ float fsub_s(float a,float b){float r;asm("v_sub_f32_e32 %0, %1, %2":"=v"(r):"v"(a),"v"(b));return r;}
typedef float f32x2_t __attribute__((ext_vector_type(2))); typedef __bf16 bf16x2_t __attribute__((ext_vector_type(2)));
__device__ __forceinline__ unsigned cvtpk_s(float lo,float hi){f32x2_t v={lo,hi};bf16x2_t b=__builtin_convertvector(v,bf16x2_t);return __builtin_bit_cast(unsigned,b);}
#define WAIT_BAR(N) asm volatile("s_waitcnt vmcnt(" #N ") lgkmcnt(0)\n\ts_barrier":::"memory")

__device__ __forceinline__ void qkt(f32x16&p0,f32x16&p1,const char*Kslot,const bf16x8*qr,const f32x16&negm,int r32,int hi){
  const char*kb=Kslot+hi*1024+r32*16;
  #pragma unroll
  for(int d0=0;d0<4;++d0){
    const bf16x8 b0=*reinterpret_cast<const bf16x8*>(kb+d0*2048);
    const bf16x8 b1=*reinterpret_cast<const bf16x8*>(kb+d0*2048+512);
    if(d0==0){p0=__builtin_amdgcn_mfma_f32_32x32x16_bf16(b0,qr[0],negm,0,0,0);p1=__builtin_amdgcn_mfma_f32_32x32x16_bf16(b1,qr[0],negm,0,0,0);}
    else{p0=__builtin_amdgcn_mfma_f32_32x32x16_bf16(b0,qr[d0],p0,0,0,0);p1=__builtin_amdgcn_mfma_f32_32x32x16_bf16(b1,qr[d0],p1,0,0,0);}}
}
typedef __attribute__((address_space(3))) const char* lds_cptr;
typedef short v4i16_t __attribute__((ext_vector_type(4)));
__device__ __forceinline__ void kload8(bf16x8*kf,lds_cptr kp){
  kf[0]=*(const __attribute__((address_space(3))) bf16x8*)(kp);      kf[1]=*(const __attribute__((address_space(3))) bf16x8*)(kp+512);
  kf[2]=*(const __attribute__((address_space(3))) bf16x8*)(kp+2048); kf[3]=*(const __attribute__((address_space(3))) bf16x8*)(kp+2560);
  kf[4]=*(const __attribute__((address_space(3))) bf16x8*)(kp+4096); kf[5]=*(const __attribute__((address_space(3))) bf16x8*)(kp+4608);
  kf[6]=*(const __attribute__((address_space(3))) bf16x8*)(kp+6144); kf[7]=*(const __attribute__((address_space(3))) bf16x8*)(kp+6656);
}
__device__ __forceinline__ void kload2(bf16x8*kf,lds_cptr kp,int j){ kf[2*j]=*(const __attribute__((address_space(3))) bf16x8*)(kp+j*2048); kf[2*j+1]=*(const __attribute__((address_space(3))) bf16x8*)(kp+j*2048+512); }
__device__ __forceinline__ s16x4 vtr(lds_cptr p){ return __builtin_bit_cast(s16x4,__builtin_amdgcn_ds_read_tr16_b64_v4i16((__attribute__((address_space(3))) v4i16_t*)p)); }
__device__ __forceinline__ float rowmax(const f32x16&p0,const f32x16&p1){
  float a=max3f(p0[0],p0[1],p1[0]),b=max3f(p0[2],p0[3],p1[1]);a=max3f(a,p1[2],p1[3]);
  #pragma unroll
  for(int r=4;r<16;r+=4){a=max3f(a,p0[r],p0[r+1]);b=max3f(b,p0[r+2],p0[r+3]);a=max3f(a,p1[r],p1[r+1]);b=max3f(b,p1[r+2],p1[r+3]);}
  const float m=max2f(a,b);
  auto rr=__builtin_amdgcn_permlane32_swap(__float_as_uint(m),__float_as_uint(m),false,false);
  return max2f(__uint_as_float(rr[0]),__uint_as_float(rr[1]));
}
__device__ __forceinline__ void pv(f32x16*o,int vb,bf16x8 pa0,bf16x8 pa1,bf16x8 pa2,bf16x8 pa3){
  #pragma unroll
  for(int d0=0;d0<2;++d0){s16x4 lo[4],hi[4];
    #pragma unroll
    for(int ks=0;ks<4;++ks){
      asm volatile("ds_read_b64_tr_b16 %0,%1 offset:%c2":"=&v"(lo[ks]):"v"(vb),"i"(d0*4096+ks*1024):"memory");
      asm volatile("ds_read_b64_tr_b16 %0,%1 offset:%c2":"=&v"(hi[ks]):"v"(vb),"i"(d0*4096+ks*1024+512):"memory");}
    asm volatile("s_waitcnt lgkmcnt(0)":::"memory");SBAR();
    #define PK(k) (bf16x8){lo[k][0],lo[k][1],lo[k][2],lo[k][3],hi[k][0],hi[k][1],hi[k][2],hi[k][3]}
    o[d0]=__builtin_amdgcn_mfma_f32_32x32x16_bf16(pa0,PK(0),o[d0],0,0,0);
    o[d0]=__builtin_amdgcn_mfma_f32_32x32x16_bf16(pa1,PK(1),o[d0],0,0,0);
    o[d0]=__builtin_amdgcn_mfma_f32_32x32x16_bf16(pa2,PK(2),o[d0],0,0,0);
    o[d0]=__builtin_amdgcn_mfma_f32_32x32x16_bf16(pa3,PK(3),o[d0],0,0,0);
    #undef PK
  }
}

template<int MODE,int THRL> __device__ __forceinline__ void attn_unit(const bf16*Qu,const bf16*__restrict__ Kh,const bf16*__restrict__ Vh,bf16*Ou,int PO,int NT,int wadd,int dq0,float sink2,char*shm){
  int tid=threadIdx.x; asm volatile("":"+v"(tid)); const int lane=tid&63,r32=lane&31,hi=lane>>5; const int wid=__builtin_amdgcn_readfirstlane(tid>>6);
  const bf16*Qw=Qu+(long)(wid*QBLK)*P;
  const unsigned lds0=(unsigned)(uintptr_t)shm;
  float*wsf=(float*)(shm+LDS_WS)+wid*64;
  const bf16*ksrc=Kh+(long)lane*P+wid*8;
  const bf16*vsrc=Vh+(long)(16*(wid&3)+(lane>>2))*P+(wid>>2)*32+(lane&3)*8;
  const unsigned kdst=lds0+LDS_K+wid*1024, vdst=lds0+LDS_V+wid*1024;
  #define TROW(t) ((long)(t)*KVBLK+((MODE==1&&(t)>=4)?(long)wadd:0l))
  #define DMA_K(t,slot) glds16(ksrc+TROW(t)*P,(unsigned)__builtin_amdgcn_readfirstlane(kdst+(slot)))
  #define DMA_V(t,slot) glds16(vsrc+TROW(t)*P,(unsigned)__builtin_amdgcn_readfirstlane(vdst+(slot)))
  const int vb0=(int)(lds0+LDS_V)+((lane>>4)&1)*32+(lane&3)*8+(4*hi+((lane&15)>>2))*64;
  const char*Kbase=shm+LDS_K; bf16x8 kf[8];
  const lds_cptr shm3=(lds_cptr)shm; const lds_cptr kp0=shm3+LDS_K+hi*1024+r32*16; const lds_cptr vp0=shm3+LDS_V+((lane>>4)&1)*32+(lane&3)*8+(4*hi+((lane&15)>>2))*64;
  DMA_K(0,0);DMA_V(0,0);DMA_K(1,SLOTB);
  bf16x8 qr[4];
  #pragma unroll
  for(int d0=0;d0<4;++d0)qr[d0]=*reinterpret_cast<const bf16x8*>(&Qw[(long)r32*P+d0*16+hi*8]);
  float mhat=0.f,l_reg=0.f;f32x16 o[2];o[0]=f32x16{};o[1]=f32x16{};f32x16 negm=f32x16{};asm volatile("":"+v"(negm));
  const int qrel=wid*QBLK+r32;
  const int dlane=dq0-qrel+4*hi;
  #define CMASK(P0,P1,t) do{ if(MODE==1){ if((t)>=4) wmask(P0,P1,dlane+64*((t)-4)); } }while(0)
  bool resc=false;
  #define START(P0,P1) do{ const float rm=rowmax(P0,P1); resc=false; \
    { const float dl=rm; mhat=fadd_s(mhat,dl); \
      _Pragma("unroll") for(int r=0;r<16;++r){P0[r]=fsub_s(P0[r],dl);P1[r]=fsub_s(P1[r],dl);} \
      _Pragma("unroll") for(int r=0;r<16;++r)negm[r]=-mhat; asm volatile("":"+v"(negm)); } \
    _Pragma("unroll") for(int r=0;r<16;++r)P0[r]=__builtin_amdgcn_exp2f(P0[r]); }while(0)
  #define RESC() do{ if(resc){ asm volatile("s_waitcnt lgkmcnt(0)":::"memory"); \
      _Pragma("unroll") for(int d_=0;d_<2;++d_) _Pragma("unroll") for(int r=0;r<16;++r)o[d_][r]*=wsf[crow(r,hi)]; } }while(0)
  f32x16 pA0,pA1,pB0,pB1;
  int sl_prev=0,sl_cur=0,sl_next=SLOTB;
  #define ROT() do{sl_prev=sl_cur;sl_cur=sl_next;sl_next=(sl_next==(NSLOT-1)*SLOTB)?0:sl_next+SLOTB;}while(0)
  DMA_K(2,2*SLOTB);
  WAIT_BAR(3);
  qkt(pA0,pA1,Kbase,qr,negm,r32,hi);asm volatile("s_nop 15\n\ts_nop 7":"+v"(pA0),"+v"(pA1));
  START(pA0,pA1);
  _Pragma("unroll") for(int r=0;r<16;++r)pA1[r]=__builtin_amdgcn_exp2f(pA1[r]);
  WAIT_BAR(0);
  DMA_K(3,0);DMA_V(1,SLOTB);
  ROT();
  kload8(kf,kp0+sl_cur);
  WAIT_BAR(2);
  s16x4 vlo[8],vhi[8]; u32x4 pw0,pw1,pw2,pw3;
  #define PKW(P,B) cvtpk_s(P[B],P[B+1])
  #define PAF(k) __builtin_bit_cast(bf16x8,pw##k)
  #define VFR(i) (bf16x8){vlo[i][0],vlo[i][1],vlo[i][2],vlo[i][3],vhi[i][0],vhi[i][1],vhi[i][2],vhi[i][3]}
  #define PIN(x) asm volatile("":"+v"(x))
  #define MX3(a,b,c) __builtin_fmaxf(__builtin_fmaxf((a),(b)),(c))
  #define GAPA(MF,A0,A1,A2,A3,W0,W1,PW) do{ MF; sacc+=A0; sacc+=A1; sacc+=A2; sacc+=A3; PIN(sacc); W0; W1; PIN(PW); SBAR(); }while(0)
  #define EX(v) __builtin_amdgcn_exp2f(v)
  #define GAPB(MF,X,B) do{ MF; X[B]=EX(X[B]); X[B+1]=EX(X[B+1]); X[B+2]=EX(X[B+2]); X[B+3]=EX(X[B+3]); PIN(X); SBAR(); }while(0)
  #define VRD(i) do{ vlo[i]=vtr(vp_+(((i)>>2)*4096+((i)&3)*1024)); vhi[i]=vtr(vp_+(((i)>>2)*4096+((i)&3)*1024+512)); }while(0)
  #define KRD(G,j) do{ if(G){ kload2(kf,kp0+sl_next,j); SBAR(); } }while(0)
  #define STEP(C0,C1,P0,P1,t,GK,GV,GL) do{ SBAR(); \
    const lds_cptr vp_=vp0+sl_prev; \
    VRD(0); SBAR(); float sacc=(P0[0]+P0[1]); \
    GAPA(C0=__builtin_amdgcn_mfma_f32_32x32x16_bf16(kf[0],qr[0],negm,0,0,0), P0[2],P0[3],P0[4],P0[5],     pw0[0]=PKW(P0,0), pw0[1]=PKW(P0,2), pw0); \
    VRD(4); SBAR(); GAPA(C1=__builtin_amdgcn_mfma_f32_32x32x16_bf16(kf[1],qr[0],negm,0,0,0), P0[6],P0[7],P0[8],P0[9],     pw0[2]=PKW(P0,4), pw0[3]=PKW(P0,6), pw0); \
    VRD(1); SBAR(); GAPA(C0=__builtin_amdgcn_mfma_f32_32x32x16_bf16(kf[2],qr[1],C0,0,0,0),   P0[10],P0[11],P0[12],P0[13], pw1[0]=PKW(P0,8), pw1[1]=PKW(P0,10), pw1); \
    VRD(5); SBAR(); GAPA(C1=__builtin_amdgcn_mfma_f32_32x32x16_bf16(kf[3],qr[1],C1,0,0,0),   P0[14],P0[15],P1[0],P1[1],   pw1[2]=PKW(P0,12),pw1[3]=PKW(P0,14), pw1); \
    VRD(2); SBAR(); GAPA(C0=__builtin_amdgcn_mfma_f32_32x32x16_bf16(kf[4],qr[2],C0,0,0,0),   P1[2],P1[3],P1[4],P1[5],     pw2[0]=PKW(P1,0), pw2[1]=PKW(P1,2), pw2); \
    VRD(6); SBAR(); GAPA(C1=__builtin_amdgcn_mfma_f32_32x32x16_bf16(kf[5],qr[2],C1,0,0,0),   P1[6],P1[7],P1[8],P1[9],     pw2[2]=PKW(P1,4), pw2[3]=PKW(P1,6), pw2); \
    VRD(3); SBAR(); GAPA(C0=__builtin_amdgcn_mfma_f32_32x32x16_bf16(kf[6],qr[3],C0,0,0,0),   P1[10],P1[11],P1[12],P1[13], pw3[0]=PKW(P1,8), pw3[1]=PKW(P1,10), pw3); \
    VRD(7); SBAR(); GAPA(C1=__builtin_amdgcn_mfma_f32_32x32x16_bf16(kf[7],qr[3],C1,0,0,0),   P1[14],P1[15],0.f,0.f,       pw3[2]=PKW(P1,12),pw3[3]=PKW(P1,14), pw3); \
    l_reg+=sacc; \
    if(GK){DMA_K((t)+3,sl_cur);} if(GV){DMA_V((t)+1,sl_next);} \
    CMASK(C0,C1,t); \
    { float a=MX3(C0[0],C0[1],C1[0]),b=MX3(C0[2],C0[3],C1[1]); a=MX3(a,C1[2],C1[3]); \
      _Pragma("unroll") for(int r=4;r<16;r+=4){a=MX3(a,C0[r],C0[r+1]);b=MX3(b,C0[r+2],C0[r+3]);a=MX3(a,C1[r],C1[r+1]);b=MX3(b,C1[r+2],C1[r+3]);} \
      float rm=__builtin_fmaxf(a,b); { auto rr=__builtin_amdgcn_permlane32_swap(__float_as_uint(rm),__float_as_uint(rm),false,false); rm=__builtin_fmaxf(__uint_as_float(rr[0]),__uint_as_float(rr[1])); } \
      resc=false; \
      if(__builtin_expect(__any(rm>(float)THRL),0)){ const float dl=__builtin_fmaxf(rm,0.f); mhat+=dl; \
        _Pragma("unroll") for(int r=0;r<16;++r){C0[r]-=dl;C1[r]-=dl;} \
        _Pragma("unroll") for(int r=0;r<16;++r)negm[r]=-mhat; asm volatile("":"+v"(negm)); \
        const float f=__builtin_amdgcn_exp2f(-dl); l_reg*=f; if(hi==0)wsf[r32]=f; resc=true; } } \
    SBAR(); \
    GAPB(o[0]=__builtin_amdgcn_mfma_f32_32x32x16_bf16(PAF(0),VFR(0),o[0],0,0,0), C0,0); \
    GAPB(o[1]=__builtin_amdgcn_mfma_f32_32x32x16_bf16(PAF(0),VFR(4),o[1],0,0,0), C0,4); \
    KRD(GL,0); GAPB(o[0]=__builtin_amdgcn_mfma_f32_32x32x16_bf16(PAF(1),VFR(1),o[0],0,0,0), C0,8); \
    KRD(GL,1); GAPB(o[1]=__builtin_amdgcn_mfma_f32_32x32x16_bf16(PAF(1),VFR(5),o[1],0,0,0), C0,12); \
    KRD(GL,2); GAPB(o[0]=__builtin_amdgcn_mfma_f32_32x32x16_bf16(PAF(2),VFR(2),o[0],0,0,0), C1,0); \
    KRD(GL,3); GAPB(o[1]=__builtin_amdgcn_mfma_f32_32x32x16_bf16(PAF(2),VFR(6),o[1],0,0,0), C1,4); \
    GAPB(o[0]=__builtin_amdgcn_mfma_f32_32x32x16_bf16(PAF(3),VFR(3),o[0],0,0,0), C1,8); \
    GAPB(o[1]=__builtin_amdgcn_mfma_f32_32x32x16_bf16(PAF(3),VFR(7),o[1],0,0,0), C1,12); \
    }while(0)
  int t=1;
  if(MODE==0){
    for(;t+5<NT;t+=2){
      STEP(pB0,pB1,pA0,pA1,t,true,true,true);     WAIT_BAR(2); RESC(); ROT();
      STEP(pA0,pA1,pB0,pB1,t+1,true,true,true);   WAIT_BAR(2); RESC(); ROT();
    }
  }
  #define ENDW(tt) do{ if((tt)+3<NT){WAIT_BAR(2);} else if((tt)+2<NT){WAIT_BAR(1);} else {WAIT_BAR(0);} }while(0)
  for(;t+1<NT;t+=2){
    STEP(pB0,pB1,pA0,pA1,t,(t+3<NT),(t+1<NT),(t+1<NT));       ENDW(t);   RESC(); ROT();
    STEP(pA0,pA1,pB0,pB1,t+1,(t+4<NT),(t+2<NT),(t+2<NT));     ENDW(t+1); RESC(); ROT();
  }
  STEP(pB0,pB1,pA0,pA1,NT-1,false,false,false); RESC();
  { float sacc=pB0[0]+pB0[1]; _Pragma("unroll") for(int r=2;r<16;++r)sacc+=pB0[r]; _Pragma("unroll") for(int r=0;r<16;++r)sacc+=pB1[r]; l_reg+=sacc;
    pw0=(u32x4){PKW(pB0,0),PKW(pB0,2),PKW(pB0,4),PKW(pB0,6)};pw1=(u32x4){PKW(pB0,8),PKW(pB0,10),PKW(pB0,12),PKW(pB0,14)};pw2=(u32x4){PKW(pB1,0),PKW(pB1,2),PKW(pB1,4),PKW(pB1,6)};pw3=(u32x4){PKW(pB1,8),PKW(pB1,10),PKW(pB1,12),PKW(pB1,14)};
    SBAR(); pv(o,vb0+sl_cur,PAF(0),PAF(1),PAF(2),PAF(3)); }
  #undef PKW
  #undef PAF
  #undef VFR
  #undef PIN
  #undef MX3
  #undef GAPA
  #undef GAPB
  #undef EX
  #undef VRD
  #undef KRD
  #undef STEP
  #undef ENDW
  {auto rr=__builtin_amdgcn_permlane32_swap(__float_as_uint(l_reg),__float_as_uint(l_reg),false,false);l_reg=__uint_as_float(rr[0])+__uint_as_float(rr[1]);}
  l_reg+=__builtin_amdgcn_exp2f(sink2-mhat);
  if(hi==0)wsf[32+r32]=l_reg;asm volatile("s_waitcnt lgkmcnt(0)":::"memory");
  float rli[16];
  #pragma unroll
  for(int r=0;r<16;++r)rli[r]=__builtin_amdgcn_rcpf(wsf[32+crow(r,hi)]);
  bf16*Ow=Ou+(long)(wid*QBLK)*PO;
  { bf16*stg=(bf16*)(shm+LDS_OST)+wid*2048;
    #pragma unroll
    for(int r=0;r<16;++r){const int orow=crow(r,hi);
      #pragma unroll
      for(int d0=0;d0<2;++d0)stg[orow*64+d0*32+r32]=__float2bfloat16(o[d0][r]*rli[r]);}
    asm volatile("s_waitcnt lgkmcnt(0)":::"memory");
    #pragma unroll
    for(int i=0;i<4;++i){const int row=i*8+(lane>>3),ch=lane&7; const u32x4 v=*(const u32x4*)(stg+row*64+ch*8); *(u32x4*)(Ow+(long)row*PO+ch*8)=v;} }
  asm volatile("s_waitcnt lgkmcnt(0)\n\ts_barrier":::"memory");
  #undef DMA_K
  #undef DMA_V
  #undef TROW
  #undef CMASK
  #undef START
  #undef RESC
  #undef ROT
}
constexpr int ATTN_LDS_BYTES=LDS_BYTES;
#undef SBAR
#undef WAIT_BAR
}
constexpr int NWAVES = 8;
constexpr int NB = 8, SEQ = 8192, TCTX = 256, RB = SEQ + TCTX  , R = NB * RB  ;
constexpr int D = 1024, NL = 4, NPAN = R / 256  , QKVW = 3072;
constexpr int NE = 128, TOPK = 8, CAP = R  , MAXTILES = 2240, MAXSLOTS = MAXTILES * 256;
constexpr float EPS = 1e-6f, LOG2E = 1.4426950408889634f;
constexpr int PH_PER_LAYER = 13, NPH = 2 + NL * PH_PER_LAYER;
enum { I_X = 0, I_C, I_CTX, I_CCTX, I_WMOD, I_BMOD, I_G1, I_WQKV, I_GQA, I_GKA, I_SINK, I_LQ1, I_LK1, I_LQ2, I_LK2, I_GSUB, I_WBRA, I_WBRB, I_WBRC, I_WGATE, I_BGATE, I_WOUT, I_G2, I_WR, I_EBIAS,
       I_W1, I_W3, I_W2, I_WS1, I_WS3, I_WS2, I_GF, N_IN };

constexpr size_t MiB = 1u << 20;
constexpr size_t WS_CTL = 0, CTL_ZERO_BYTES = 1 * MiB;
constexpr size_t WS_MOD = 1 * MiB;
constexpr size_t WS_LAYP = WS_MOD + 960 * 1024;
constexpr size_t WS_ROPE = 2 * MiB;
constexpr size_t WS_WSM = 4 * MiB, WSM_LAYER = 19 * MiB;
constexpr size_t WL_QKV = 0, WL_GATE = 6 * MiB, WL_BR = 12 * MiB, WL_OUT = 15 * MiB, WL_R = 17 * MiB, WL_S13 = 17 * MiB + 512 * 1024, WL_S2 = 18 * MiB + 512 * 1024;
constexpr size_t WS_E13 = 80 * MiB;
constexpr size_t WS_E2 = 208 * MiB;
constexpr size_t WS_XC = 272 * MiB;
constexpr size_t WS_A = 280 * MiB;
constexpr size_t WS_HS = 412 * MiB;
constexpr size_t WS_HR = 445 * MiB;
constexpr size_t WS_LIST = 725 * MiB;
constexpr size_t WS_EP = 758 * MiB;
constexpr size_t WS_WT = 761 * MiB;
constexpr size_t WS_LOG = 764 * MiB;
constexpr size_t WS_DBG = 797 * MiB;
constexpr size_t WS_YR = 800 * MiB;
constexpr size_t WS_QKV = 800 * MiB;
constexpr size_t WS_YA = 1196 * MiB, WS_YB = 1262 * MiB, WS_YC = 1328 * MiB;
constexpr size_t WS_OC = 1394 * MiB;
constexpr size_t WS_MG = 1526 * MiB;
constexpr size_t WS_WR2 = 1920 * MiB, WR2_LAYER = 1536 * 1024;
constexpr size_t WS_END = 1926 * MiB;
static_assert(WS_YR + (size_t)MAXSLOTS * 2048 <= WS_END && WS_MG + (size_t)R * 2048 <= WS_END && WS_HR + (size_t)MAXSLOTS * 512 <= WS_LIST && WS_A + (size_t)R * 2048 <= WS_HS, "d_ws map");
constexpr int CW_BAR = 4096;
constexpr int CW_CNT = 16384;
constexpr int CW_ERR = 20480;

constexpr int RING_OFF = 0, RING_BYTES = 131072;
constexpr int LDSCTL_OFF = RING_BYTES, MISC_OFF = LDSCTL_OFF + 320;
constexpr int MOE_OFF = LDSCTL_OFF + 512;
constexpr int LDS_BYTES = 147456;
static_assert(MOE_OFF + 132 * 4 + 128 * 4 + MAXTILES * 2 <= LDS_BYTES && attn_body::ATTN_LDS_BYTES <= RING_BYTES, "LDS map");

#define GAS __attribute__((address_space(1)))
#define LAS __attribute__((address_space(3)))
typedef unsigned short bf16;
typedef unsigned v4u __attribute__((ext_vector_type(4)));
typedef unsigned v2u __attribute__((ext_vector_type(2)));
typedef float f32x4 __attribute__((ext_vector_type(4)));
typedef float f32x2 __attribute__((ext_vector_type(2)));
typedef GAS unsigned gu32;
#define RLX_AGENT __ATOMIC_RELAXED, __HIP_MEMORY_SCOPE_AGENT
#define LDS_WAIT() asm volatile("s_waitcnt lgkmcnt(0)" ::: "memory")
#define VM_WAIT() asm volatile("s_waitcnt vmcnt(0)" ::: "memory")
__device__ __forceinline__ unsigned f2bf(float f) { unsigned u = __builtin_bit_cast(unsigned, f); return (u + 0x7fffu + ((u >> 16) & 1u)) >> 16; }
__device__ __forceinline__ unsigned pk2(float lo, float hi) { return f2bf(lo) | (f2bf(hi) << 16); }
__device__ __forceinline__ float bflo(unsigned w) { return __builtin_bit_cast(float, w << 16); }
__device__ __forceinline__ float bfhi(unsigned w) { return __builtin_bit_cast(float, w & 0xffff0000u); }

#define XB_TMO      128
#define XB_XCNT(j)  (256  + 64 * (j))
#define XB_XSUB(j)  (1280 + 64 * (j))
#define XB_XGEN(j)  (2304 + 64 * (j))
#define XB_TOP      3328
#define XB_TOPGEN   3392
#define XCD_BAR_WORDS 3456
#define XB_SPIN_CAP (1u << 22)

__device__ __forceinline__ unsigned xb_ld(unsigned* p)              { return __hip_atomic_load(p, __ATOMIC_RELAXED, __HIP_MEMORY_SCOPE_AGENT); }
__device__ __forceinline__ unsigned xb_add(unsigned* p, unsigned v) { return __hip_atomic_fetch_add(p, v, __ATOMIC_RELAXED, __HIP_MEMORY_SCOPE_AGENT); }
__device__ __forceinline__ unsigned xb_xcc_id() { return (unsigned)__builtin_amdgcn_s_getreg((3 << 11) | 20) & 0xFu; }
#define XB_SPIN(cond, bar) do { unsigned _sp = 0; while (cond) { __builtin_amdgcn_s_sleep(1); \
    if ((++_sp & 255u) == 0u) { if (xb_ld(&(bar)[XB_TMO])) break; if (_sp > XB_SPIN_CAP) { atomicAdd(&(bar)[XB_TMO], 1u); break; } } } } while (0)

struct XcdBarrier {
    unsigned* bar; unsigned x;
    volatile LAS unsigned* st;
};
__device__ __forceinline__ XcdBarrier xcd_barrier_post(unsigned* bar, volatile LAS unsigned* st) {
    XcdBarrier b; b.bar = bar; b.x = xb_xcc_id(); b.st = st;
    if (threadIdx.x == 0) (void)xb_add(&bar[XB_XCNT(b.x)], 1u);
    return b;
}
__device__ __forceinline__ void xcd_barrier_complete(unsigned* bar, unsigned x, unsigned& nloc, unsigned& nx) {
    const unsigned G = gridDim.x * gridDim.y * gridDim.z;
    unsigned sum, cnt, mine, sp = 0u;
    for (;;) {
        sum = 0u; cnt = 0u; mine = 0u;
#pragma unroll
        for (unsigned j = 0; j < 16; ++j) { const unsigned c = xb_ld(&bar[XB_XCNT(j)]); sum += c; cnt += (c > 0u) ? 1u : 0u; mine = (j == x) ? c : mine; }
        if (sum == G) break;
        __builtin_amdgcn_s_sleep(1);
        if ((++sp & 255u) == 0u) { if (xb_ld(&bar[XB_TMO])) break; if (sp > XB_SPIN_CAP) { atomicAdd(&bar[XB_TMO], 1u); break; } }
    }
    nloc = mine > 0u ? mine : 1u; nx = cnt > 0u ? cnt : 1u;
}
__device__ __forceinline__ void xcd_barrier(const XcdBarrier& b) {
    asm volatile("s_waitcnt vmcnt(0)" ::: "memory");
    __syncthreads();
    if (threadIdx.x == 0) {
        unsigned* bar = b.bar;
        __builtin_amdgcn_s_waitcnt(0);
        unsigned nloc = b.st[0], nx = b.st[1];
        if (nloc == 0u) { xcd_barrier_complete(bar, b.x, nloc, nx); b.st[0] = nloc; b.st[1] = nx; }
        const unsigned old = xb_add(&bar[XB_XSUB(b.x)], 1u);
        const unsigned gen = old / nloc;
        if (old + 1u == (gen + 1u) * nloc) {
            __builtin_amdgcn_fence(__ATOMIC_RELEASE, "agent");
            asm volatile("s_waitcnt vmcnt(0)" ::: "memory");
            const unsigned og = xb_add(&bar[XB_TOP], 1u);
            const unsigned tg = og / nx;
            if (og + 1u == (tg + 1u) * nx) xb_add(&bar[XB_TOPGEN], 1u);
            else XB_SPIN(xb_ld(&bar[XB_TOPGEN]) == tg, bar);
            __builtin_amdgcn_fence(__ATOMIC_ACQUIRE, "agent");
            xb_add(&bar[XB_XGEN(b.x)], 1u);
            asm volatile("s_waitcnt vmcnt(0)" ::: "memory");
        } else {
            XB_SPIN(xb_ld(&bar[XB_XGEN(b.x)]) == gen, bar);
            __builtin_amdgcn_fence(__ATOMIC_ACQUIRE, "agent");
            asm volatile("s_waitcnt vmcnt(0)" ::: "memory");
        }
    }
    __syncthreads();
}

struct Args { const float* in[N_IN]; float* out; unsigned char* ws; int ph_lo, ph_hi; };
typedef const __attribute__((address_space(4))) Args* KArgs;

__device__ __forceinline__ float wave_sum(float v) {
#pragma unroll
    for (int o = 1; o < 64; o <<= 1) v += __shfl_xor(v, o);
    return v;
}
__device__ __forceinline__ float wave_max(float v) {
#pragma unroll
    for (int o = 1; o < 64; o <<= 1) v = fmaxf(v, __shfl_xor(v, o));
    return v;
}
__device__ __forceinline__ float* xrow_ptr(float* XL, float* XC, int r) { const int b = r / RB, j = r - b * RB; return (j < TCTX) ? XC + ((size_t)b * TCTX + j) * D : XL + ((size_t)b * SEQ + (j - TCTX)) * D; }

__device__ __forceinline__ void tr_block(const float* W, int ldw, int k0, int n0, bf16* WT, int ldt, int drow0, LAS float* scr, int lane) {
#pragma unroll 8
    for (int i = 0; i < 32; ++i) { const int kk = 2 * i + (lane >> 5); scr[kk * 33 + (lane & 31)] = W[(size_t)(k0 + kk) * ldw + n0 + (lane & 31)]; }
    LDS_WAIT(); asm volatile("" ::: "memory");
    const int c = lane & 7;
#pragma unroll
    for (int j = 0; j < 4; ++j) { const int n = (lane >> 3) + 8 * j; const LAS float* s = scr + (8 * c) * 33 + n;
        v4u o; o.x = pk2(s[0 * 33], s[1 * 33]); o.y = pk2(s[2 * 33], s[3 * 33]); o.z = pk2(s[4 * 33], s[5 * 33]); o.w = pk2(s[6 * 33], s[7 * 33]);
        *(GAS v4u*)(WT + (size_t)(drow0 + n) * ldt + k0 + 8 * c) = o; }
    LDS_WAIT(); asm volatile("" ::: "memory");
}

__device__ __forceinline__ void tr_block_split(const float* W, int ldw, int k0, int n0, bf16* WT, LAS float* scr, int lane) {
#pragma unroll 8
    for (int i = 0; i < 32; ++i) { const int kk = 2 * i + (lane >> 5); scr[kk * 33 + (lane & 31)] = W[(size_t)(k0 + kk) * ldw + n0 + (lane & 31)]; }
    LDS_WAIT(); asm volatile("" ::: "memory");
    const int c = lane & 7;
#pragma unroll
    for (int j = 0; j < 4; ++j) { const int n = (lane >> 3) + 8 * j; const LAS float* s = scr + (8 * c) * 33 + n;
        float w[8], lo[8];
#pragma unroll
        for (int q = 0; q < 8; ++q) { w[q] = s[q * 33]; lo[q] = w[q] - __builtin_bit_cast(float, f2bf(w[q]) << 16); }
        const v4u oh = (v4u){pk2(w[0], w[1]), pk2(w[2], w[3]), pk2(w[4], w[5]), pk2(w[6], w[7])}, ol = (v4u){pk2(lo[0], lo[1]), pk2(lo[2], lo[3]), pk2(lo[4], lo[5]), pk2(lo[6], lo[7])};
        bf16* row = WT + (size_t)(n0 + n) * 3072 + k0 + 8 * c;
        *(GAS v4u*)(row) = oh; *(GAS v4u*)(row + 1024) = ol; *(GAS v4u*)(row + 2048) = oh; }
    LDS_WAIT(); asm volatile("" ::: "memory");
}
template <int MAP> __device__ __forceinline__ void tr_item(const float* W, int K, int N, bf16* WT, int row_off, int item, LAS float* scr, int lane) {
    const int nblk = N / 32, kb = item / nblk, nb = item - kb * nblk, k0 = 64 * kb, n0 = 32 * nb;
    const int drow0 = (MAP == 0) ? row_off + n0 : (n0 >> 7) * 256 + (n0 & 127) + row_off;
    tr_block(W, N, k0, n0, WT, K, drow0, scr, lane);
}

#define PHASE_IDS() int tid_ = threadIdx.x; asm volatile("" : "+v"(tid_)); const int lane = tid_ & 63, wave = __builtin_amdgcn_readfirstlane(tid_ >> 6); const int G = gridDim.x, bx = blockIdx.x; \
    const int vcu = (G % 8 == 0) ? (bx % 8) * (G / 8) + bx / 8 : bx; const int gw = vcu * NWAVES + wave, NGW = G * NWAVES; (void)lane; (void)wave; (void)gw; (void)NGW; (void)vcu
__device__ __forceinline__ void phase_prologue(KArgs a, LAS unsigned char* lds) {
    PHASE_IDS();
    unsigned char* ws = a->ws;
    LAS float* scr = (LAS float*)(lds + RING_OFF + wave * 16384);
    constexpr int I_QKV = 16 * 96, I_GATE = 16 * 96, I_BR = 8 * 32, I_OUT = 16 * 32, I_R = 16 * 4, I_S1 = 16 * 8, I_S2 = 4 * 32;
    constexpr int PER_L = I_QKV + I_GATE + 3 * I_BR + I_OUT + I_R + 2 * I_S1 + I_S2;
    for (int it = gw; it < NL * PER_L; it += NGW) {
        const int l = it / PER_L; int r = it - l * PER_L; unsigned char* wl = ws + WS_WSM + (size_t)l * WSM_LAYER;
        if (r < I_QKV) { tr_item<0>(a->in[I_WQKV] + (size_t)l * D * QKVW, D, QKVW, (bf16*)(wl + WL_QKV), 0, r, scr, lane); continue; } r -= I_QKV;
        if (r < I_GATE) { tr_item<0>(a->in[I_WGATE] + (size_t)l * D * 3072, D, 3072, (bf16*)(wl + WL_GATE), 0, r, scr, lane); continue; } r -= I_GATE;
        if (r < I_BR) { tr_item<0>(a->in[I_WBRA] + (size_t)l * 512 * D, 512, D, (bf16*)(wl + WL_BR), 0, r, scr, lane); continue; } r -= I_BR;
        if (r < I_BR) { tr_item<0>(a->in[I_WBRB] + (size_t)l * 512 * D, 512, D, (bf16*)(wl + WL_BR + 1 * MiB), 0, r, scr, lane); continue; } r -= I_BR;
        if (r < I_BR) { tr_item<0>(a->in[I_WBRC] + (size_t)l * 512 * D, 512, D, (bf16*)(wl + WL_BR + 2 * MiB), 0, r, scr, lane); continue; } r -= I_BR;
        if (r < I_OUT) { tr_item<0>(a->in[I_WOUT] + (size_t)l * D * D, D, D, (bf16*)(wl + WL_OUT), 0, r, scr, lane); continue; } r -= I_OUT;
        if (r < I_R) { const int kb = r / 4, nb = r - kb * 4; tr_block_split(a->in[I_WR] + (size_t)l * D * NE, NE, 64 * kb, 32 * nb, (bf16*)(ws + WS_WR2 + (size_t)l * WR2_LAYER), scr, lane); continue; } r -= I_R;
        if (r < I_S1) { tr_item<1>(a->in[I_WS1] + (size_t)l * D * 256, D, 256, (bf16*)(wl + WL_S13), 0, r, scr, lane); continue; } r -= I_S1;
        if (r < I_S1) { tr_item<1>(a->in[I_WS3] + (size_t)l * D * 256, D, 256, (bf16*)(wl + WL_S13), 128, r, scr, lane); continue; } r -= I_S1;
        tr_item<0>(a->in[I_WS2] + (size_t)l * 256 * D, 256, D, (bf16*)(wl + WL_S2), 0, r, scr, lane);
    }
    for (int it = gw; it < NL * 128; it += NGW) { const int l = it >> 7, row = 128 + (it & 127); GAS v4u* p = (GAS v4u*)(ws + WS_WR2 + (size_t)l * WR2_LAYER + (size_t)row * 6144);
#pragma unroll
        for (int q = 0; q < 6; ++q) p[64 * q + lane] = (v4u){0u, 0u, 0u, 0u}; }
    { f32x2* rope = (f32x2*)(ws + WS_ROPE);
      for (int i = gw * 64 + lane; i < SEQ * 32; i += NGW * 64) { const int t = i >> 5, ax = (i >> 4) & 1, f = i & 15;
          const float pos = (float)(ax == 0 ? (t >> 6) : (t & 63)); const float invf = powf(10000.0f, -(float)f / 16.0f); const float ang = pos * invf;
          rope[i] = (f32x2){(float)cos((double)ang), (float)sin((double)ang)}; } }
    if (gw == 0 && lane < NL) { const int l = lane; float d1 = 0.f, d2 = 0.f;
        for (int i = 0; i < 64; ++i) { d1 += a->in[I_LQ1][l * 64 + i] * a->in[I_LK1][l * 64 + i]; d2 += a->in[I_LQ2][l * 64 + i] * a->in[I_LK2][l * 64 + i]; }
        const float li = 0.8f - 0.6f * expf(-0.3f * (float)l); float* lp = (float*)(ws + WS_LAYP) + l * 4;
        lp[0] = expf(d1) - expf(d2) + li; lp[1] = li; lp[2] = 1.0f - li; lp[3] = 0.f; }
    { const GAS f32x4* s = (const GAS f32x4*)a->in[I_X]; GAS f32x4* d = (GAS f32x4*)a->out; const size_t n4 = (size_t)NB * SEQ * D / 4;
      for (size_t i = (size_t)gw * 64 + lane; i < n4; i += (size_t)NGW * 64) d[i] = s[i];
      const GAS f32x4* s2 = (const GAS f32x4*)a->in[I_CTX]; GAS f32x4* d2 = (GAS f32x4*)(ws + WS_XC); const size_t m4 = (size_t)NB * TCTX * D / 4;
      for (size_t i = (size_t)gw * 64 + lane; i < m4; i += (size_t)NGW * 64) d2[i] = s2[i]; }
    __syncthreads();
    { LAS float* red = (LAS float*)(lds + RING_OFF);
      float* MOD = (float*)(ws + WS_MOD);
      for (int item = blockIdx.x; item < NL * 96; item += gridDim.x) {
          const int l = item / 96, n0 = (item - l * 96) * 64;
          float acc[9];
#pragma unroll
          for (int m = 0; m < 9; ++m) acc[m] = 0.f;
          const float* wm = a->in[I_WMOD] + (size_t)l * D * 6144 + n0 + lane;
          for (int k = wave * 128; k < wave * 128 + 128; ++k) { const float w = wm[(size_t)k * 6144];
#pragma unroll
              for (int m = 0; m < 9; ++m) { const float cv = (m < 8) ? a->in[I_C][m * D + k] : a->in[I_CCTX][k]; const float s = cv / (1.0f + expf(-cv)); acc[m] += s * w; } }
#pragma unroll
          for (int m = 0; m < 9; ++m) red[(wave * 9 + m) * 64 + lane] = acc[m];
          __syncthreads();
          for (int idx = threadIdx.x; idx < 9 * 64; idx += NWAVES * 64) { const int m = idx >> 6, ln = idx & 63; float s = 0.f;
#pragma unroll
              for (int w = 0; w < 8; ++w) s += red[(w * 9 + m) * 64 + ln];
              MOD[((size_t)l * 9 + m) * 6144 + n0 + ln] = s + a->in[I_BMOD][l * 6144 + n0 + ln]; }
          __syncthreads();
      } }
}

__device__ __forceinline__ void moe_tables(LAS unsigned char* lds, const unsigned* cnt, bool want_te) {
    LAS int* tb = (LAS int*)(lds + MOE_OFF); LAS int* cn = tb + 132; LAS unsigned short* te = (LAS unsigned short*)(cn + 128);
    int tid = threadIdx.x; asm volatile("" : "+v"(tid));
    __syncthreads();
    if (tid < NE) cn[tid] = (int)__hip_atomic_load(cnt + tid, RLX_AGENT);
    __syncthreads();
    if (tid == 0) { int s = 0; for (int e = 0; e < NE; ++e) { tb[e] = s; s += (cn[e] + 255) >> 8; } tb[NE] = s; }
    __syncthreads();
    if (want_te && tid < NE) { const int t0 = tb[tid], t1 = tb[tid + 1]; for (int t = t0; t < t1; ++t) te[t] = (unsigned short)tid; }
    __syncthreads();
}

template <int KIND> __device__ __forceinline__ void phase_norm(KArgs a, LAS unsigned char* lds, int l) {
    PHASE_IDS();
    unsigned char* ws = a->ws; float* XL = a->out; float* XC = (float*)(ws + WS_XC);
    const float* MOD = (const float*)(ws + WS_MOD);
    const bool comb = (KIND == 2) || (KIND == 0 && l > 0); const int lc = (KIND == 2) ? NL - 1 : l - 1;
    if (comb) moe_tables(lds, (const unsigned*)(ws + WS_CTL) + CW_CNT + lc * NE, false);
    const LAS int* tb = (const LAS int*)(lds + MOE_OFF);
    const bf16* YR = (const bf16*)(ws + WS_YR); const int* EP = (const int*)(ws + WS_EP); const float* WT = (const float*)(ws + WS_WT);
    bf16* A = (bf16*)(ws + WS_A);
    const float* gvec = (KIND == 0) ? a->in[I_G1] + l * D : (KIND == 1) ? a->in[I_G2] + l * D : a->in[I_GF];
    for (int r = gw; r < R; r += NGW) {
        const int b = r / RB, j = r - b * RB, mb = (j < TCTX) ? 8 : b;
        if (KIND == 2 && j < TCTX) continue;
        float* xr = xrow_ptr(XL, XC, r);
        f32x4 v[4];
#pragma unroll
        for (int q = 0; q < 4; ++q) v[q] = ((const GAS f32x4*)xr)[lane + 64 * q];
        if (comb) {
            int slot = 0; float w = 0.f;
            if (lane < TOPK) { const int ep = EP[(size_t)r * 8 + lane]; slot = tb[ep >> 17] * 256 + (ep & 0x1ffff); w = WT[(size_t)r * 8 + lane]; }
            f32x4 acc[4];
#pragma unroll
            for (int q = 0; q < 4; ++q) acc[q] = (f32x4){0.f, 0.f, 0.f, 0.f};
#pragma unroll
            for (int k = 0; k < TOPK; ++k) { const int sk = __shfl(slot, k); const float wk = __shfl(w, k); const GAS v2u* yr = (const GAS v2u*)(YR + (size_t)sk * D);
#pragma unroll
                for (int q = 0; q < 4; ++q) { const v2u u = yr[lane + 64 * q]; acc[q] += wk * (f32x4){bflo(u.x), bfhi(u.x), bflo(u.y), bfhi(u.y)}; } }
            const float* g2 = MOD + ((size_t)lc * 9 + mb) * 6144 + 5 * D;
#pragma unroll
            for (int q = 0; q < 4; ++q) { const f32x4 g = ((const GAS f32x4*)g2)[lane + 64 * q]; v[q] += g * acc[q]; if (KIND != 2) ((GAS f32x4*)xr)[lane + 64 * q] = v[q]; }
        }
        float s = 0.f;
#pragma unroll
        for (int q = 0; q < 4; ++q) s += (v[q].x * v[q].x + v[q].y * v[q].y) + (v[q].z * v[q].z + v[q].w * v[q].w);
        const float rs = 1.0f / sqrtf(wave_sum(s) * (1.f / D) + EPS);
        if (KIND == 2) {
#pragma unroll
            for (int q = 0; q < 4; ++q) { const f32x4 g = ((const GAS f32x4*)gvec)[lane + 64 * q]; ((GAS f32x4*)xr)[lane + 64 * q] = v[q] * rs * g; }
        } else {
            const float* md = MOD + ((size_t)l * 9 + mb) * 6144 + (KIND == 0 ? 0 : 3 * D);
            GAS v2u* o8 = (GAS v2u*)(A + (size_t)r * D);
#pragma unroll
            for (int q = 0; q < 4; ++q) { const f32x4 g = ((const GAS f32x4*)gvec)[lane + 64 * q], sh = ((const GAS f32x4*)md)[lane + 64 * q], sc = ((const GAS f32x4*)(md + D))[lane + 64 * q];
                const f32x4 y = (v[q] * rs) * g * (sc + 1.0f) + sh; const v2u hi2 = (v2u){pk2(y.x, y.y), pk2(y.z, y.w)}; o8[lane + 64 * q] = hi2;
                if (KIND == 1) { GAS v2u* s8 = (GAS v2u*)((bf16*)(ws + WS_QKV) + (size_t)r * QKVW);
                    const v2u lo2 = (v2u){pk2(y.x - bflo(hi2.x), y.y - bfhi(hi2.x)), pk2(y.z - bflo(hi2.y), y.w - bfhi(hi2.y))};
                    s8[lane + 64 * q] = hi2; s8[256 + lane + 64 * q] = hi2; s8[512 + lane + 64 * q] = lo2; } }
        }
    }
}

__device__ __forceinline__ void phase_convert_experts(KArgs a, LAS unsigned char* lds, int l) {
    PHASE_IDS();
    LAS float* scr = (LAS float*)(lds + RING_OFF + wave * 16384);
    bf16* E13 = (bf16*)(a->ws + WS_E13); bf16* E2 = (bf16*)(a->ws + WS_E2);
    for (int it = gw; it < NE * 384; it += NGW) { const int e = it / 384; int r = it - e * 384;
        if (r < 128) { tr_item<1>(a->in[I_W1] + ((size_t)l * NE + e) * D * 256, D, 256, E13 + (size_t)e * 512 * D, 0, r, scr, lane); continue; } r -= 128;
        if (r < 128) { tr_item<1>(a->in[I_W3] + ((size_t)l * NE + e) * D * 256, D, 256, E13 + (size_t)e * 512 * D, 128, r, scr, lane); continue; } r -= 128;
        tr_item<0>(a->in[I_W2] + ((size_t)l * NE + e) * 256 * D, 256, D, E2 + (size_t)e * D * 256, 0, r, scr, lane); }
}

__device__ __forceinline__ void phase_qkv_post(KArgs a, int l) {
    PHASE_IDS();
    bf16* QKV = (bf16*)(a->ws + WS_QKV); const f32x2* rope = (const f32x2*)(a->ws + WS_ROPE);
    const float* gq = a->in[I_GQA] + l * 64; const float* gk = a->in[I_GKA] + l * 64;
    const int j = lane & 7;
    for (int r = gw; r < R; r += NGW) {
        const int b = r / RB, jr = r - b * RB; const bool lat = jr >= TCTX; const int t = jr - TCTX;
#pragma unroll
        for (int pass = 0; pass < 6; ++pass) {
            const int s = pass * 8 + (lane >> 3);
            int kind, nrm = 0;
            if (s < 8) { kind = 1; nrm = 1; } else if (s < 10) { kind = 2; nrm = 2; } else if (s < 12) kind = 0; else if (s < 20) kind = 1; else if (s < 22) kind = 2; else if (s < 24) kind = 0;
            else if (s < 32) kind = 1; else if (s < 40) kind = 2; else kind = 0;
            GAS v4u* p = (GAS v4u*)(QKV + (size_t)r * QKVW + s * 64 + j * 8);
            const v4u raw = *p;
            float x[8] = {bflo(raw.x), bfhi(raw.x), bflo(raw.y), bfhi(raw.y), bflo(raw.z), bfhi(raw.z), bflo(raw.w), bfhi(raw.w)};
            float ss = 0.f;
#pragma unroll
            for (int i = 0; i < 8; ++i) ss += x[i] * x[i];
            ss += __shfl_xor(ss, 1); ss += __shfl_xor(ss, 2); ss += __shfl_xor(ss, 4);
            if (nrm) { const float rs = 1.0f / sqrtf(ss * (1.f / 64.f) + EPS); const float* g = (nrm == 1 ? gq : gk) + j * 8;
#pragma unroll
                for (int i = 0; i < 8; ++i) x[i] = x[i] * rs * g[i]; }
            float px[8];
#pragma unroll
            for (int i = 0; i < 8; ++i) px[i] = __shfl_xor(x[i], 2);
            if (lat && kind != 0) { const f32x2* cs = rope + ((size_t)t * 2 + (j >> 2)) * 16 + 8 * (j & 1);
#pragma unroll
                for (int i = 0; i < 8; ++i) { const f32x2 c = cs[i]; x[i] = (j & 2) ? (px[i] * c.y + x[i] * c.x) : (x[i] * c.x - px[i] * c.y); } }
            if (kind == 1) {
#pragma unroll
                for (int i = 0; i < 8; ++i) x[i] *= attn_body::C2; }
            if (kind != 0) *p = (v4u){pk2(x[0], x[1]), pk2(x[2], x[3]), pk2(x[4], x[5]), pk2(x[6], x[7])};
        }
    }
}

__device__ __forceinline__ void phase_c_combine(KArgs a, int l) {
    PHASE_IDS();
    const bf16* OC = (const bf16*)(a->ws + WS_OC); bf16* YC = (bf16*)(a->ws + WS_YC);
    const float* lp = (const float*)(a->ws + WS_LAYP) + l * 4; const float lam = lp[0], om = lp[2];
    const float g0 = a->in[I_GSUB][l * 128 + 2 * lane], g1 = a->in[I_GSUB][l * 128 + 2 * lane + 1];
    for (int r = gw; r < R; r += NGW) {
#pragma unroll
        for (int hc = 0; hc < 4; ++hc) {
            const unsigned u1 = ((const GAS unsigned*)(OC + (size_t)r * D + (2 * hc) * 128))[lane], u2 = ((const GAS unsigned*)(OC + (size_t)r * D + (2 * hc + 1) * 128))[lane];
            const float d0 = bflo(u1) - lam * bflo(u2), d1 = bfhi(u1) - lam * bfhi(u2);
            const float rs = 1.0f / sqrtf(wave_sum(d0 * d0 + d1 * d1) * (1.f / 128.f) + EPS);
            ((GAS unsigned*)(YC + (size_t)r * 512 + hc * 128))[lane] = pk2(d0 * rs * g0 * om, d1 * rs * g1 * om);
        }
    }
}

__device__ __forceinline__ float seg16_max(float v) { v = fmaxf(v, __shfl_xor(v, 1)); v = fmaxf(v, __shfl_xor(v, 2)); v = fmaxf(v, __shfl_xor(v, 4)); v = fmaxf(v, __shfl_xor(v, 8)); return v; }
__device__ __forceinline__ float seg_top2sum(float v, int lane) {
    const float m1 = seg16_max(v);
    const unsigned long long bal = __ballot(v == m1);
    const unsigned seg = (unsigned)(bal >> (lane & 48)) & 0xffffu;
    const int first = __ffs((int)seg) - 1;
    const float v2 = ((lane & 15) == first) ? -INFINITY : v;
    return m1 + seg16_max(v2);
}
__device__ __forceinline__ void phase_topk(KArgs a, int l) {
    PHASE_IDS();
    const float* LG = (const float*)(a->ws + WS_LOG); int* EP = (int*)(a->ws + WS_EP); float* WT = (float*)(a->ws + WS_WT); int* LIST = (int*)(a->ws + WS_LIST);
    unsigned* cnt = (unsigned*)(a->ws + WS_CTL) + CW_CNT + l * NE;
    const float eb0 = a->in[I_EBIAS][l * NE + lane], eb1 = a->in[I_EBIAS][l * NE + 64 + lane];
    for (int r = gw; r < R; r += NGW) {
        const float s0 = 1.0f / (1.0f + expf(-LG[(size_t)r * NE + lane])), s1 = 1.0f / (1.0f + expf(-LG[(size_t)r * NE + 64 + lane]));
        const float c0 = s0 + eb0, c1 = s1 + eb1;
        const float gs0 = seg_top2sum(c0, lane), gs1 = seg_top2sum(c1, lane);
        float g[8];
#pragma unroll
        for (int k = 0; k < 4; ++k) { g[k] = __shfl(gs0, 16 * k); g[4 + k] = __shfl(gs1, 16 * k); }
        bool selA = false, selB = false;
#pragma unroll
        for (int k = 0; k < 8; ++k) { int rank = 0;
#pragma unroll
            for (int k2 = 0; k2 < 8; ++k2) rank += (g[k2] > g[k] || (g[k2] == g[k] && k2 < k)) ? 1 : 0;
            const bool sel = rank < 4;
            if (k < 4) { if ((lane >> 4) == k) selA = sel; } else { if ((lane >> 4) == k - 4) selB = sel; } }
        float m0 = selA ? c0 : -INFINITY, m1 = selB ? c1 : -INFINITY;
        int my_e = 0; float my_s = 0.f, ssum = 0.f;
#pragma unroll
        for (int k = 0; k < TOPK; ++k) {
            const float m = wave_max(fmaxf(m0, m1));
            const unsigned long long b0 = __ballot(m0 == m);
            int idx; if (b0) idx = __ffsll((long long)b0) - 1; else { const unsigned long long b1 = __ballot(m1 == m); idx = 64 + __ffsll((long long)b1) - 1; }
            const float sc = (idx < 64) ? __shfl(s0, idx) : __shfl(s1, idx - 64);
            if (lane == (idx & 63)) { if (idx < 64) m0 = -INFINITY; else m1 = -INFINITY; }
            ssum += sc; if (lane == k) { my_e = idx; my_s = sc; }
        }
        if (lane < TOPK) { const unsigned pos = __hip_atomic_fetch_add(cnt + my_e, 1u, RLX_AGENT);
            LIST[(size_t)my_e * CAP + pos] = r; EP[(size_t)r * 8 + lane] = (my_e << 17) | (int)pos; WT[(size_t)r * 8 + lane] = my_s / ssum * 2.5f; }
    }
}

struct MoeOrder {
    int NCT, G, c, ntile; const LAS int* tb; const LAS int* cn; const LAS unsigned short* te; const int* list;
    __device__ __forceinline__ void init(LAS unsigned char* lds, int NCT_, int G_, int c_, const int* list_) { tb = (const LAS int*)(lds + MOE_OFF); cn = tb + 132; te = (const LAS unsigned short*)(cn + 128);
        NCT = NCT_; G = G_; c = c_; list = list_; ntile = tb[NE]; }
    __device__ __forceinline__ bool next(int i, pg8::Unit& u) const {
        const int L = i * G + c; if (L >= ntile * NCT) return false;
        const int tile = L / NCT, ct = L - tile * NCT, e = te[tile];
        u.pm = tile; u.pn = e * NCT + ct; u.om = tile; u.on = ct; u.aux = e; return true; }
    __device__ __forceinline__ unsigned arow(const pg8::Unit& u, int h, int Rl) const {
        int p = (u.om - tb[u.aux]) * 256 + h * 128 + Rl; const int c1 = cn[u.aux] - 1; p = p < c1 ? p : c1;
        return (unsigned)list[(size_t)u.aux * CAP + p]; }
};

__device__ __forceinline__ void phase_attn(KArgs a, char* lds, int l) {
    const int G = gridDim.x, bx = blockIdx.x; const int vcu = (G % 8 == 0) ? (bx % 8) * (G / 8) + bx / 8 : bx;
    typedef attn_body::bf16 abf;
    const abf* QKV = (const abf*)(a->ws + WS_QKV); abf* YA = (abf*)(a->ws + WS_YA); abf* YB = (abf*)(a->ws + WS_YB); abf* OC = (abf*)(a->ws + WS_OC);
    const float* sink = a->in[I_SINK] + l * 8;
    for (int f = vcu; f < 6144 + 256; f += G) {
        int qcol, kcol, vcol, ocol, PO, NT; size_t qrow, krow; abf* O; float sk2 = -INFINITY;
        if (f < 6144) { const int blk = f >> 8, v = f & 255, b = blk / 3, ri = blk - 3 * b, grp = v >> 5, qb = v & 31;
            qrow = (size_t)b * RB + TCTX + (size_t)qb * 256; krow = (size_t)b * RB; NT = RB / 64;
            if (ri == 0) { qcol = grp * 64; kcol = 512 + (grp >> 2) * 64; vcol = 640 + (grp >> 2) * 64; O = YA; PO = 512; ocol = grp * 64; }
            else { const int combo = (ri - 1) * 8 + grp, s = combo >> 1, vh = combo & 1; qcol = 1536 + s * 64; kcol = 2048 + s * 64; vcol = 2560 + (s >> 1) * 128 + vh * 64; O = OC; PO = 1024; ocol = s * 128 + vh * 64; }
        } else { const int c = f - 6144, b = c >> 5, k = c & 31; qrow = (size_t)b * RB; krow = qrow; NT = TCTX / 64;
            if (k < 8) { qcol = k * 64; kcol = 512 + (k >> 2) * 64; vcol = 640 + (k >> 2) * 64; O = YA; PO = 512; ocol = k * 64; }
            else if (k < 16) { const int h = k - 8; qcol = 768 + h * 64; kcol = 1280 + (h >> 2) * 64; vcol = 1408 + (h >> 2) * 64; O = YB; PO = 512; ocol = h * 64; sk2 = sink[h] * LOG2E; }
            else { const int s = (k - 16) >> 1, vh = (k - 16) & 1; qcol = 1536 + s * 64; kcol = 2048 + s * 64; vcol = 2560 + (s >> 1) * 128 + vh * 64; O = OC; PO = 1024; ocol = s * 128 + vh * 64; }
        }
        attn_body::attn_unit<0, 8>(QKV + qrow * QKVW + qcol, QKV + krow * QKVW + kcol, QKV + krow * QKVW + vcol, O + qrow * PO + ocol, PO, NT, 0, 0, sk2, lds);
    }
    for (int w = vcu; w < 2048; w += G) {
        const int b = w >> 8, v = w & 255, h = v >> 5, qb = v & 31, q0 = qb * 256;
        const int wstart = (q0 - 128 > 0) ? q0 - 128 : 0, wend = (q0 + 384 < SEQ) ? q0 + 384 : SEQ, NT = 4 + (wend - wstart) / 64;
        const size_t qrow = (size_t)b * RB + TCTX + q0, krow = (size_t)b * RB;
        attn_body::attn_unit<1, 8>(QKV + qrow * QKVW + 768 + h * 64, QKV + krow * QKVW + 1280 + (h >> 2) * 64, QKV + krow * QKVW + 1408 + (h >> 2) * 64, YB + qrow * 512 + h * 64, 512, NT, wstart, wstart - q0, sink[h] * LOG2E, lds);
    }
}
#ifndef MK_PHMASK
#define MK_PHMASK 0xffff
#endif
#define PHE(p) ((MK_PHMASK >> (p)) & 1)
__global__ void __launch_bounds__(NWAVES * 64, 2) mk_fwd(Args args) {
    extern __shared__ __attribute__((aligned(16))) unsigned char lds_raw[];
    LAS unsigned char* lds = (LAS unsigned char*)lds_raw;
    const KArgs ka = (KArgs)__builtin_amdgcn_kernarg_segment_ptr();
#define KA() ({ KArgs _p = ka; asm volatile("" : "+s"(_p)); _p; })
#define WSP(off) (KA()->ws + (off))
    for (int u = threadIdx.x; u < (LDS_BYTES - LDSCTL_OFF) / 4; u += NWAVES * 64) ((LAS unsigned*)(lds + LDSCTL_OFF))[u] = 0u;
    __syncthreads();
    XcdBarrier bar; bar.bar = (unsigned*)(args.ws + WS_CTL) + CW_BAR; bar.x = 0; bar.st = nullptr;
    if (!MK_MULTI) bar = xcd_barrier_post((unsigned*)(args.ws + WS_CTL) + CW_BAR, (volatile LAS unsigned*)(lds + MISC_OFF) + 8);
    const int lo = args.ph_lo, hi = args.ph_hi;
#define IN(k) (lo <= (k) && (k) < hi)
#define SEAM(k) do { if (!MK_MULTI) { if (IN(k) && IN((k) + 1)) xcd_barrier(bar); } } while (0)
#define GRID_IDS() const int G = gridDim.x, bx = blockIdx.x; const int vcu = (G % 8 == 0) ? (bx % 8) * (G / 8) + bx / 8 : bx; (void)vcu
#define WL(l, off) (const bf16*)(WSP(WS_WSM + (size_t)(l) * WSM_LAYER + (off)))

    if (PHE(13) && IN(0)) { phase_prologue(KA(), lds); } SEAM(0);

    for (int l = 0; l < NL; ++l) {
        const int p0 = 1 + l * PH_PER_LAYER;
        if (p0 + PH_PER_LAYER <= lo || p0 >= hi) continue;
        if (PHE(0) && IN(p0 + 0)) { phase_norm<0>(KA(), lds, l); phase_convert_experts(KA(), lds, l); } SEAM(p0 + 0);
        if (PHE(1) && IN(p0 + 1)) { GRID_IDS(); pg8::Gemm g{(const bf16*)WSP(WS_A), WL(l, WL_QKV), D}; pg8::StaticOrder S; S.init(NPAN, QKVW / 256, G, bx);
            pg8::EpiBf16<0> E{(bf16*)WSP(WS_QKV), QKVW, nullptr};
            pg8::gemm_phase<pg8::EpiBf16<0>, pg8::StaticOrder, true, false>(lds + RING_OFF, g, S, E); } SEAM(p0 + 1);
        if (PHE(2) && IN(p0 + 2)) { phase_qkv_post(KA(), l); } SEAM(p0 + 2);
        if (PHE(3) && IN(p0 + 3)) { phase_attn(KA(), (char*)lds_raw + RING_OFF, l); } SEAM(p0 + 3);
        if (PHE(4) && IN(p0 + 4)) { phase_c_combine(KA(), l); } SEAM(p0 + 4);
        if (PHE(5) && IN(p0 + 5)) { GRID_IDS(); pg8::Gemm g{(const bf16*)WSP(WS_A), WL(l, WL_GATE), D}; pg8::StaticOrder S; S.init(NPAN, 12, G, bx);
            pg8::EpiBf16<1> E{(bf16*)WSP(WS_QKV), QKVW, KA()->in[I_BGATE] + l * 3072};
            pg8::gemm_phase<pg8::EpiBf16<1>, pg8::StaticOrder, true, false>(lds + RING_OFF, g, S, E); } SEAM(p0 + 5);
        if (PHE(6) && IN(p0 + 6)) {
            { GRID_IDS(); pg8::StaticOrder S; S.init(NPAN, 4, G, bx); pg8::Gemm g{(const bf16*)WSP(WS_YA), WL(l, WL_BR), 512}; pg8::EpiBranch<0> E{(const bf16*)WSP(WS_QKV), (bf16*)WSP(WS_MG)};
              pg8::gemm_phase<pg8::EpiBranch<0>, pg8::StaticOrder, true, false>(lds + RING_OFF, g, S, E); }
            { GRID_IDS(); pg8::StaticOrder S; S.init(NPAN, 4, G, bx); pg8::Gemm g{(const bf16*)WSP(WS_YB), WL(l, WL_BR + 1 * MiB), 512}; pg8::EpiBranch<1> E{(const bf16*)WSP(WS_QKV), (bf16*)WSP(WS_MG)};
              pg8::gemm_phase<pg8::EpiBranch<1>, pg8::StaticOrder, true, false>(lds + RING_OFF, g, S, E); }
            { GRID_IDS(); pg8::StaticOrder S; S.init(NPAN, 4, G, bx); pg8::Gemm g{(const bf16*)WSP(WS_YC), WL(l, WL_BR + 2 * MiB), 512}; pg8::EpiBranch<2> E{(const bf16*)WSP(WS_QKV), (bf16*)WSP(WS_MG)};
              pg8::gemm_phase<pg8::EpiBranch<2>, pg8::StaticOrder, true, false>(lds + RING_OFF, g, S, E); } } SEAM(p0 + 6);
        if (PHE(7) && IN(p0 + 7)) { GRID_IDS(); pg8::Gemm g{(const bf16*)WSP(WS_MG), WL(l, WL_OUT), D}; pg8::StaticOrder S; S.init(NPAN, 4, G, bx);
            pg8::EpiResid E{KA()->out, (float*)WSP(WS_XC), (const float*)WSP(WS_MOD) + (size_t)l * 9 * 6144, 2 * D};
            pg8::gemm_phase<pg8::EpiResid, pg8::StaticOrder, true, false>(lds + RING_OFF, g, S, E); } SEAM(p0 + 7);
        if (PHE(8) && IN(p0 + 8)) { phase_norm<1>(KA(), lds, l); } SEAM(p0 + 8);
        if (PHE(9) && IN(p0 + 9)) { GRID_IDS(); pg8::Gemm g{(const bf16*)WSP(WS_QKV), (const bf16*)WSP(WS_WR2 + (size_t)l * WR2_LAYER), 3 * D}; pg8::StaticOrder S; S.init(NPAN, 1, G, bx);
            pg8::EpiRouter E{(float*)WSP(WS_LOG)};
            pg8::gemm_phase<pg8::EpiRouter, pg8::StaticOrder, true, false>(lds + RING_OFF, g, S, E); } SEAM(p0 + 9);
        if (PHE(10) && IN(p0 + 10)) { phase_topk(KA(), l); } SEAM(p0 + 10);
        if (PHE(11) && IN(p0 + 11)) { moe_tables(lds, (const unsigned*)WSP(WS_CTL) + CW_CNT + l * NE, true);
            { GRID_IDS(); pg8::Gemm g{(const bf16*)WSP(WS_A), (const bf16*)WSP(WS_E13), D}; MoeOrder S; S.init(lds, 2, G, vcu, (const int*)WSP(WS_LIST)); pg8::EpiUp E{(bf16*)WSP(WS_HR)};
              pg8::gemm_phase<pg8::EpiUp, MoeOrder, true, true>(lds + RING_OFF, g, S, E); }
            { GRID_IDS(); pg8::Gemm g{(const bf16*)WSP(WS_A), WL(l, WL_S13), D}; pg8::StaticOrder S; S.init(NPAN, 2, G, bx); pg8::EpiUp E{(bf16*)WSP(WS_HS)};
              pg8::gemm_phase<pg8::EpiUp, pg8::StaticOrder, true, false>(lds + RING_OFF, g, S, E); } } SEAM(p0 + 11);
        if (PHE(12) && IN(p0 + 12)) { moe_tables(lds, (const unsigned*)WSP(WS_CTL) + CW_CNT + l * NE, true);
            { GRID_IDS(); pg8::Gemm g{(const bf16*)WSP(WS_HR), (const bf16*)WSP(WS_E2), 256}; MoeOrder S; S.init(lds, 4, G, vcu, (const int*)WSP(WS_LIST)); pg8::EpiBf16<0> E{(bf16*)WSP(WS_YR), D, nullptr};
              pg8::gemm_phase<pg8::EpiBf16<0>, MoeOrder, true, false>(lds + RING_OFF, g, S, E); }
            { GRID_IDS(); pg8::Gemm g{(const bf16*)WSP(WS_HS), WL(l, WL_S2), 256}; pg8::StaticOrder S; S.init(NPAN, 4, G, bx);
              pg8::EpiResid E{KA()->out, (float*)WSP(WS_XC), (const float*)WSP(WS_MOD) + (size_t)l * 9 * 6144, 5 * D};
              pg8::gemm_phase<pg8::EpiResid, pg8::StaticOrder, true, false>(lds + RING_OFF, g, S, E); } } SEAM(p0 + 12);
    }
    if (PHE(14) && IN(NPH - 1)) { phase_norm<2>(KA(), lds, NL); }
#undef IN
#undef SEAM
}

extern "C" void kernel_launch(void* const* d_in, const int* in_sizes, int n_in, void* d_out, int out_size, void* d_ws, size_t ws_size, hipStream_t stream) {
    static int grid = 0;
    if (grid == 0) {
        if (n_in != N_IN || out_size != NB * SEQ * D || ws_size < WS_END) { fprintf(stderr, "kernel_launch: unexpected shapes (n_in %d, out %d, ws %zu); nothing launched\n", n_in, out_size, ws_size); grid = -1; return; }
        int dev = 0, cus = 0, per_cu = 0;
        if (hipGetDevice(&dev) != hipSuccess || hipDeviceGetAttribute(&cus, hipDeviceAttributeMultiprocessorCount, dev) != hipSuccess) { grid = -1; return; }
        if (hipFuncSetAttribute((const void*)mk_fwd, hipFuncAttributeMaxDynamicSharedMemorySize, LDS_BYTES) != hipSuccess) { fprintf(stderr, "kernel_launch: hipFuncSetAttribute failed\n"); grid = -1; return; }
        if (hipOccupancyMaxActiveBlocksPerMultiprocessor(&per_cu, (const void*)mk_fwd, NWAVES * 64, LDS_BYTES) != hipSuccess || per_cu < 1) { fprintf(stderr, "kernel_launch: occupancy query says %d\n", per_cu); (void)hipGetLastError(); grid = -1; return; }
        grid = cus;
    }
    if (grid < 0) return;
    (void)hipMemsetAsync((char*)d_ws + WS_CTL, 0, CTL_ZERO_BYTES, stream);
    Args a{};
    for (int i = 0; i < N_IN; ++i) a.in[i] = (const float*)d_in[i];
    a.out = (float*)d_out; a.ws = (unsigned char*)d_ws;
#if MK_MULTI
    for (int ph = 0; ph < NPH; ++ph) {
        a.ph_lo = ph; a.ph_hi = ph + 1;
        hipLaunchKernelGGL(mk_fwd, dim3(grid), dim3(NWAVES * 64), LDS_BYTES, stream, a);
#if MK_CHECK
        dbg_after_phase(ph, a, stream);
#endif
    }
#else
    a.ph_lo = 0; a.ph_hi = NPH;
    hipLaunchKernelGGL(mk_fwd, dim3(grid), dim3(NWAVES * 64), LDS_BYTES, stream, a);
#endif
}
```

```cpp
#include <hip/hip_runtime.h>
#include <hip/hip_bf16.h>
#include <cstdio>
#include <cstdint>
#include <cmath>

#ifndef MK_MULTI
#define MK_MULTI 0
#endif
#ifndef MK_CHECK
#define MK_CHECK 0
#endif

namespace pg8 {
#define PG8_LAS __attribute__((address_space(3)))
typedef unsigned short bf16_t;
typedef short bf16x8 __attribute__((ext_vector_type(8)));
typedef float f32x4 __attribute__((ext_vector_type(4)));
typedef float f32x2 __attribute__((ext_vector_type(2)));
typedef unsigned u32x4 __attribute__((ext_vector_type(4)));
constexpr int BM = 256, BK = 64, HALF = 128, HTB = HALF * BK * 2  , STAGE_BYTES = 8 * HTB, NXCD = 8, WGM = 8;

__host__ __device__ __forceinline__ int lds_byte(int r, int c) { const int st = (r >> 4) * 2 + (c >> 5), rr = r & 15, cc = c & 31, ob = rr * 64 + cc * 2; return st * 1024 + (ob ^ (((ob >> 9) & 1) << 5)); }
__host__ __device__ __forceinline__ void stage_rc(int b, int& R, int& C) { const int st = b / 1024, sb = b % 1024, swz = sb ^ (((sb >> 9) & 1) << 5); R = (st >> 1) * 16 + swz / 64; C = (st & 1) * 32 + (swz % 64) / 2; }
__host__ __device__ __forceinline__ int perm32(int rho) { const int n = rho >> 4, i = rho & 15; return 8 * (i >> 2) + 4 * n + (i & 3); }

struct Unit { int pm, pn, om, on, aux; };
struct Gemm { const bf16_t* A; const bf16_t* Bt; int K; };

struct StaticOrder {
    int nM, nN, nwg, G, c;
    __device__ __forceinline__ void init(int nM_, int nN_, int G_, int c_) { nM = nM_; nN = nN_; nwg = nM * nN; G = G_; c = c_; }
    __device__ __forceinline__ bool next(int i, Unit& u) const {
        const long L = (long)i * G + c; if (L >= nwg) return false;
        int wgid = (int)L; { const int q = nwg / NXCD, r = nwg % NXCD, xcd = wgid % NXCD, off = wgid / NXCD; wgid = (xcd < r ? xcd * (q + 1) : r * (q + 1) + (xcd - r) * q) + off; }
        const int nig = WGM * nN, gid = wgid / nig, fm = gid * WGM, gsz = (nM - fm) < WGM ? (nM - fm) : WGM;
        u.pm = fm + ((wgid % nig) % gsz); u.pn = (wgid % nig) / gsz; u.om = u.pm; u.on = u.pn; u.aux = 0; return true;
    }
    __device__ __forceinline__ unsigned arow(const Unit&, int, int) const { return 0u; }
};

typedef __bf16 bf16x2_t __attribute__((ext_vector_type(2)));
__device__ __forceinline__ unsigned cvt_pk_bf16(float lo, float hi) { f32x2 v = {lo, hi}; bf16x2_t b = __builtin_convertvector(v, bf16x2_t); return __builtin_bit_cast(unsigned, b); }
__device__ __forceinline__ float bf_lo(unsigned w) { return __builtin_bit_cast(float, w << 16); }
__device__ __forceinline__ float bf_hi(unsigned w) { return __builtin_bit_cast(float, w & 0xffff0000u); }
__device__ __forceinline__ float sigmoidf_fast(float x) { return __builtin_amdgcn_rcpf(1.0f + __builtin_amdgcn_exp2f(-1.4426950408889634f * x)); }

template <int ACT> struct EpiBf16 {
    static constexpr bool PERM = true;
    bf16_t* O; int ldc; const float* bias;
    __device__ __forceinline__ void operator()(const f32x4 (&acc)[2][2][4][2], const Unit& u, int wr, int wc, int fr, int fq) const {
        const int row0 = u.om * BM + wr * 64 + fr; const int col0 = u.on * BM + wc * 32 + 8 * fq;
        f32x4 bv[2][2];
#pragma unroll
        for (int bj = 0; bj < 2; ++bj)
#pragma unroll
            for (int n = 0; n < 2; ++n) bv[bj][n] = (ACT == 1) ? *(const f32x4*)(bias + col0 + bj * HALF + 4 * n) : (f32x4){0.f, 0.f, 0.f, 0.f};
#pragma unroll
        for (int ai = 0; ai < 2; ++ai)
#pragma unroll
            for (int m = 0; m < 4; ++m) { bf16_t* rowp = O + (size_t)(row0 + ai * HALF + m * 16) * ldc + col0;
#pragma unroll
                for (int bj = 0; bj < 2; ++bj) { f32x4 v0 = acc[ai][bj][m][0] + bv[bj][0], v1 = acc[ai][bj][m][1] + bv[bj][1];
                    if (ACT == 1) {
#pragma unroll
                        for (int j = 0; j < 4; ++j) { v0[j] = sigmoidf_fast(v0[j]); v1[j] = sigmoidf_fast(v1[j]); } }
                    u32x4 w; w.x = cvt_pk_bf16(v0[0], v0[1]); w.y = cvt_pk_bf16(v0[2], v0[3]); w.z = cvt_pk_bf16(v1[0], v1[1]); w.w = cvt_pk_bf16(v1[2], v1[3]);
                    *(u32x4*)(rowp + bj * HALF) = w; } }
    }
};
template <int BR> struct EpiBranch {
    static constexpr bool PERM = true;
    const bf16_t* GATE; bf16_t* MG;
    __device__ __forceinline__ void operator()(const f32x4 (&acc)[2][2][4][2], const Unit& u, int wr, int wc, int fr, int fq) const {
        const int row0 = u.om * BM + wr * 64 + fr; const int col0 = u.on * BM + wc * 32 + 8 * fq;
#pragma unroll
        for (int ai = 0; ai < 2; ++ai)
#pragma unroll
            for (int m = 0; m < 4; ++m) { const size_t row = (size_t)(row0 + ai * HALF + m * 16);
#pragma unroll
                for (int bj = 0; bj < 2; ++bj) {
                    const u32x4 gw = *(const u32x4*)(GATE + row * 3072 + BR * 1024 + col0 + bj * HALF);
                    bf16_t* mp = MG + row * 1024 + col0 + bj * HALF;
                    u32x4 mw = (u32x4){0u, 0u, 0u, 0u}; if (BR > 0) mw = *(const u32x4*)mp;
                    const f32x4 a0 = acc[ai][bj][m][0], a1 = acc[ai][bj][m][1];
                    float o[8];
                    o[0] = bf_lo(gw.x) * a0[0]; o[1] = bf_hi(gw.x) * a0[1]; o[2] = bf_lo(gw.y) * a0[2]; o[3] = bf_hi(gw.y) * a0[3];
                    o[4] = bf_lo(gw.z) * a1[0]; o[5] = bf_hi(gw.z) * a1[1]; o[6] = bf_lo(gw.w) * a1[2]; o[7] = bf_hi(gw.w) * a1[3];
                    if (BR > 0) { o[0] += bf_lo(mw.x); o[1] += bf_hi(mw.x); o[2] += bf_lo(mw.y); o[3] += bf_hi(mw.y); o[4] += bf_lo(mw.z); o[5] += bf_hi(mw.z); o[6] += bf_lo(mw.w); o[7] += bf_hi(mw.w); }
                    u32x4 w; w.x = cvt_pk_bf16(o[0], o[1]); w.y = cvt_pk_bf16(o[2], o[3]); w.z = cvt_pk_bf16(o[4], o[5]); w.w = cvt_pk_bf16(o[6], o[7]);
                    *(u32x4*)mp = w; } }
    }
};
struct EpiResid {
    static constexpr bool PERM = false;
    float* XL; float* XC; const float* modl; int goff;
    __device__ __forceinline__ void operator()(const f32x4 (&acc)[2][2][4][2], const Unit& u, int wr, int wc, int fr, int fq) const {
        const int b = u.om / 33, pj = u.om % 33;
        float* base = (pj == 0) ? XC + (size_t)b * 256 * 1024 : XL + ((size_t)b * 8192 + (size_t)(pj - 1) * 256) * 1024;
        const float* gv = modl + (pj == 0 ? 8 : b) * 6144 + goff;
        const int row0 = wr * 64 + fr, col0 = u.on * BM + wc * 32 + 4 * fq;
#pragma unroll
        for (int bj = 0; bj < 2; ++bj)
#pragma unroll
            for (int n = 0; n < 2; ++n) { const f32x4 g4 = *(const f32x4*)(gv + col0 + bj * HALF + n * 16);
#pragma unroll
                for (int ai = 0; ai < 2; ++ai)
#pragma unroll
                    for (int m = 0; m < 4; ++m) { f32x4* p = (f32x4*)(base + (size_t)(row0 + ai * HALF + m * 16) * 1024 + col0 + bj * HALF + n * 16); *p = *p + g4 * acc[ai][bj][m][n]; } }
    }
};
struct EpiRouter {
    static constexpr bool PERM = false;
    float* LG;
    __device__ __forceinline__ void operator()(const f32x4 (&acc)[2][2][4][2], const Unit& u, int wr, int wc, int fr, int fq) const {
        const int row0 = u.om * BM + wr * 64 + fr, col0 = wc * 32 + 4 * fq;
#pragma unroll
        for (int ai = 0; ai < 2; ++ai)
#pragma unroll
            for (int m = 0; m < 4; ++m) { float* rowp = LG + (size_t)(row0 + ai * HALF + m * 16) * 128 + col0;
#pragma unroll
                for (int n = 0; n < 2; ++n) *(f32x4*)(rowp + n * 16) = acc[ai][0][m][n]; }
    }
};
struct EpiUp {
    static constexpr bool PERM = true;
    bf16_t* H;
    __device__ __forceinline__ void operator()(const f32x4 (&acc)[2][2][4][2], const Unit& u, int wr, int wc, int fr, int fq) const {
        const int row0 = u.om * BM + wr * 64 + fr; const int col0 = u.on * HALF + wc * 32 + 8 * fq;
#pragma unroll
        for (int ai = 0; ai < 2; ++ai)
#pragma unroll
            for (int m = 0; m < 4; ++m) { bf16_t* rowp = H + (size_t)(row0 + ai * HALF + m * 16) * 256 + col0;
                float o[8];
#pragma unroll
                for (int n = 0; n < 2; ++n)
#pragma unroll
                    for (int j = 0; j < 4; ++j) { const float a = acc[ai][0][m][n][j], c = acc[ai][1][m][n][j]; o[n * 4 + j] = a * sigmoidf_fast(a) * c; }
                u32x4 w; w.x = cvt_pk_bf16(o[0], o[1]); w.y = cvt_pk_bf16(o[2], o[3]); w.z = cvt_pk_bf16(o[4], o[5]); w.w = cvt_pk_bf16(o[6], o[7]);
                *(u32x4*)rowp = w; }
    }
};

template <class Epi, class Sched, bool ALIGN_EPI, bool GATHER>
__device__ __forceinline__ void gemm_phase(PG8_LAS unsigned char* lds, const Gemm g, const Sched& S, const Epi& E) {
    int tid = threadIdx.x; asm volatile("" : "+v"(tid));
    const int wid = __builtin_amdgcn_readfirstlane(tid >> 6), lane = tid & 63, wr = wid >> 2, wc = wid & 3, fr = lane & 15, fq = lane >> 4;
    int K = g.K; asm volatile("" : "+s"(K));
    const int nt = K / BK;
    unsigned voffA[2], voffB[2]; int RA[2]; unsigned CA2[2];
#pragma unroll
    for (int i = 0; i < 2; ++i) { int R, C; stage_rc(tid * 16 + i * 8192, R, C); const int Rb = Epi::PERM ? ((R & ~31) + perm32(R & 31)) : R;
        voffA[i] = (unsigned)(R * K + C) * 2u; voffB[i] = (unsigned)(Rb * K + C) * 2u; RA[i] = R; CA2[i] = (unsigned)C * 2u; }
    const size_t kstep = (size_t)(BK * 2);
    const size_t hstep = (size_t)HALF * K * 2;
    const size_t tstep = 2 * hstep;
    const unsigned rowb = (unsigned)K * 2u;
    const unsigned ldsw = (unsigned)wid * 1024u;
    const int aoff = lds_byte(wr * 64 + fr, fq * 8), boff = lds_byte(wc * 32 + fr, fq * 8);
#define PG8_SA(b, h) (((b) * 2 + (h)) * HTB)
#define PG8_SB(b, h) ((4 + (b) * 2 + (h)) * HTB)
#define PG8_STAGE(bufoff, gbase, voff) do { _Pragma("unroll") for (int _i = 0; _i < 2; ++_i) \
        __builtin_amdgcn_global_load_lds((const unsigned*)((const char*)(gbase) + (voff)[_i]), (PG8_LAS unsigned*)(lds + (bufoff) + ldsw + _i * 8192), 16, 0, 0); } while (0)
#define PG8_STAGE_A(bufoff, gb, h, VO) do { if constexpr (GATHER) { PG8_STAGE(bufoff, gb, VO[h]); } else { PG8_STAGE(bufoff, (gb) + (h) * hstep, voffA); } } while (0)
#define PG8_LDA(dst, b, h) do { _Pragma("unroll") for (int m = 0; m < 4; ++m) _Pragma("unroll") for (int k = 0; k < 2; ++k) dst[m][k] = *(const PG8_LAS bf16x8*)(lds + PG8_SA(b, h) + aoff + m * 2048 + k * 1024); } while (0)
#define PG8_LDB(dst, b, h) do { _Pragma("unroll") for (int n = 0; n < 2; ++n) _Pragma("unroll") for (int k = 0; k < 2; ++k) dst[n][k] = *(const PG8_LAS bf16x8*)(lds + PG8_SB(b, h) + boff + n * 2048 + k * 1024); } while (0)
#define PG8_MMA(ai, bj, At, Bt) do { __builtin_amdgcn_s_setprio(1); _Pragma("unroll") for (int m = 0; m < 4; ++m) _Pragma("unroll") for (int n = 0; n < 2; ++n) _Pragma("unroll") for (int k = 0; k < 2; ++k) \
        acc[ai][bj][m][n] = __builtin_amdgcn_mfma_f32_16x16x32_bf16(Bt[n][k], At[m][k], acc[ai][bj][m][n], 0, 0, 0); __builtin_amdgcn_s_setprio(0); } while (0)
#define PG8_WAIT_V(n) asm volatile("s_waitcnt vmcnt(" #n ")" ::: "memory")
#define PG8_WAIT_L(n) asm volatile("s_waitcnt lgkmcnt(" #n ")" ::: "memory")
#define PG8_BAR __builtin_amdgcn_s_barrier()
#define PG8_SCHED __builtin_amdgcn_sched_barrier(0)
    Unit cur, nxt, nx2; int ui = 0;
    if (!S.next(0, cur)) return;
    f32x4 acc[2][2][4][2];
#pragma unroll
    for (int a = 0; a < 2; ++a)
#pragma unroll
        for (int b = 0; b < 2; ++b)
#pragma unroll
            for (int m = 0; m < 4; ++m)
#pragma unroll
                for (int n = 0; n < 2; ++n) acc[a][b][m][n] = (f32x4){0.f, 0.f, 0.f, 0.f};
    bf16x8 At[4][2], B0[2][2], B1[2][2];
    unsigned cvo[2][2], nvo[2][2], n2vo[2][2];
    bool has_next = S.next(1, nxt);
    if constexpr (GATHER) {
#pragma unroll
        for (int h = 0; h < 2; ++h)
#pragma unroll
            for (int i = 0; i < 2; ++i) { cvo[h][i] = S.arow(cur, h, RA[i]) * rowb + CA2[i]; nvo[h][i] = has_next ? S.arow(nxt, h, RA[i]) * rowb + CA2[i] : cvo[h][i]; n2vo[h][i] = nvo[h][i]; }
    }
    const char* cA = GATHER ? (const char*)g.A : (const char*)g.A + (size_t)cur.pm * tstep; const char* cB = (const char*)g.Bt + (size_t)cur.pn * tstep;
    PG8_STAGE(PG8_SB(0, 0), cB, voffB); PG8_STAGE(PG8_SB(0, 1), cB + hstep, voffB); PG8_STAGE_A(PG8_SA(0, 0), cA, 0, cvo); PG8_STAGE_A(PG8_SA(0, 1), cA, 1, cvo);
    if (wr == 1) PG8_BAR;
    PG8_WAIT_V(2); PG8_BAR;
    PG8_STAGE(PG8_SB(1, 0), cB + kstep, voffB); PG8_STAGE_A(PG8_SA(1, 0), cA + kstep, 0, cvo); PG8_STAGE(PG8_SB(1, 1), cB + hstep + kstep, voffB);
    PG8_WAIT_V(6); PG8_BAR;
    for (;;) {
        bool has_n2 = false;
        if constexpr (GATHER) { if (has_next) { has_n2 = S.next(ui + 2, nx2); if (has_n2) {
#pragma unroll
            for (int h = 0; h < 2; ++h)
#pragma unroll
                for (int i = 0; i < 2; ++i) n2vo[h][i] = S.arow(nx2, h, RA[i]) * rowb + CA2[i]; } } }
        const char* nA = GATHER ? (const char*)g.A : (has_next ? (const char*)g.A + (size_t)nxt.pm * tstep : cA); const char* nB = has_next ? (const char*)g.Bt + (size_t)nxt.pn * tstep : cB;
        for (int t = 0; t < nt; t += 2) {
            const bool last = (t == nt - 2);
            const char* a1 = cA + (size_t)(t + 1) * kstep;
            const char* a2 = last ? nA : cA + (size_t)(t + 2) * kstep; const char* b2 = last ? nB : cB + (size_t)(t + 2) * kstep;
            const char* a3 = a2 + kstep; const char* b3 = b2 + kstep;
            unsigned xvo[2][2];
            if constexpr (GATHER) {
#pragma unroll
                for (int h = 0; h < 2; ++h)
#pragma unroll
                    for (int i = 0; i < 2; ++i) xvo[h][i] = last ? nvo[h][i] : cvo[h][i];
            }
            PG8_LDB(B0, 0, 0); PG8_LDB(B1, 0, 1); PG8_SCHED; PG8_LDA(At, 0, 0); PG8_STAGE_A(PG8_SA(1, 1), a1, 1, cvo);
            PG8_WAIT_V(8); PG8_WAIT_L(0); PG8_BAR; PG8_MMA(0, 0, At, B0); PG8_MMA(0, 1, At, B1); PG8_BAR; PG8_SCHED;
            PG8_LDA(At, 0, 1); PG8_STAGE(PG8_SB(0, 0), b2, voffB); PG8_STAGE(PG8_SB(0, 1), b2 + hstep, voffB); PG8_STAGE_A(PG8_SA(0, 0), a2, 0, xvo);
            PG8_WAIT_V(8); PG8_WAIT_L(0); PG8_BAR; PG8_MMA(1, 0, At, B0); PG8_MMA(1, 1, At, B1); PG8_BAR; PG8_SCHED;
            PG8_LDB(B0, 1, 0); PG8_LDB(B1, 1, 1); PG8_SCHED; PG8_LDA(At, 1, 0); PG8_STAGE_A(PG8_SA(0, 1), a2, 1, xvo);
            PG8_WAIT_V(8); PG8_WAIT_L(0); PG8_BAR; PG8_MMA(0, 0, At, B0); PG8_MMA(0, 1, At, B1); PG8_BAR; PG8_SCHED;
            PG8_LDA(At, 1, 1); PG8_STAGE(PG8_SB(1, 0), b3, voffB); PG8_STAGE(PG8_SB(1, 1), b3 + hstep, voffB); PG8_STAGE_A(PG8_SA(1, 0), a3, 0, xvo);
            PG8_WAIT_V(8); PG8_WAIT_L(0); PG8_BAR; PG8_MMA(1, 0, At, B0); PG8_MMA(1, 1, At, B1); PG8_BAR; PG8_SCHED;
        }
        if constexpr (ALIGN_EPI) { if (wr == 0) PG8_BAR; }
        E(acc, cur, wr, wc, fr, fq);
        if (!has_next) break;
#pragma unroll
        for (int a = 0; a < 2; ++a)
#pragma unroll
            for (int b = 0; b < 2; ++b)
#pragma unroll
                for (int m = 0; m < 4; ++m)
#pragma unroll
                    for (int n = 0; n < 2; ++n) acc[a][b][m][n] = (f32x4){0.f, 0.f, 0.f, 0.f};
        cur = nxt; cA = nA; cB = nB; ++ui;
        if constexpr (GATHER) {
#pragma unroll
            for (int h = 0; h < 2; ++h)
#pragma unroll
                for (int i = 0; i < 2; ++i) { cvo[h][i] = nvo[h][i]; nvo[h][i] = n2vo[h][i]; }
            has_next = has_n2; nxt = nx2;
        } else { has_next = S.next(ui + 1, nxt); }
        if constexpr (ALIGN_EPI) { if (wr == 1) PG8_BAR; }
    }
    PG8_WAIT_V(0);
    if constexpr (!ALIGN_EPI) { if (wr == 0) PG8_BAR; }
    PG8_BAR;
#undef PG8_SA
#undef PG8_SB
#undef PG8_STAGE
#undef PG8_STAGE_A
#undef PG8_LDA
#undef PG8_LDB
#undef PG8_MMA
#undef PG8_WAIT_V
#undef PG8_WAIT_L
#undef PG8_BAR
#undef PG8_SCHED
}
}
namespace attn_body {
using bf16=__hip_bfloat16;
using bf16x8=__attribute__((ext_vector_type(8)))short;
using s16x4=__attribute__((ext_vector_type(4)))short;
using f32x16=__attribute__((ext_vector_type(16)))float;
using u32x4=__attribute__((ext_vector_type(4)))unsigned;
constexpr int D=64, P=3072;
constexpr int NW=8,QBLK=32,QB=QBLK*NW,KVBLK=64;
__device__ __forceinline__ int crow(int r,int hi){return (r&3)+8*(r>>2)+4*hi;}
#define SBAR() __builtin_amdgcn_sched_barrier(0)
__device__ __forceinline__ void wmask(f32x16&p0,f32x16&p1,int dbase){
  const float NEG=-INFINITY;
  #pragma unroll
  for(int r=0;r<16;++r){const int d=dbase+(r&3)+8*(r>>2); if(d>128||d<-128)p0[r]=NEG; if(d+32>128||d+32<-128)p1[r]=NEG;}
}
constexpr int NSLOT=3, SLOTB=8192;
constexpr int LDS_K=0, LDS_V=NSLOT*SLOTB, LDS_WS=2*NSLOT*SLOTB, LDS_OST=LDS_WS+NW*64*4, LDS_BYTES=LDS_OST+NW*4096;
constexpr float C2=0.125f*1.4426950408889634f;
__device__ __forceinline__ void glds16(const void*gsrc,unsigned lds_dst){unsigned keep;
  asm volatile("s_mov_b32 %0, m0\n\ts_mov_b32 m0, %2\n\ts_nop 0\n\tglobal_load_lds_dwordx4 %1, off\n\ts_mov_b32 m0, %0":"=&s"(keep):"v"(gsrc),"s"(lds_dst):"memory");}
__device__ __forceinline__ float max3f(float a,float b,float c){float r;asm("v_max3_f32 %0, %1, %2, %3":"=v"(r):"v"(a),"v"(b),"v"(c));return r;}
__device__ __forceinline__ float max2f(float a,float b){float r;asm("v_max_f32_e32 %0, %1, %2":"=v"(r):"v"(a),"v"(b));return r;}
__device__ __forceinline__ float fadd_s(float a,float b){float r;asm("v_add_f32_e32 %0, %1, %2":"=v"(r):"v"(a),"v"(b));return r;}
__device__ __forceinline__ float fsub_s(float a,float b){float r;asm("v_sub_f32_e32 %0, %1, %2":"=v"(r):"v"(a),"v"(b));return r;}
typedef float f32x2_t __attribute__((ext_vector_type(2))); typedef __bf16 bf16x2_t __attribute__((ext_vector_type(2)));
__device__ __forceinline__ unsigned cvtpk_s(float lo,float hi){f32x2_t v={lo,hi};bf16x2_t b=__builtin_convertvector(v,bf16x2_t);return __builtin_bit_cast(unsigned,b);}
#define WAIT_BAR(N) asm volatile("s_waitcnt vmcnt(" #N ") lgkmcnt(0)\n\ts_barrier":::"memory")

__device__ __forceinline__ void qkt(f32x16&p0,f32x16&p1,const char*Kslot,const bf16x8*qr,const f32x16&negm,int r32,int hi){
  const char*kb=Kslot+hi*1024+r32*16;
  #pragma unroll
  for(int d0=0;d0<4;++d0){
    const bf16x8 b0=*reinterpret_cast<const bf16x8*>(kb+d0*2048);
    const bf16x8 b1=*reinterpret_cast<const bf16x8*>(kb+d0*2048+512);
    if(d0==0){p0=__builtin_amdgcn_mfma_f32_32x32x16_bf16(b0,qr[0],negm,0,0,0);p1=__builtin_amdgcn_mfma_f32_32x32x16_bf16(b1,qr[0],negm,0,0,0);}
    else{p0=__builtin_amdgcn_mfma_f32_32x32x16_bf16(b0,qr[d0],p0,0,0,0);p1=__builtin_amdgcn_mfma_f32_32x32x16_bf16(b1,qr[d0],p1,0,0,0);}}
}
typedef __attribute__((address_space(3))) const char* lds_cptr;
typedef short v4i16_t __attribute__((ext_vector_type(4)));
__device__ __forceinline__ void kload8(bf16x8*kf,lds_cptr kp){
  kf[0]=*(const __attribute__((address_space(3))) bf16x8*)(kp);      kf[1]=*(const __attribute__((address_space(3))) bf16x8*)(kp+512);
  kf[2]=*(const __attribute__((address_space(3))) bf16x8*)(kp+2048); kf[3]=*(const __attribute__((address_space(3))) bf16x8*)(kp+2560);
  kf[4]=*(const __attribute__((address_space(3))) bf16x8*)(kp+4096); kf[5]=*(const __attribute__((address_space(3))) bf16x8*)(kp+4608);
  kf[6]=*(const __attribute__((address_space(3))) bf16x8*)(kp+6144); kf[7]=*(const __attribute__((address_space(3))) bf16x8*)(kp+6656);
}
__device__ __forceinline__ void kload2(bf16x8*kf,lds_cptr kp,int j){ kf[2*j]=*(const __attribute__((address_space(3))) bf16x8*)(kp+j*2048); kf[2*j+1]=*(const __attribute__((address_space(3))) bf16x8*)(kp+j*2048+512); }
__device__ __forceinline__ s16x4 vtr(lds_cptr p){ return __builtin_bit_cast(s16x4,__builtin_amdgcn_ds_read_tr16_b64_v4i16((__attribute__((address_space(3))) v4i16_t*)p)); }
__device__ __forceinline__ float rowmax(const f32x16&p0,const f32x16&p1){
  float a=max3f(p0[0],p0[1],p1[0]),b=max3f(p0[2],p0[3],p1[1]);a=max3f(a,p1[2],p1[3]);
  #pragma unroll
  for(int r=4;r<16;r+=4){a=max3f(a,p0[r],p0[r+1]);b=max3f(b,p0[r+2],p0[r+3]);a=max3f(a,p1[r],p1[r+1]);b=max3f(b,p1[r+2],p1[r+3]);}
  const float m=max2f(a,b);
  auto rr=__builtin_amdgcn_permlane32_swap(__float_as_uint(m),__float_as_uint(m),false,false);
  return max2f(__uint_as_float(rr[0]),__uint_as_float(rr[1]));
}
__device__ __forceinline__ void pv(f32x16*o,int vb,bf16x8 pa0,bf16x8 pa1,bf16x8 pa2,bf16x8 pa3){
  #pragma unroll
  for(int d0=0;d0<2;++d0){s16x4 lo[4],hi[4];
    #pragma unroll
    for(int ks=0;ks<4;++ks){
      asm volatile("ds_read_b64_tr_b16 %0,%1 offset:%c2":"=&v"(lo[ks]):"v"(vb),"i"(d0*4096+ks*1024):"memory");
      asm volatile("ds_read_b64_tr_b16 %0,%1 offset:%c2":"=&v"(hi[ks]):"v"(vb),"i"(d0*4096+ks*1024+512):"memory");}
    asm volatile("s_waitcnt lgkmcnt(0)":::"memory");SBAR();
    #define PK(k) (bf16x8){lo[k][0],lo[k][1],lo[k][2],lo[k][3],hi[k][0],hi[k][1],hi[k][2],hi[k][3]}
    o[d0]=__builtin_amdgcn_mfma_f32_32x32x16_bf16(pa0,PK(0),o[d0],0,0,0);
    o[d0]=__builtin_amdgcn_mfma_f32_32x32x16_bf16(pa1,PK(1),o[d0],0,0,0);
    o[d0]=__builtin_amdgcn_mfma_f32_32x32x16_bf16(pa2,PK(2),o[d0],0,0,0);
    o[d0]=__builtin_amdgcn_mfma_f32_32x32x16_bf16(pa3,PK(3),o[d0],0,0,0);
    #undef PK
  }
}

template<int MODE,int THRL> __device__ __forceinline__ void attn_unit(const bf16*Qu,const bf16*__restrict__ Kh,const bf16*__restrict__ Vh,bf16*Ou,int PO,int NT,int wadd,int dq0,float sink2,char*shm){
  int tid=threadIdx.x; asm volatile("":"+v"(tid)); const int lane=tid&63,r32=lane&31,hi=lane>>5; const int wid=__builtin_amdgcn_readfirstlane(tid>>6);
  const bf16*Qw=Qu+(long)(wid*QBLK)*P;
  const unsigned lds0=(unsigned)(uintptr_t)shm;
  float*wsf=(float*)(shm+LDS_WS)+wid*64;
  const bf16*ksrc=Kh+(long)lane*P+wid*8;
  const bf16*vsrc=Vh+(long)(16*(wid&3)+(lane>>2))*P+(wid>>2)*32+(lane&3)*8;
  const unsigned kdst=lds0+LDS_K+wid*1024, vdst=lds0+LDS_V+wid*1024;
  #define TROW(t) ((long)(t)*KVBLK+((MODE==1&&(t)>=4)?(long)wadd:0l))
  #define DMA_K(t,slot) glds16(ksrc+TROW(t)*P,(unsigned)__builtin_amdgcn_readfirstlane(kdst+(slot)))
  #define DMA_V(t,slot) glds16(vsrc+TROW(t)*P,(unsigned)__builtin_amdgcn_readfirstlane(vdst+(slot)))
  const int vb0=(int)(lds0+LDS_V)+((lane>>4)&1)*32+(lane&3)*8+(4*hi+((lane&15)>>2))*64;
  const char*Kbase=shm+LDS_K; bf16x8 kf[8];
  const lds_cptr shm3=(lds_cptr)shm; const lds_cptr kp0=shm3+LDS_K+hi*1024+r32*16; const lds_cptr vp0=shm3+LDS_V+((lane>>4)&1)*32+(lane&3)*8+(4*hi+((lane&15)>>2))*64;
  DMA_K(0,0);DMA_V(0,0);DMA_K(1,SLOTB);
  bf16x8 qr[4];
  #pragma unroll
  for(int d0=0;d0<4;++d0)qr[d0]=*reinterpret_cast<const bf16x8*>(&Qw[(long)r32*P+d0*16+hi*8]);
  float mhat=0.f,l_reg=0.f;f32x16 o[2];o[0]=f32x16{};o[1]=f32x16{};f32x16 negm=f32x16{};asm volatile("":"+v"(negm));
  const int qrel=wid*QBLK+r32;
  const int dlane=dq0-qrel+4*hi;
  #define CMASK(P0,P1,t) do{ if(MODE==1){ if((t)>=4) wmask(P0,P1,dlane+64*((t)-4)); } }while(0)
  bool resc=false;
  #define START(P0,P1) do{ const float rm=rowmax(P0,P1); resc=false; \
    { const float dl=rm; mhat=fadd_s(mhat,dl); \
      _Pragma("unroll") for(int r=0;r<16;++r){P0[r]=fsub_s(P0[r],dl);P1[r]=fsub_s(P1[r],dl);} \
      _Pragma("unroll") for(int r=0;r<16;++r)negm[r]=-mhat; asm volatile("":"+v"(negm)); } \
    _Pragma("unroll") for(int r=0;r<16;++r)P0[r]=__builtin_amdgcn_exp2f(P0[r]); }while(0)
  #define RESC() do{ if(resc){ asm volatile("s_waitcnt lgkmcnt(0)":::"memory"); \
      _Pragma("unroll") for(int d_=0;d_<2;++d_) _Pragma("unroll") for(int r=0;r<16;++r)o[d_][r]*=wsf[crow(r,hi)]; } }while(0)
  f32x16 pA0,pA1,pB0,pB1;
  int sl_prev=0,sl_cur=0,sl_next=SLOTB;
  #define ROT() do{sl_prev=sl_cur;sl_cur=sl_next;sl_next=(sl_next==(NSLOT-1)*SLOTB)?0:sl_next+SLOTB;}while(0)
  DMA_K(2,2*SLOTB);
  WAIT_BAR(3);
  qkt(pA0,pA1,Kbase,qr,negm,r32,hi);asm volatile("s_nop 15\n\ts_nop 7":"+v"(pA0),"+v"(pA1));
  START(pA0,pA1);
  _Pragma("unroll") for(int r=0;r<16;++r)pA1[r]=__builtin_amdgcn_exp2f(pA1[r]);
  WAIT_BAR(0);
  DMA_K(3,0);DMA_V(1,SLOTB);
  ROT();
  kload8(kf,kp0+sl_cur);
  WAIT_BAR(2);
  s16x4 vlo[8],vhi[8]; u32x4 pw0,pw1,pw2,pw3;
  #define PKW(P,B) cvtpk_s(P[B],P[B+1])
  #define PAF(k) __builtin_bit_cast(bf16x8,pw##k)
  #define VFR(i) (bf16x8){vlo[i][0],vlo[i][1],vlo[i][2],vlo[i][3],vhi[i][0],vhi[i][1],vhi[i][2],vhi[i][3]}
  #define PIN(x) asm volatile("":"+v"(x))
  #define MX3(a,b,c) __builtin_fmaxf(__builtin_fmaxf((a),(b)),(c))
  #define GAPA(MF,A0,A1,A2,A3,W0,W1,PW) do{ MF; sacc+=A0; sacc+=A1; sacc+=A2; sacc+=A3; PIN(sacc); W0; W1; PIN(PW); SBAR(); }while(0)
  #define EX(v) __builtin_amdgcn_exp2f(v)
  #define GAPB(MF,X,B) do{ MF; X[B]=EX(X[B]); X[B+1]=EX(X[B+1]); X[B+2]=EX(X[B+2]); X[B+3]=EX(X[B+3]); PIN(X); SBAR(); }while(0)
  #define VRD(i) do{ vlo[i]=vtr(vp_+(((i)>>2)*4096+((i)&3)*1024)); vhi[i]=vtr(vp_+(((i)>>2)*4096+((i)&3)*1024+512)); }while(0)
  #define KRD(G,j) do{ if(G){ kload2(kf,kp0+sl_next,j); SBAR(); } }while(0)
  #define STEP(C0,C1,P0,P1,t,GK,GV,GL) do{ SBAR(); \
    const lds_cptr vp_=vp0+sl_prev; \
    VRD(0); SBAR(); float sacc=(P0[0]+P0[1]); \
    GAPA(C0=__builtin_amdgcn_mfma_f32_32x32x16_bf16(kf[0],qr[0],negm,0,0,0), P0[2],P0[3],P0[4],P0[5],     pw0[0]=PKW(P0,0), pw0[1]=PKW(P0,2), pw0); \
    VRD(4); SBAR(); GAPA(C1=__builtin_amdgcn_mfma_f32_32x32x16_bf16(kf[1],qr[0],negm,0,0,0), P0[6],P0[7],P0[8],P0[9],     pw0[2]=PKW(P0,4), pw0[3]=PKW(P0,6), pw0); \
    VRD(1); SBAR(); GAPA(C0=__builtin_amdgcn_mfma_f32_32x32x16_bf16(kf[2],qr[1],C0,0,0,0),   P0[10],P0[11],P0[12],P0[13], pw1[0]=PKW(P0,8), pw1[1]=PKW(P0,10), pw1); \
    VRD(5); SBAR(); GAPA(C1=__builtin_amdgcn_mfma_f32_32x32x16_bf16(kf[3],qr[1],C1,0,0,0),   P0[14],P0[15],P1[0],P1[1],   pw1[2]=PKW(P0,12),pw1[3]=PKW(P0,14), pw1); \
    VRD(2); SBAR(); GAPA(C0=__builtin_amdgcn_mfma_f32_32x32x16_bf16(kf[4],qr[2],C0,0,0,0),   P1[2],P1[3],P1[4],P1[5],     pw2[0]=PKW(P1,0), pw2[1]=PKW(P1,2), pw2); \
    VRD(6); SBAR(); GAPA(C1=__builtin_amdgcn_mfma_f32_32x32x16_bf16(kf[5],qr[2],C1,0,0,0),   P1[6],P1[7],P1[8],P1[9],     pw2[2]=PKW(P1,4), pw2[3]=PKW(P1,6), pw2); \
    VRD(3); SBAR(); GAPA(C0=__builtin_amdgcn_mfma_f32_32x32x16_bf16(kf[6],qr[3],C0,0,0,0),   P1[10],P1[11],P1[12],P1[13], pw3[0]=PKW(P1,8), pw3[1]=PKW(P1,10), pw3); \
    VRD(7); SBAR(); GAPA(C1=__builtin_amdgcn_mfma_f32_32x32x16_bf16(kf[7],qr[3],C1,0,0,0),   P1[14],P1[15],0.f,0.f,       pw3[2]=PKW(P1,12),pw3[3]=PKW(P1,14), pw3); \
    l_reg+=sacc; \
    if(GK){DMA_K((t)+3,sl_cur);} if(GV){DMA_V((t)+1,sl_next);} \
    CMASK(C0,C1,t); \
    { float a=MX3(C0[0],C0[1],C1[0]),b=MX3(C0[2],C0[3],C1[1]); a=MX3(a,C1[2],C1[3]); \
      _Pragma("unroll") for(int r=4;r<16;r+=4){a=MX3(a,C0[r],C0[r+1]);b=MX3(b,C0[r+2],C0[r+3]);a=MX3(a,C1[r],C1[r+1]);b=MX3(b,C1[r+2],C1[r+3]);} \
      float rm=__builtin_fmaxf(a,b); { auto rr=__builtin_amdgcn_permlane32_swap(__float_as_uint(rm),__float_as_uint(rm),false,false); rm=__builtin_fmaxf(__uint_as_float(rr[0]),__uint_as_float(rr[1])); } \
      resc=false; \
      if(__builtin_expect(__any(rm>(float)THRL),0)){ const float dl=__builtin_fmaxf(rm,0.f); mhat+=dl; \
        _Pragma("unroll") for(int r=0;r<16;++r){C0[r]-=dl;C1[r]-=dl;} \
        _Pragma("unroll") for(int r=0;r<16;++r)negm[r]=-mhat; asm volatile("":"+v"(negm)); \
        const float f=__builtin_amdgcn_exp2f(-dl); l_reg*=f; if(hi==0)wsf[r32]=f; resc=true; } } \
    SBAR(); \
    GAPB(o[0]=__builtin_amdgcn_mfma_f32_32x32x16_bf16(PAF(0),VFR(0),o[0],0,0,0), C0,0); \
    GAPB(o[1]=__builtin_amdgcn_mfma_f32_32x32x16_bf16(PAF(0),VFR(4),o[1],0,0,0), C0,4); \
    KRD(GL,0); GAPB(o[0]=__builtin_amdgcn_mfma_f32_32x32x16_bf16(PAF(1),VFR(1),o[0],0,0,0), C0,8); \
    KRD(GL,1); GAPB(o[1]=__builtin_amdgcn_mfma_f32_32x32x16_bf16(PAF(1),VFR(5),o[1],0,0,0), C0,12); \
    KRD(GL,2); GAPB(o[0]=__builtin_amdgcn_mfma_f32_32x32x16_bf16(PAF(2),VFR(2),o[0],0,0,0), C1,0); \
    KRD(GL,3); GAPB(o[1]=__builtin_amdgcn_mfma_f32_32x32x16_bf16(PAF(2),VFR(6),o[1],0,0,0), C1,4); \
    GAPB(o[0]=__builtin_amdgcn_mfma_f32_32x32x16_bf16(PAF(3),VFR(3),o[0],0,0,0), C1,8); \
    GAPB(o[1]=__builtin_amdgcn_mfma_f32_32x32x16_bf16(PAF(3),VFR(7),o[1],0,0,0), C1,12); \
    }while(0)
  int t=1;
  if(MODE==0){
    for(;t+5<NT;t+=2){
      STEP(pB0,pB1,pA0,pA1,t,true,true,true);     WAIT_BAR(2); RESC(); ROT();
      STEP(pA0,pA1,pB0,pB1,t+1,true,true,true);   WAIT_BAR(2); RESC(); ROT();
    }
  }
  #define ENDW(tt) do{ if((tt)+3<NT){WAIT_BAR(2);} else if((tt)+2<NT){WAIT_BAR(1);} else {WAIT_BAR(0);} }while(0)
  for(;t+1<NT;t+=2){
    STEP(pB0,pB1,pA0,pA1,t,(t+3<NT),(t+1<NT),(t+1<NT));       ENDW(t);   RESC(); ROT();
    STEP(pA0,pA1,pB0,pB1,t+1,(t+4<NT),(t+2<NT),(t+2<NT));     ENDW(t+1); RESC(); ROT();
  }
  STEP(pB0,pB1,pA0,pA1,NT-1,false,false,false); RESC();
  { float sacc=pB0[0]+pB0[1]; _Pragma("unroll") for(int r=2;r<16;++r)sacc+=pB0[r]; _Pragma("unroll") for(int r=0;r<16;++r)sacc+=pB1[r]; l_reg+=sacc;
    pw0=(u32x4){PKW(pB0,0),PKW(pB0,2),PKW(pB0,4),PKW(pB0,6)};pw1=(u32x4){PKW(pB0,8),PKW(pB0,10),PKW(pB0,12),PKW(pB0,14)};pw2=(u32x4){PKW(pB1,0),PKW(pB1,2),PKW(pB1,4),PKW(pB1,6)};pw3=(u32x4){PKW(pB1,8),PKW(pB1,10),PKW(pB1,12),PKW(pB1,14)};
    SBAR(); pv(o,vb0+sl_cur,PAF(0),PAF(1),PAF(2),PAF(3)); }
  #undef PKW
  #undef PAF
  #undef VFR
  #undef PIN
  #undef MX3
  #undef GAPA
  #undef GAPB
  #undef EX
  #undef VRD
  #undef KRD
  #undef STEP
  #undef ENDW
  {auto rr=__builtin_amdgcn_permlane32_swap(__float_as_uint(l_reg),__float_as_uint(l_reg),false,false);l_reg=__uint_as_float(rr[0])+__uint_as_float(rr[1]);}
  l_reg+=__builtin_amdgcn_exp2f(sink2-mhat);
  if(hi==0)wsf[32+r32]=l_reg;asm volatile("s_waitcnt lgkmcnt(0)":::"memory");
  float rli[16];
  #pragma unroll
  for(int r=0;r<16;++r)rli[r]=__builtin_amdgcn_rcpf(wsf[32+crow(r,hi)]);
  bf16*Ow=Ou+(long)(wid*QBLK)*PO;
  { bf16*stg=(bf16*)(shm+LDS_OST)+wid*2048;
    #pragma unroll
    for(int r=0;r<16;++r){const int orow=crow(r,hi);
      #pragma unroll
      for(int d0=0;d0<2;++d0)stg[orow*64+d0*32+r32]=__float2bfloat16(o[d0][r]*rli[r]);}
    asm volatile("s_waitcnt lgkmcnt(0)":::"memory");
    #pragma unroll
    for(int i=0;i<4;++i){const int row=i*8+(lane>>3),ch=lane&7; const u32x4 v=*(const u32x4*)(stg+row*64+ch*8); *(u32x4*)(Ow+(long)row*PO+ch*8)=v;} }
  asm volatile("s_waitcnt lgkmcnt(0)\n\ts_barrier":::"memory");
  #undef DMA_K
  #undef DMA_V
  #undef TROW
  #undef CMASK
  #undef START
  #undef RESC
  #undef ROT
}
constexpr int ATTN_LDS_BYTES=LDS_BYTES;
#undef SBAR
#undef WAIT_BAR
}
constexpr int NWAVES = 8;
constexpr int NB = 8, SEQ = 8192, TCTX = 256, RB = SEQ + TCTX  , R = NB * RB  ;
constexpr int D = 1024, NL = 4, NPAN = R / 256  , QKVW = 3072;
constexpr int NE = 128, TOPK = 8, CAP = R  , MAXTILES = 2240, MAXSLOTS = MAXTILES * 256;
constexpr float EPS = 1e-6f, LOG2E = 1.4426950408889634f;
constexpr int PH_PER_LAYER = 13, NPH = 2 + NL * PH_PER_LAYER;
enum { I_X = 0, I_C, I_CTX, I_CCTX, I_WMOD, I_BMOD, I_G1, I_WQKV, I_GQA, I_GKA, I_SINK, I_LQ1, I_LK1, I_LQ2, I_LK2, I_GSUB, I_WBRA, I_WBRB, I_WBRC, I_WGATE, I_BGATE, I_WOUT, I_G2, I_WR, I_EBIAS,
       I_W1, I_W3, I_W2, I_WS1, I_WS3, I_WS2, I_GF, N_IN };

constexpr size_t MiB = 1u << 20;
constexpr size_t WS_CTL = 0, CTL_ZERO_BYTES = 1 * MiB;
constexpr size_t WS_MOD = 1 * MiB;
constexpr size_t WS_LAYP = WS_MOD + 960 * 1024;
constexpr size_t WS_ROPE = 2 * MiB;
constexpr size_t WS_WSM = 4 * MiB, WSM_LAYER = 19 * MiB;
constexpr size_t WL_QKV = 0, WL_GATE = 6 * MiB, WL_BR = 12 * MiB, WL_OUT = 15 * MiB, WL_R = 17 * MiB, WL_S13 = 17 * MiB + 512 * 1024, WL_S2 = 18 * MiB + 512 * 1024;
constexpr size_t WS_E13 = 80 * MiB;
constexpr size_t WS_E2 = 208 * MiB;
constexpr size_t WS_XC = 272 * MiB;
constexpr size_t WS_A = 280 * MiB;
constexpr size_t WS_HS = 412 * MiB;
constexpr size_t WS_HR = 445 * MiB;
constexpr size_t WS_LIST = 725 * MiB;
constexpr size_t WS_EP = 758 * MiB;
constexpr size_t WS_WT = 761 * MiB;
constexpr size_t WS_LOG = 764 * MiB;
constexpr size_t WS_DBG = 797 * MiB;
constexpr size_t WS_YR = 800 * MiB;
constexpr size_t WS_QKV = 800 * MiB;
constexpr size_t WS_YA = 1196 * MiB, WS_YB = 1262 * MiB, WS_YC = 1328 * MiB;
constexpr size_t WS_OC = 1394 * MiB;
constexpr size_t WS_MG = 1526 * MiB;
constexpr size_t WS_WR2 = 1920 * MiB, WR2_LAYER = 1536 * 1024;
constexpr size_t WS_END = 1926 * MiB;
static_assert(WS_YR + (size_t)MAXSLOTS * 2048 <= WS_END && WS_MG + (size_t)R * 2048 <= WS_END && WS_HR + (size_t)MAXSLOTS * 512 <= WS_LIST && WS_A + (size_t)R * 2048 <= WS_HS, "d_ws map");
constexpr int CW_BAR = 4096;
constexpr int CW_CNT = 16384;
constexpr int CW_ERR = 20480;

constexpr int RING_OFF = 0, RING_BYTES = 131072;
constexpr int LDSCTL_OFF = RING_BYTES, MISC_OFF = LDSCTL_OFF + 320;
constexpr int MOE_OFF = LDSCTL_OFF + 512;
constexpr int LDS_BYTES = 147456;
static_assert(MOE_OFF + 132 * 4 + 128 * 4 + MAXTILES * 2 <= LDS_BYTES && attn_body::ATTN_LDS_BYTES <= RING_BYTES, "LDS map");

#define GAS __attribute__((address_space(1)))
#define LAS __attribute__((address_space(3)))
typedef unsigned short bf16;
typedef unsigned v4u __attribute__((ext_vector_type(4)));
typedef unsigned v2u __attribute__((ext_vector_type(2)));
typedef float f32x4 __attribute__((ext_vector_type(4)));
typedef float f32x2 __attribute__((ext_vector_type(2)));
typedef GAS unsigned gu32;
#define RLX_AGENT __ATOMIC_RELAXED, __HIP_MEMORY_SCOPE_AGENT
#define LDS_WAIT() asm volatile("s_waitcnt lgkmcnt(0)" ::: "memory")
#define VM_WAIT() asm volatile("s_waitcnt vmcnt(0)" ::: "memory")
__device__ __forceinline__ unsigned f2bf(float f) { unsigned u = __builtin_bit_cast(unsigned, f); return (u + 0x7fffu + ((u >> 16) & 1u)) >> 16; }
__device__ __forceinline__ unsigned pk2(float lo, float hi) { return f2bf(lo) | (f2bf(hi) << 16); }
__device__ __forceinline__ float bflo(unsigned w) { return __builtin_bit_cast(float, w << 16); }
__device__ __forceinline__ float bfhi(unsigned w) { return __builtin_bit_cast(float, w & 0xffff0000u); }

#define XB_TMO      128
#define XB_XCNT(j)  (256  + 64 * (j))
#define XB_XSUB(j)  (1280 + 64 * (j))
#define XB_XGEN(j)  (2304 + 64 * (j))
#define XB_TOP      3328
#define XB_TOPGEN   3392
#define XCD_BAR_WORDS 3456
#define XB_SPIN_CAP (1u << 22)

__device__ __forceinline__ unsigned xb_ld(unsigned* p)              { return __hip_atomic_load(p, __ATOMIC_RELAXED, __HIP_MEMORY_SCOPE_AGENT); }
__device__ __forceinline__ unsigned xb_add(unsigned* p, unsigned v) { return __hip_atomic_fetch_add(p, v, __ATOMIC_RELAXED, __HIP_MEMORY_SCOPE_AGENT); }
__device__ __forceinline__ unsigned xb_xcc_id() { return (unsigned)__builtin_amdgcn_s_getreg((3 << 11) | 20) & 0xFu; }
#define XB_SPIN(cond, bar) do { unsigned _sp = 0; while (cond) { __builtin_amdgcn_s_sleep(1); \
    if ((++_sp & 255u) == 0u) { if (xb_ld(&(bar)[XB_TMO])) break; if (_sp > XB_SPIN_CAP) { atomicAdd(&(bar)[XB_TMO], 1u); break; } } } } while (0)

struct XcdBarrier {
    unsigned* bar; unsigned x;
    volatile LAS unsigned* st;
};
__device__ __forceinline__ XcdBarrier xcd_barrier_post(unsigned* bar, volatile LAS unsigned* st) {
    XcdBarrier b; b.bar = bar; b.x = xb_xcc_id(); b.st = st;
    if (threadIdx.x == 0) (void)xb_add(&bar[XB_XCNT(b.x)], 1u);
    return b;
}
__device__ __forceinline__ void xcd_barrier_complete(unsigned* bar, unsigned x, unsigned& nloc, unsigned& nx) {
    const unsigned G = gridDim.x * gridDim.y * gridDim.z;
    unsigned sum, cnt, mine, sp = 0u;
    for (;;) {
        sum = 0u; cnt = 0u; mine = 0u;
#pragma unroll
        for (unsigned j = 0; j < 16; ++j) { const unsigned c = xb_ld(&bar[XB_XCNT(j)]); sum += c; cnt += (c > 0u) ? 1u : 0u; mine = (j == x) ? c : mine; }
        if (sum == G) break;
        __builtin_amdgcn_s_sleep(1);
        if ((++sp & 255u) == 0u) { if (xb_ld(&bar[XB_TMO])) break; if (sp > XB_SPIN_CAP) { atomicAdd(&bar[XB_TMO], 1u); break; } }
    }
    nloc = mine > 0u ? mine : 1u; nx = cnt > 0u ? cnt : 1u;
}
__device__ __forceinline__ void xcd_barrier(const XcdBarrier& b) {
    asm volatile("s_waitcnt vmcnt(0)" ::: "memory");
    __syncthreads();
    if (threadIdx.x == 0) {
        unsigned* bar = b.bar;
        __builtin_amdgcn_s_waitcnt(0);
        unsigned nloc = b.st[0], nx = b.st[1];
        if (nloc == 0u) { xcd_barrier_complete(bar, b.x, nloc, nx); b.st[0] = nloc; b.st[1] = nx; }
        const unsigned old = xb_add(&bar[XB_XSUB(b.x)], 1u);
        const unsigned gen = old / nloc;
        if (old + 1u == (gen + 1u) * nloc) {
            __builtin_amdgcn_fence(__ATOMIC_RELEASE, "agent");
            asm volatile("s_waitcnt vmcnt(0)" ::: "memory");
            const unsigned og = xb_add(&bar[XB_TOP], 1u);
            const unsigned tg = og / nx;
            if (og + 1u == (tg + 1u) * nx) xb_add(&bar[XB_TOPGEN], 1u);
            else XB_SPIN(xb_ld(&bar[XB_TOPGEN]) == tg, bar);
            __builtin_amdgcn_fence(__ATOMIC_ACQUIRE, "agent");
            xb_add(&bar[XB_XGEN(b.x)], 1u);
            asm volatile("s_waitcnt vmcnt(0)" ::: "memory");
        } else {
            XB_SPIN(xb_ld(&bar[XB_XGEN(b.x)]) == gen, bar);
            __builtin_amdgcn_fence(__ATOMIC_ACQUIRE, "agent");
            asm volatile("s_waitcnt vmcnt(0)" ::: "memory");
        }
    }
    __syncthreads();
}

struct Args { const float* in[N_IN]; float* out; unsigned char* ws; int ph_lo, ph_hi; };
typedef const __attribute__((address_space(4))) Args* KArgs;

template <int M> __device__ __forceinline__ float xor_f(float v) { static_assert(M >= 1 && M < 32, "xor within 32 lanes"); return __builtin_bit_cast(float, __builtin_amdgcn_ds_swizzle(__builtin_bit_cast(int, v), (M << 10) | 0x1f)); }
__device__ __forceinline__ float half_other(float v, float& own) { const unsigned a = __builtin_bit_cast(unsigned, v); auto rr = __builtin_amdgcn_permlane32_swap(a, a, false, false); const unsigned r0 = rr[0], r1 = rr[1]; own = __uint_as_float(r0); return __uint_as_float(r1); }
__device__ __forceinline__ float lane_f(float v, int src) { return __builtin_bit_cast(float, __builtin_amdgcn_readlane(__builtin_bit_cast(int, v), src)); }
__device__ __forceinline__ int lane_i(int v, int src) { return __builtin_amdgcn_readlane(v, src); }
__device__ __forceinline__ float wave_sum(float v) {
    v += xor_f<1>(v); v += xor_f<2>(v); v += xor_f<4>(v); v += xor_f<8>(v); v += xor_f<16>(v);
    float own; const float oth = half_other(v, own); return own + oth;
}
__device__ __forceinline__ float wave_max(float v) {
    v = fmaxf(v, xor_f<1>(v)); v = fmaxf(v, xor_f<2>(v)); v = fmaxf(v, xor_f<4>(v)); v = fmaxf(v, xor_f<8>(v)); v = fmaxf(v, xor_f<16>(v));
    float own; const float oth = half_other(v, own); return fmaxf(own, oth);
}
__device__ __forceinline__ float* xrow_ptr(float* XL, float* XC, int r) { const int b = r / RB, j = r - b * RB; return (j < TCTX) ? XC + ((size_t)b * TCTX + j) * D : XL + ((size_t)b * SEQ + (j - TCTX)) * D; }

__device__ __forceinline__ void tr_block(const float* W, int ldw, int k0, int n0, bf16* WT, int ldt, int drow0, LAS float* scr, int lane) {
#pragma unroll 8
    for (int i = 0; i < 32; ++i) { const int kk = 2 * i + (lane >> 5); scr[kk * 33 + (lane & 31)] = W[(size_t)(k0 + kk) * ldw + n0 + (lane & 31)]; }
    LDS_WAIT(); asm volatile("" ::: "memory");
    const int c = lane & 7;
#pragma unroll
    for (int j = 0; j < 4; ++j) { const int n = (lane >> 3) + 8 * j; const LAS float* s = scr + (8 * c) * 33 + n;
        v4u o; o.x = pk2(s[0 * 33], s[1 * 33]); o.y = pk2(s[2 * 33], s[3 * 33]); o.z = pk2(s[4 * 33], s[5 * 33]); o.w = pk2(s[6 * 33], s[7 * 33]);
        *(GAS v4u*)(WT + (size_t)(drow0 + n) * ldt + k0 + 8 * c) = o; }
    LDS_WAIT(); asm volatile("" ::: "memory");
}

__device__ __forceinline__ void tr_block_split(const float* W, int ldw, int k0, int n0, bf16* WT, LAS float* scr, int lane) {
#pragma unroll 8
    for (int i = 0; i < 32; ++i) { const int kk = 2 * i + (lane >> 5); scr[kk * 33 + (lane & 31)] = W[(size_t)(k0 + kk) * ldw + n0 + (lane & 31)]; }
    LDS_WAIT(); asm volatile("" ::: "memory");
    const int c = lane & 7;
#pragma unroll
    for (int j = 0; j < 4; ++j) { const int n = (lane >> 3) + 8 * j; const LAS float* s = scr + (8 * c) * 33 + n;
        float w[8], lo[8];
#pragma unroll
        for (int q = 0; q < 8; ++q) { w[q] = s[q * 33]; lo[q] = w[q] - __builtin_bit_cast(float, f2bf(w[q]) << 16); }
        const v4u oh = (v4u){pk2(w[0], w[1]), pk2(w[2], w[3]), pk2(w[4], w[5]), pk2(w[6], w[7])}, ol = (v4u){pk2(lo[0], lo[1]), pk2(lo[2], lo[3]), pk2(lo[4], lo[5]), pk2(lo[6], lo[7])};
        bf16* row = WT + (size_t)(n0 + n) * 3072 + k0 + 8 * c;
        *(GAS v4u*)(row) = oh; *(GAS v4u*)(row + 1024) = ol; *(GAS v4u*)(row + 2048) = oh; }
    LDS_WAIT(); asm volatile("" ::: "memory");
}
template <int MAP> __device__ __forceinline__ void tr_item(const float* W, int K, int N, bf16* WT, int row_off, int item, LAS float* scr, int lane) {
    const int nblk = N / 32, kb = item / nblk, nb = item - kb * nblk, k0 = 64 * kb, n0 = 32 * nb;
    const int drow0 = (MAP == 0) ? row_off + n0 : (n0 >> 7) * 256 + (n0 & 127) + row_off;
    tr_block(W, N, k0, n0, WT, K, drow0, scr, lane);
}

#define PHASE_IDS() int tid_ = threadIdx.x; asm volatile("" : "+v"(tid_)); const int lane = tid_ & 63, wave = __builtin_amdgcn_readfirstlane(tid_ >> 6); const int G = gridDim.x, bx = blockIdx.x; \
    const int vcu = (G % 8 == 0) ? (bx % 8) * (G / 8) + bx / 8 : bx; const int gw = vcu * NWAVES + wave, NGW = G * NWAVES; (void)lane; (void)wave; (void)gw; (void)NGW; (void)vcu
__device__ __forceinline__ void phase_prologue(KArgs a, LAS unsigned char* lds) {
    PHASE_IDS();
    unsigned char* ws = a->ws;
    LAS float* scr = (LAS float*)(lds + RING_OFF + wave * 16384);
    constexpr int I_QKV = 16 * 96, I_GATE = 16 * 96, I_BR = 8 * 32, I_OUT = 16 * 32, I_R = 16 * 4, I_S1 = 16 * 8, I_S2 = 4 * 32;
    constexpr int PER_L = I_QKV + I_GATE + 3 * I_BR + I_OUT + I_R + 2 * I_S1 + I_S2;
    for (int it = gw; it < NL * PER_L; it += NGW) {
        const int l = it / PER_L; int r = it - l * PER_L; unsigned char* wl = ws + WS_WSM + (size_t)l * WSM_LAYER;
        if (r < I_QKV) { tr_item<0>(a->in[I_WQKV] + (size_t)l * D * QKVW, D, QKVW, (bf16*)(wl + WL_QKV), 0, r, scr, lane); continue; } r -= I_QKV;
        if (r < I_GATE) { tr_item<0>(a->in[I_WGATE] + (size_t)l * D * 3072, D, 3072, (bf16*)(wl + WL_GATE), 0, r, scr, lane); continue; } r -= I_GATE;
        if (r < I_BR) { tr_item<0>(a->in[I_WBRA] + (size_t)l * 512 * D, 512, D, (bf16*)(wl + WL_BR), 0, r, scr, lane); continue; } r -= I_BR;
        if (r < I_BR) { tr_item<0>(a->in[I_WBRB] + (size_t)l * 512 * D, 512, D, (bf16*)(wl + WL_BR + 1 * MiB), 0, r, scr, lane); continue; } r -= I_BR;
        if (r < I_BR) { tr_item<0>(a->in[I_WBRC] + (size_t)l * 512 * D, 512, D, (bf16*)(wl + WL_BR + 2 * MiB), 0, r, scr, lane); continue; } r -= I_BR;
        if (r < I_OUT) { tr_item<0>(a->in[I_WOUT] + (size_t)l * D * D, D, D, (bf16*)(wl + WL_OUT), 0, r, scr, lane); continue; } r -= I_OUT;
        if (r < I_R) { tr_item<0>(a->in[I_WR] + (size_t)l * D * NE, D, NE, (bf16*)(wl + WL_R), 0, r, scr, lane); continue; } r -= I_R;
        if (r < I_S1) { tr_item<1>(a->in[I_WS1] + (size_t)l * D * 256, D, 256, (bf16*)(wl + WL_S13), 0, r, scr, lane); continue; } r -= I_S1;
        if (r < I_S1) { tr_item<1>(a->in[I_WS3] + (size_t)l * D * 256, D, 256, (bf16*)(wl + WL_S13), 128, r, scr, lane); continue; } r -= I_S1;
        tr_item<0>(a->in[I_WS2] + (size_t)l * 256 * D, 256, D, (bf16*)(wl + WL_S2), 0, r, scr, lane);
    }
    for (int it = gw; it < NL * 128; it += NGW) { const int l = it >> 7, row = 128 + (it & 127); GAS v4u* p = (GAS v4u*)(ws + WS_WSM + (size_t)l * WSM_LAYER + WL_R + (size_t)row * 2048);
        p[lane] = (v4u){0u, 0u, 0u, 0u}; p[64 + lane] = (v4u){0u, 0u, 0u, 0u}; }
    { f32x2* rope = (f32x2*)(ws + WS_ROPE);
      for (int i = gw * 64 + lane; i < SEQ * 32; i += NGW * 64) { const int t = i >> 5, ax = (i >> 4) & 1, f = i & 15;
          const float pos = (float)(ax == 0 ? (t >> 6) : (t & 63)); const float invf = powf(10000.0f, -(float)f / 16.0f); const float ang = pos * invf;
          rope[i] = (f32x2){(float)cos((double)ang), (float)sin((double)ang)}; } }
    if (gw == 0 && lane < NL) { const int l = lane; float d1 = 0.f, d2 = 0.f;
        for (int i = 0; i < 64; ++i) { d1 += a->in[I_LQ1][l * 64 + i] * a->in[I_LK1][l * 64 + i]; d2 += a->in[I_LQ2][l * 64 + i] * a->in[I_LK2][l * 64 + i]; }
        const float li = 0.8f - 0.6f * expf(-0.3f * (float)l); float* lp = (float*)(ws + WS_LAYP) + l * 4;
        lp[0] = expf(d1) - expf(d2) + li; lp[1] = li; lp[2] = 1.0f - li; lp[3] = 0.f; }
    { const GAS f32x4* s = (const GAS f32x4*)a->in[I_X]; GAS f32x4* d = (GAS f32x4*)a->out; const size_t n4 = (size_t)NB * SEQ * D / 4;
      for (size_t i = (size_t)gw * 64 + lane; i < n4; i += (size_t)NGW * 64) d[i] = s[i];
      const GAS f32x4* s2 = (const GAS f32x4*)a->in[I_CTX]; GAS f32x4* d2 = (GAS f32x4*)(ws + WS_XC); const size_t m4 = (size_t)NB * TCTX * D / 4;
      for (size_t i = (size_t)gw * 64 + lane; i < m4; i += (size_t)NGW * 64) d2[i] = s2[i]; }
    __syncthreads();
    { LAS float* red = (LAS float*)(lds + RING_OFF);
      float* MOD = (float*)(ws + WS_MOD);
      for (int item = blockIdx.x; item < NL * 96; item += gridDim.x) {
          const int l = item / 96, n0 = (item - l * 96) * 64;
          float acc[9];
#pragma unroll
          for (int m = 0; m < 9; ++m) acc[m] = 0.f;
          const float* wm = a->in[I_WMOD] + (size_t)l * D * 6144 + n0 + lane;
          for (int k = wave * 128; k < wave * 128 + 128; ++k) { const float w = wm[(size_t)k * 6144];
#pragma unroll
              for (int m = 0; m < 9; ++m) { const float cv = (m < 8) ? a->in[I_C][m * D + k] : a->in[I_CCTX][k]; const float s = cv / (1.0f + expf(-cv)); acc[m] += s * w; } }
#pragma unroll
          for (int m = 0; m < 9; ++m) red[(wave * 9 + m) * 64 + lane] = acc[m];
          __syncthreads();
          for (int idx = threadIdx.x; idx < 9 * 64; idx += NWAVES * 64) { const int m = idx >> 6, ln = idx & 63; float s = 0.f;
#pragma unroll
              for (int w = 0; w < 8; ++w) s += red[(w * 9 + m) * 64 + ln];
              MOD[((size_t)l * 9 + m) * 6144 + n0 + ln] = s + a->in[I_BMOD][l * 6144 + n0 + ln]; }
          __syncthreads();
      } }
}

__device__ __forceinline__ void moe_tables(LAS unsigned char* lds, const unsigned* cnt, bool want_te) {
    LAS int* tb = (LAS int*)(lds + MOE_OFF); LAS int* cn = tb + 132; LAS unsigned short* te = (LAS unsigned short*)(cn + 128);
    int tid = threadIdx.x; asm volatile("" : "+v"(tid));
    __syncthreads();
    if (tid < NE) cn[tid] = (int)__hip_atomic_load(cnt + tid, RLX_AGENT);
    __syncthreads();
    if (tid == 0) { int s = 0; for (int e = 0; e < NE; ++e) { tb[e] = s; s += (cn[e] + 255) >> 8; } tb[NE] = s; }
    __syncthreads();
    if (want_te && tid < NE) { const int t0 = tb[tid], t1 = tb[tid + 1]; for (int t = t0; t < t1; ++t) te[t] = (unsigned short)tid; }
    __syncthreads();
}

__device__ __forceinline__ void ld8f(const float* p, int lane, f32x4 (&v)[4]) { const GAS f32x4* q = (const GAS f32x4*)p; v[0] = q[2 * lane]; v[1] = q[2 * lane + 1]; v[2] = q[128 + 2 * lane]; v[3] = q[128 + 2 * lane + 1]; }
__device__ __forceinline__ void st8f(float* p, int lane, const f32x4 (&v)[4]) { GAS f32x4* q = (GAS f32x4*)p; q[2 * lane] = v[0]; q[2 * lane + 1] = v[1]; q[128 + 2 * lane] = v[2]; q[128 + 2 * lane + 1] = v[3]; }
__device__ __forceinline__ void unpk8(const v4u u, f32x4& a, f32x4& b) { a = (f32x4){bflo(u.x), bfhi(u.x), bflo(u.y), bfhi(u.y)}; b = (f32x4){bflo(u.z), bfhi(u.z), bflo(u.w), bfhi(u.w)}; }
__device__ __forceinline__ v4u pk8(const f32x4 a, const f32x4 b) { return (v4u){pk2(a.x, a.y), pk2(a.z, a.w), pk2(b.x, b.y), pk2(b.z, b.w)}; }
template <int KIND> __device__ __forceinline__ void phase_norm(KArgs a, LAS unsigned char* lds, int l) {
    PHASE_IDS();
    unsigned char* ws = a->ws; float* XL = a->out; float* XC = (float*)(ws + WS_XC);
    const float* MOD = (const float*)(ws + WS_MOD);
    const bool comb = (KIND == 2) || (KIND == 0 && l > 0); const int lc = (KIND == 2) ? NL - 1 : l - 1;
    if (comb) moe_tables(lds, (const unsigned*)(ws + WS_CTL) + CW_CNT + lc * NE, false);
    const LAS int* tb = (const LAS int*)(lds + MOE_OFF);
    const bf16* YR = (const bf16*)(ws + WS_YR); const int* EP = (const int*)(ws + WS_EP); const float* WT = (const float*)(ws + WS_WT);
    bf16* A = (bf16*)(ws + WS_A);
    const float* gvec = (KIND == 0) ? a->in[I_G1] + l * D : (KIND == 1) ? a->in[I_G2] + l * D : a->in[I_GF];
    f32x4 gv[4]; ld8f(gvec, lane, gv);
    constexpr int NR = 2;
    for (int r0 = gw; r0 < R; r0 += NR * NGW) {
        int rr[NR], mbv[NR]; bool live[NR]; float* xr[NR]; f32x4 v[NR][4];
#pragma unroll
        for (int u = 0; u < NR; ++u) { const int r = r0 + u * NGW; live[u] = r < R; rr[u] = live[u] ? r : r0; const int b = rr[u] / RB, j = rr[u] - b * RB; mbv[u] = (j < TCTX) ? 8 : b;
            if (KIND == 2 && j < TCTX) live[u] = false; xr[u] = xrow_ptr(XL, XC, rr[u]); ld8f(xr[u], lane, v[u]); }
        if (comb) {
            int slot[NR]; float w[NR];
#pragma unroll
            for (int u = 0; u < NR; ++u) { slot[u] = 0; w[u] = 0.f; if (lane < TOPK) { const int ep = EP[(size_t)rr[u] * 8 + lane]; slot[u] = tb[ep >> 17] * 256 + (ep & 0x1ffff); w[u] = WT[(size_t)rr[u] * 8 + lane]; } }
            f32x4 acc[NR][4];
#pragma unroll
            for (int u = 0; u < NR; ++u)
#pragma unroll
                for (int q = 0; q < 4; ++q) acc[u][q] = (f32x4){0.f, 0.f, 0.f, 0.f};
#pragma unroll
            for (int k = 0; k < TOPK; ++k)
#pragma unroll
                for (int u = 0; u < NR; ++u) { const int sk = lane_i(slot[u], k); const float wk = lane_f(w[u], k); const GAS v4u* yr = (const GAS v4u*)(YR + (size_t)sk * D);
                    f32x4 t0, t1, t2, t3; unpk8(yr[lane], t0, t1); unpk8(yr[64 + lane], t2, t3); acc[u][0] += wk * t0; acc[u][1] += wk * t1; acc[u][2] += wk * t2; acc[u][3] += wk * t3; }
#pragma unroll
            for (int u = 0; u < NR; ++u) { f32x4 g2[4]; ld8f(MOD + ((size_t)lc * 9 + mbv[u]) * 6144 + 5 * D, lane, g2);
#pragma unroll
                for (int q = 0; q < 4; ++q) v[u][q] += g2[q] * acc[u][q];
                if (KIND != 2 && live[u]) st8f(xr[u], lane, v[u]); }
        }
#pragma unroll
        for (int u = 0; u < NR; ++u) {
            float s = 0.f;
#pragma unroll
            for (int q = 0; q < 4; ++q) s += (v[u][q].x * v[u][q].x + v[u][q].y * v[u][q].y) + (v[u][q].z * v[u][q].z + v[u][q].w * v[u][q].w);
            const float rs = 1.0f / sqrtf(wave_sum(s) * (1.f / D) + EPS);
            if (KIND == 2) { f32x4 o[4];
#pragma unroll
                for (int q = 0; q < 4; ++q) o[q] = v[u][q] * rs * gv[q];
                if (live[u]) st8f(xr[u], lane, o);
            } else {
                const float* md = MOD + ((size_t)l * 9 + mbv[u]) * 6144 + (KIND == 0 ? 0 : 3 * D);
                f32x4 sh[4], sc[4], y[4]; ld8f(md, lane, sh); ld8f(md + D, lane, sc);
#pragma unroll
                for (int q = 0; q < 4; ++q) y[q] = (v[u][q] * rs) * gv[q] * (sc[q] + 1.0f) + sh[q];
                if (live[u]) { GAS v4u* o16 = (GAS v4u*)(A + (size_t)rr[u] * D); o16[lane] = pk8(y[0], y[1]); o16[64 + lane] = pk8(y[2], y[3]); }
            }
        }
    }
}

__device__ __forceinline__ void phase_convert_experts(KArgs a, LAS unsigned char* lds, int l) {
    PHASE_IDS();
    LAS float* scr = (LAS float*)(lds + RING_OFF + wave * 16384);
    bf16* E13 = (bf16*)(a->ws + WS_E13); bf16* E2 = (bf16*)(a->ws + WS_E2);
    for (int it = gw; it < NE * 384; it += NGW) { const int e = it / 384; int r = it - e * 384;
        if (r < 128) { tr_item<1>(a->in[I_W1] + ((size_t)l * NE + e) * D * 256, D, 256, E13 + (size_t)e * 512 * D, 0, r, scr, lane); continue; } r -= 128;
        if (r < 128) { tr_item<1>(a->in[I_W3] + ((size_t)l * NE + e) * D * 256, D, 256, E13 + (size_t)e * 512 * D, 128, r, scr, lane); continue; } r -= 128;
        tr_item<0>(a->in[I_W2] + ((size_t)l * NE + e) * 256 * D, 256, D, E2 + (size_t)e * D * 256, 0, r, scr, lane); }
}

__device__ __forceinline__ void phase_qkv_post(KArgs a, int l) {
    PHASE_IDS();
    bf16* QKV = (bf16*)(a->ws + WS_QKV); const f32x2* rope = (const f32x2*)(a->ws + WS_ROPE);
    const int j = lane & 7;
    float gq[8], gk[8];
#pragma unroll
    for (int i = 0; i < 8; ++i) { gq[i] = a->in[I_GQA][l * 64 + j * 8 + i]; gk[i] = a->in[I_GKA][l * 64 + j * 8 + i]; }
    for (int r = gw; r < R; r += NGW) {
        const int b = r / RB, jr = r - b * RB; const bool lat = jr >= TCTX; const int t = lat ? jr - TCTX : 0;
        GAS v4u* prow = (GAS v4u*)(QKV + (size_t)r * QKVW);
        v4u raw[6];
#pragma unroll
        for (int pass = 0; pass < 6; ++pass) raw[pass] = prow[pass * 64 + lane];
        f32x2 cs[8]; { const f32x2* cp = rope + ((size_t)t * 2 + (j >> 2)) * 16 + 8 * (j & 1);
#pragma unroll
            for (int i = 0; i < 8; ++i) cs[i] = cp[i]; }
#pragma unroll
        for (int pass = 0; pass < 6; ++pass) {
            const int s = pass * 8 + (lane >> 3);
            int kind, nrm = 0;
            if (s < 8) { kind = 1; nrm = 1; } else if (s < 10) { kind = 2; nrm = 2; } else if (s < 12) kind = 0; else if (s < 20) kind = 1; else if (s < 22) kind = 2; else if (s < 24) kind = 0;
            else if (s < 32) kind = 1; else if (s < 40) kind = 2; else kind = 0;
            if (pass == 5) continue;
            const v4u rw = raw[pass];
            float x[8] = {bflo(rw.x), bfhi(rw.x), bflo(rw.y), bfhi(rw.y), bflo(rw.z), bfhi(rw.z), bflo(rw.w), bfhi(rw.w)};
            if (pass < 2) {
                float ss = 0.f;
#pragma unroll
                for (int i = 0; i < 8; ++i) ss += x[i] * x[i];
                ss += xor_f<1>(ss); ss += xor_f<2>(ss); ss += xor_f<4>(ss);
                if (nrm) { const float rs = 1.0f / sqrtf(ss * (1.f / 64.f) + EPS);
#pragma unroll
                    for (int i = 0; i < 8; ++i) x[i] = x[i] * rs * (nrm == 1 ? gq[i] : gk[i]); } }
            float px[8];
#pragma unroll
            for (int i = 0; i < 8; ++i) px[i] = xor_f<2>(x[i]);
            if (lat && kind != 0) {
#pragma unroll
                for (int i = 0; i < 8; ++i) { const f32x2 c = cs[i]; x[i] = (j & 2) ? (px[i] * c.y + x[i] * c.x) : (x[i] * c.x - px[i] * c.y); } }
            if (kind == 1) {
#pragma unroll
                for (int i = 0; i < 8; ++i) x[i] *= attn_body::C2; }
            if (kind != 0) prow[pass * 64 + lane] = (v4u){pk2(x[0], x[1]), pk2(x[2], x[3]), pk2(x[4], x[5]), pk2(x[6], x[7])};
        }
    }
}

__device__ __forceinline__ void phase_c_combine(KArgs a, int l) {
    PHASE_IDS();
    const bf16* OC = (const bf16*)(a->ws + WS_OC); bf16* YC = (bf16*)(a->ws + WS_YC);
    const float* lp = (const float*)(a->ws + WS_LAYP) + l * 4; const float lam = lp[0], om = lp[2];
    const int hc = lane >> 4, w = lane & 15;
    float g[8];
#pragma unroll
    for (int i = 0; i < 8; ++i) g[i] = a->in[I_GSUB][l * 128 + w * 8 + i] * om;
    constexpr int NR = 4;
    for (int r0 = gw; r0 < R; r0 += NR * NGW) {
        v4u u1[NR], u2[NR]; int rr[NR]; bool live[NR];
#pragma unroll
        for (int u = 0; u < NR; ++u) { const int r = r0 + u * NGW; live[u] = r < R; rr[u] = live[u] ? r : r0; const GAS v4u* p = (const GAS v4u*)(OC + (size_t)rr[u] * D); u1[u] = p[hc * 32 + w]; u2[u] = p[hc * 32 + 16 + w]; }
#pragma unroll
        for (int u = 0; u < NR; ++u) { f32x4 a0, a1, b0, b1; unpk8(u1[u], a0, a1); unpk8(u2[u], b0, b1); const f32x4 d0 = a0 - lam * b0, d1 = a1 - lam * b1;
            float ss = (d0.x * d0.x + d0.y * d0.y) + (d0.z * d0.z + d0.w * d0.w) + (d1.x * d1.x + d1.y * d1.y) + (d1.z * d1.z + d1.w * d1.w);
            ss += xor_f<1>(ss); ss += xor_f<2>(ss); ss += xor_f<4>(ss); ss += xor_f<8>(ss);
            const float rs = 1.0f / sqrtf(ss * (1.f / 128.f) + EPS);
            const f32x4 y0 = (f32x4){d0.x * g[0], d0.y * g[1], d0.z * g[2], d0.w * g[3]} * rs, y1 = (f32x4){d1.x * g[4], d1.y * g[5], d1.z * g[6], d1.w * g[7]} * rs;
            if (live[u]) ((GAS v4u*)(YC + (size_t)rr[u] * 512))[lane] = pk8(y0, y1); }
    }
}

__device__ __forceinline__ float seg16_max(float v) { v = fmaxf(v, xor_f<1>(v)); v = fmaxf(v, xor_f<2>(v)); v = fmaxf(v, xor_f<4>(v)); v = fmaxf(v, xor_f<8>(v)); return v; }
__device__ __forceinline__ float seg_top2sum(float v, int lane) {
    const float m1 = seg16_max(v);
    const unsigned long long bal = __ballot(v == m1);
    const unsigned seg = (unsigned)(bal >> (lane & 48)) & 0xffffu;
    const int first = __ffs((int)seg) - 1;
    const float v2 = ((lane & 15) == first) ? -INFINITY : v;
    return m1 + seg16_max(v2);
}
__device__ __forceinline__ void phase_topk(KArgs a, int l) {
    PHASE_IDS();
    const float* LG = (const float*)(a->ws + WS_LOG); int* EP = (int*)(a->ws + WS_EP); float* WT = (float*)(a->ws + WS_WT); int* LIST = (int*)(a->ws + WS_LIST);
    unsigned* cnt = (unsigned*)(a->ws + WS_CTL) + CW_CNT + l * NE;
    const float eb0 = a->in[I_EBIAS][l * NE + lane], eb1 = a->in[I_EBIAS][l * NE + 64 + lane];
    int pr = -1, pe = 0; unsigned ppos = 0u;
    float lg0 = 0.f, lg1 = 0.f; if (gw < R) { lg0 = LG[(size_t)gw * NE + lane]; lg1 = LG[(size_t)gw * NE + 64 + lane]; }
    for (int r = gw; r < R; r += NGW) {
        const float x0 = lg0, x1 = lg1;
        if (r + NGW < R) { lg0 = LG[(size_t)(r + NGW) * NE + lane]; lg1 = LG[(size_t)(r + NGW) * NE + 64 + lane]; }
        const float s0 = 1.0f / (1.0f + expf(-x0)), s1 = 1.0f / (1.0f + expf(-x1));
        const float c0 = s0 + eb0, c1 = s1 + eb1;
        const float gs0 = seg_top2sum(c0, lane), gs1 = seg_top2sum(c1, lane);
        float g[8];
#pragma unroll
        for (int k = 0; k < 4; ++k) { g[k] = lane_f(gs0, 16 * k); g[4 + k] = lane_f(gs1, 16 * k); }
        bool selA = false, selB = false;
#pragma unroll
        for (int k = 0; k < 8; ++k) { int rank = 0;
#pragma unroll
            for (int k2 = 0; k2 < 8; ++k2) rank += (g[k2] > g[k] || (g[k2] == g[k] && k2 < k)) ? 1 : 0;
            const bool sel = rank < 4;
            if (k < 4) { if ((lane >> 4) == k) selA = sel; } else { if ((lane >> 4) == k - 4) selB = sel; } }
        float m0 = selA ? c0 : -INFINITY, m1 = selB ? c1 : -INFINITY;
        int my_e = 0; float my_s = 0.f, ssum = 0.f;
#pragma unroll
        for (int k = 0; k < TOPK; ++k) {
            const float m = wave_max(fmaxf(m0, m1));
            const unsigned long long b0 = __ballot(m0 == m);
            int idx; if (b0) idx = __ffsll((long long)b0) - 1; else { const unsigned long long b1 = __ballot(m1 == m); idx = 64 + __ffsll((long long)b1) - 1; }
            idx = __builtin_amdgcn_readfirstlane(idx);
            const float sc = (idx < 64) ? lane_f(s0, idx) : lane_f(s1, idx - 64);
            if (lane == (idx & 63)) { if (idx < 64) m0 = -INFINITY; else m1 = -INFINITY; }
            ssum += sc; if (lane == k) { my_e = idx; my_s = sc; }
        }
        if (lane < TOPK) {
            if (pr >= 0) { LIST[(size_t)pe * CAP + ppos] = pr; EP[(size_t)pr * 8 + lane] = (pe << 17) | (int)ppos; }
            ppos = __hip_atomic_fetch_add(cnt + my_e, 1u, RLX_AGENT); pr = r; pe = my_e;
            WT[(size_t)r * 8 + lane] = my_s / ssum * 2.5f; }
    }
    if (lane < TOPK && pr >= 0) { LIST[(size_t)pe * CAP + ppos] = pr; EP[(size_t)pr * 8 + lane] = (pe << 17) | (int)ppos; }
}

struct MoeOrder {
    int NCT, G, c, ntile; const LAS int* tb; const LAS int* cn; const LAS unsigned short* te; const int* list;
    __device__ __forceinline__ void init(LAS unsigned char* lds, int NCT_, int G_, int c_, const int* list_) { tb = (const LAS int*)(lds + MOE_OFF); cn = tb + 132; te = (const LAS unsigned short*)(cn + 128);
        NCT = NCT_; G = G_; c = c_; list = list_; ntile = tb[NE]; }
    __device__ __forceinline__ bool next(int i, pg8::Unit& u) const {
        const int L = i * G + c; if (L >= ntile * NCT) return false;
        const int tile = L / NCT, ct = L - tile * NCT, e = te[tile];
        u.pm = tile; u.pn = e * NCT + ct; u.om = tile; u.on = ct; u.aux = e; return true; }
    __device__ __forceinline__ unsigned arow(const pg8::Unit& u, int h, int Rl) const {
        int p = (u.om - tb[u.aux]) * 256 + h * 128 + Rl; const int c1 = cn[u.aux] - 1; p = p < c1 ? p : c1;
        return (unsigned)list[(size_t)u.aux * CAP + p]; }
};

__device__ __forceinline__ void phase_attn(KArgs a, char* lds, int l) {
    const int G = gridDim.x, bx = blockIdx.x; const int vcu = (G % 8 == 0) ? (bx % 8) * (G / 8) + bx / 8 : bx;
    typedef attn_body::bf16 abf;
    const abf* QKV = (const abf*)(a->ws + WS_QKV); abf* YA = (abf*)(a->ws + WS_YA); abf* YB = (abf*)(a->ws + WS_YB); abf* OC = (abf*)(a->ws + WS_OC);
    const float* sink = a->in[I_SINK] + l * 8;
    for (int f = vcu; f < 6144 + 256; f += G) {
        int qcol, kcol, vcol, ocol, PO, NT; size_t qrow, krow; abf* O; float sk2 = -INFINITY;
        if (f < 6144) { const int blk = f >> 8, v = f & 255, b = blk / 3, ri = blk - 3 * b, grp = v >> 5, qb = v & 31;
            qrow = (size_t)b * RB + TCTX + (size_t)qb * 256; krow = (size_t)b * RB; NT = RB / 64;
            if (ri == 0) { qcol = grp * 64; kcol = 512 + (grp >> 2) * 64; vcol = 640 + (grp >> 2) * 64; O = YA; PO = 512; ocol = grp * 64; }
            else { const int combo = (ri - 1) * 8 + grp, s = combo >> 1, vh = combo & 1; qcol = 1536 + s * 64; kcol = 2048 + s * 64; vcol = 2560 + (s >> 1) * 128 + vh * 64; O = OC; PO = 1024; ocol = s * 128 + vh * 64; }
        } else { const int c = f - 6144, b = c >> 5, k = c & 31; qrow = (size_t)b * RB; krow = qrow; NT = TCTX / 64;
            if (k < 8) { qcol = k * 64; kcol = 512 + (k >> 2) * 64; vcol = 640 + (k >> 2) * 64; O = YA; PO = 512; ocol = k * 64; }
            else if (k < 16) { const int h = k - 8; qcol = 768 + h * 64; kcol = 1280 + (h >> 2) * 64; vcol = 1408 + (h >> 2) * 64; O = YB; PO = 512; ocol = h * 64; sk2 = sink[h] * LOG2E; }
            else { const int s = (k - 16) >> 1, vh = (k - 16) & 1; qcol = 1536 + s * 64; kcol = 2048 + s * 64; vcol = 2560 + (s >> 1) * 128 + vh * 64; O = OC; PO = 1024; ocol = s * 128 + vh * 64; }
        }
        attn_body::attn_unit<0, 8>(QKV + qrow * QKVW + qcol, QKV + krow * QKVW + kcol, QKV + krow * QKVW + vcol, O + qrow * PO + ocol, PO, NT, 0, 0, sk2, lds);
    }
    for (int w = vcu; w < 2048; w += G) {
        const int b = w >> 8, v = w & 255, h = v >> 5, qb = v & 31, q0 = qb * 256;
        const int wstart = (q0 - 128 > 0) ? q0 - 128 : 0, wend = (q0 + 384 < SEQ) ? q0 + 384 : SEQ, NT = 4 + (wend - wstart) / 64;
        const size_t qrow = (size_t)b * RB + TCTX + q0, krow = (size_t)b * RB;
        attn_body::attn_unit<1, 8>(QKV + qrow * QKVW + 768 + h * 64, QKV + krow * QKVW + 1280 + (h >> 2) * 64, QKV + krow * QKVW + 1408 + (h >> 2) * 64, YB + qrow * 512 + h * 64, 512, NT, wstart, wstart - q0, sink[h] * LOG2E, lds);
    }
}
#ifndef MK_PHMASK
#define MK_PHMASK 0xffff
#endif
#define PHE(p) ((MK_PHMASK >> (p)) & 1)
__global__ void __launch_bounds__(NWAVES * 64, 2) mk_fwd(Args args) {
    extern __shared__ __attribute__((aligned(16))) unsigned char lds_raw[];
    LAS unsigned char* lds = (LAS unsigned char*)lds_raw;
    const KArgs ka = (KArgs)__builtin_amdgcn_kernarg_segment_ptr();
#define KA() ({ KArgs _p = ka; asm volatile("" : "+s"(_p)); _p; })
#define WSP(off) (KA()->ws + (off))
    for (int u = threadIdx.x; u < (LDS_BYTES - LDSCTL_OFF) / 4; u += NWAVES * 64) ((LAS unsigned*)(lds + LDSCTL_OFF))[u] = 0u;
    __syncthreads();
    XcdBarrier bar; bar.bar = (unsigned*)(args.ws + WS_CTL) + CW_BAR; bar.x = 0; bar.st = nullptr;
    if (!MK_MULTI) bar = xcd_barrier_post((unsigned*)(args.ws + WS_CTL) + CW_BAR, (volatile LAS unsigned*)(lds + MISC_OFF) + 8);
    const int lo = args.ph_lo, hi = args.ph_hi;
#define IN(k) (lo <= (k) && (k) < hi)
#define SEAM(k) do { if (!MK_MULTI) { if (IN(k) && IN((k) + 1)) xcd_barrier(bar); } } while (0)
#define GRID_IDS() const int G = gridDim.x, bx = blockIdx.x; const int vcu = (G % 8 == 0) ? (bx % 8) * (G / 8) + bx / 8 : bx; (void)vcu
#define WL(l, off) (const bf16*)(WSP(WS_WSM + (size_t)(l) * WSM_LAYER + (off)))

    if (PHE(13) && IN(0)) { phase_prologue(KA(), lds); } SEAM(0);

    for (int l = 0; l < NL; ++l) {
        const int p0 = 1 + l * PH_PER_LAYER;
        if (p0 + PH_PER_LAYER <= lo || p0 >= hi) continue;
        if (PHE(0) && IN(p0 + 0)) { phase_norm<0>(KA(), lds, l); phase_convert_experts(KA(), lds, l); } SEAM(p0 + 0);
        if (PHE(1) && IN(p0 + 1)) { GRID_IDS(); pg8::Gemm g{(const bf16*)WSP(WS_A), WL(l, WL_QKV), D}; pg8::StaticOrder S; S.init(NPAN, QKVW / 256, G, bx);
            pg8::EpiBf16<0> E{(bf16*)WSP(WS_QKV), QKVW, nullptr};
            pg8::gemm_phase<pg8::EpiBf16<0>, pg8::StaticOrder, true, false>(lds + RING_OFF, g, S, E); } SEAM(p0 + 1);
        if (PHE(2) && IN(p0 + 2)) { phase_qkv_post(KA(), l); } SEAM(p0 + 2);
        if (PHE(3) && IN(p0 + 3)) { phase_attn(KA(), (char*)lds_raw + RING_OFF, l); } SEAM(p0 + 3);
        if (PHE(4) && IN(p0 + 4)) { phase_c_combine(KA(), l); } SEAM(p0 + 4);
        if (PHE(5) && IN(p0 + 5)) { GRID_IDS(); pg8::Gemm g{(const bf16*)WSP(WS_A), WL(l, WL_GATE), D}; pg8::StaticOrder S; S.init(NPAN, 12, G, bx);
            pg8::EpiBf16<1> E{(bf16*)WSP(WS_QKV), QKVW, KA()->in[I_BGATE] + l * 3072};
            pg8::gemm_phase<pg8::EpiBf16<1>, pg8::StaticOrder, true, false>(lds + RING_OFF, g, S, E); } SEAM(p0 + 5);
        if (PHE(6) && IN(p0 + 6)) {
            { GRID_IDS(); pg8::StaticOrder S; S.init(NPAN, 4, G, bx); pg8::Gemm g{(const bf16*)WSP(WS_YA), WL(l, WL_BR), 512}; pg8::EpiBranch<0> E{(const bf16*)WSP(WS_QKV), (bf16*)WSP(WS_MG)};
              pg8::gemm_phase<pg8::EpiBranch<0>, pg8::StaticOrder, true, false>(lds + RING_OFF, g, S, E); }
            { GRID_IDS(); pg8::StaticOrder S; S.init(NPAN, 4, G, bx); pg8::Gemm g{(const bf16*)WSP(WS_YB), WL(l, WL_BR + 1 * MiB), 512}; pg8::EpiBranch<1> E{(const bf16*)WSP(WS_QKV), (bf16*)WSP(WS_MG)};
              pg8::gemm_phase<pg8::EpiBranch<1>, pg8::StaticOrder, true, false>(lds + RING_OFF, g, S, E); }
            { GRID_IDS(); pg8::StaticOrder S; S.init(NPAN, 4, G, bx); pg8::Gemm g{(const bf16*)WSP(WS_YC), WL(l, WL_BR + 2 * MiB), 512}; pg8::EpiBranch<2> E{(const bf16*)WSP(WS_QKV), (bf16*)WSP(WS_MG)};
              pg8::gemm_phase<pg8::EpiBranch<2>, pg8::StaticOrder, true, false>(lds + RING_OFF, g, S, E); } } SEAM(p0 + 6);
        if (PHE(7) && IN(p0 + 7)) { GRID_IDS(); pg8::Gemm g{(const bf16*)WSP(WS_MG), WL(l, WL_OUT), D}; pg8::StaticOrder S; S.init(NPAN, 4, G, bx);
            pg8::EpiResid E{KA()->out, (float*)WSP(WS_XC), (const float*)WSP(WS_MOD) + (size_t)l * 9 * 6144, 2 * D};
            pg8::gemm_phase<pg8::EpiResid, pg8::StaticOrder, true, false>(lds + RING_OFF, g, S, E); } SEAM(p0 + 7);
        if (PHE(8) && IN(p0 + 8)) { phase_norm<1>(KA(), lds, l); } SEAM(p0 + 8);
        if (PHE(9) && IN(p0 + 9)) { GRID_IDS(); pg8::Gemm g{(const bf16*)WSP(WS_A), WL(l, WL_R), D}; pg8::StaticOrder S; S.init(NPAN, 1, G, bx);
            pg8::EpiRouter E{(float*)WSP(WS_LOG)};
            pg8::gemm_phase<pg8::EpiRouter, pg8::StaticOrder, true, false>(lds + RING_OFF, g, S, E); } SEAM(p0 + 9);
        if (PHE(10) && IN(p0 + 10)) { phase_topk(KA(), l); } SEAM(p0 + 10);
        if (PHE(11) && IN(p0 + 11)) { moe_tables(lds, (const unsigned*)WSP(WS_CTL) + CW_CNT + l * NE, true);
            { GRID_IDS(); pg8::Gemm g{(const bf16*)WSP(WS_A), (const bf16*)WSP(WS_E13), D}; MoeOrder S; S.init(lds, 2, G, vcu, (const int*)WSP(WS_LIST)); pg8::EpiUp E{(bf16*)WSP(WS_HR)};
              pg8::gemm_phase<pg8::EpiUp, MoeOrder, true, true>(lds + RING_OFF, g, S, E); }
            { GRID_IDS(); pg8::Gemm g{(const bf16*)WSP(WS_A), WL(l, WL_S13), D}; pg8::StaticOrder S; S.init(NPAN, 2, G, bx); pg8::EpiUp E{(bf16*)WSP(WS_HS)};
              pg8::gemm_phase<pg8::EpiUp, pg8::StaticOrder, true, false>(lds + RING_OFF, g, S, E); } } SEAM(p0 + 11);
        if (PHE(12) && IN(p0 + 12)) { moe_tables(lds, (const unsigned*)WSP(WS_CTL) + CW_CNT + l * NE, true);
            { GRID_IDS(); pg8::Gemm g{(const bf16*)WSP(WS_HR), (const bf16*)WSP(WS_E2), 256}; MoeOrder S; S.init(lds, 4, G, vcu, (const int*)WSP(WS_LIST)); pg8::EpiBf16<0> E{(bf16*)WSP(WS_YR), D, nullptr};
              pg8::gemm_phase<pg8::EpiBf16<0>, MoeOrder, true, false>(lds + RING_OFF, g, S, E); }
            { GRID_IDS(); pg8::Gemm g{(const bf16*)WSP(WS_HS), WL(l, WL_S2), 256}; pg8::StaticOrder S; S.init(NPAN, 4, G, bx);
              pg8::EpiResid E{KA()->out, (float*)WSP(WS_XC), (const float*)WSP(WS_MOD) + (size_t)l * 9 * 6144, 5 * D};
              pg8::gemm_phase<pg8::EpiResid, pg8::StaticOrder, true, false>(lds + RING_OFF, g, S, E); } } SEAM(p0 + 12);
    }
    if (PHE(14) && IN(NPH - 1)) { phase_norm<2>(KA(), lds, NL); }
#undef IN
#undef SEAM
}

extern "C" void kernel_launch(void* const* d_in, const int* in_sizes, int n_in, void* d_out, int out_size, void* d_ws, size_t ws_size, hipStream_t stream) {
    static int grid = 0;
    if (grid == 0) {
        if (n_in != N_IN || out_size != NB * SEQ * D || ws_size < WS_END) { fprintf(stderr, "kernel_launch: unexpected shapes (n_in %d, out %d, ws %zu); nothing launched\n", n_in, out_size, ws_size); grid = -1; return; }
        int dev = 0, cus = 0, per_cu = 0;
        if (hipGetDevice(&dev) != hipSuccess || hipDeviceGetAttribute(&cus, hipDeviceAttributeMultiprocessorCount, dev) != hipSuccess) { grid = -1; return; }
        if (hipFuncSetAttribute((const void*)mk_fwd, hipFuncAttributeMaxDynamicSharedMemorySize, LDS_BYTES) != hipSuccess) { fprintf(stderr, "kernel_launch: hipFuncSetAttribute failed\n"); grid = -1; return; }
        if (hipOccupancyMaxActiveBlocksPerMultiprocessor(&per_cu, (const void*)mk_fwd, NWAVES * 64, LDS_BYTES) != hipSuccess || per_cu < 1) { fprintf(stderr, "kernel_launch: occupancy query says %d\n", per_cu); (void)hipGetLastError(); grid = -1; return; }
        grid = cus;
    }
    if (grid < 0) return;
    (void)hipMemsetAsync((char*)d_ws + WS_CTL, 0, CTL_ZERO_BYTES, stream);
    Args a{};
    for (int i = 0; i < N_IN; ++i) a.in[i] = (const float*)d_in[i];
    a.out = (float*)d_out; a.ws = (unsigned char*)d_ws;
#if MK_MULTI
    for (int ph = 0; ph < NPH; ++ph) {
        a.ph_lo = ph; a.ph_hi = ph + 1;
        hipLaunchKernelGGL(mk_fwd, dim3(grid), dim3(NWAVES * 64), LDS_BYTES, stream, a);
#if MK_CHECK
        dbg_after_phase(ph, a, stream);
#endif
    }
#else
    a.ph_lo = 0; a.ph_hi = NPH;
    hipLaunchKernelGGL(mk_fwd, dim3(grid), dim3(NWAVES * 64), LDS_BYTES, stream, a);
#endif
}
```

```cpp
#include <hip/hip_runtime.h>
#include <hip/hip_bf16.h>
#include <cstdio>
#include <cstdint>
#include <cmath>

#ifndef MK_MULTI
#define MK_MULTI 0
#endif
#ifndef MK_CHECK
#define MK_CHECK 0
#endif

namespace pg8 {
#define PG8_LAS __attribute__((address_space(3)))
typedef unsigned short bf16_t;
typedef short bf16x8 __attribute__((ext_vector_type(8)));
typedef float f32x4 __attribute__((ext_vector_type(4)));
typedef float f32x2 __attribute__((ext_vector_type(2)));
typedef unsigned u32x4 __attribute__((ext_vector_type(4))); typedef unsigned u32x2 __attribute__((ext_vector_type(2)));
typedef int v4i32 __attribute__((ext_vector_type(4)));
typedef int v8i32 __attribute__((ext_vector_type(8)));
constexpr int BM = 256, BK = 64, HALF = 128, HTB = HALF * BK * 2  , STAGE_BYTES = 8 * HTB, NXCD = 8, WGM = 8;

__host__ __device__ __forceinline__ int lds_byte(int r, int c) { const int st = (r >> 4) * 2 + (c >> 5), rr = r & 15, cc = c & 31, ob = rr * 64 + cc * 2; return st * 1024 + (ob ^ (((ob >> 9) & 1) << 5)); }
__host__ __device__ __forceinline__ void stage_rc(int b, int& R, int& C) { const int st = b / 1024, sb = b % 1024, swz = sb ^ (((sb >> 9) & 1) << 5); R = (st >> 1) * 16 + swz / 64; C = (st & 1) * 32 + (swz % 64) / 2; }
__host__ __device__ __forceinline__ int perm32(int rho) { const int n = rho >> 4, i = rho & 15; return 8 * (i >> 2) + 4 * n + (i & 3); }

struct Unit { int pm, pn, om, on, aux; };
struct Gemm { const bf16_t* A; const bf16_t* Bt; int K; };

struct StaticOrder {
    int nM, nN, nwg, G, c, lat;
    __device__ __forceinline__ void init(int nM_, int nN_, int G_, int c_, int lat_ = 0) { nM = nM_; nN = nN_; nwg = nM * nN; G = G_; c = c_; lat = lat_; }
    __device__ __forceinline__ bool next(int i, Unit& u) const {
        const long L = (long)i * G + c; if (L >= nwg) return false;
        int wgid = (int)L; { const int q = nwg / NXCD, r = nwg % NXCD, xcd = wgid % NXCD, off = wgid / NXCD; wgid = (xcd < r ? xcd * (q + 1) : r * (q + 1) + (xcd - r) * q) + off; }
        const int nig = WGM * nN, gid = wgid / nig, fm = gid * WGM, gsz = (nM - fm) < WGM ? (nM - fm) : WGM;
        u.pm = fm + ((wgid % nig) % gsz); if (lat) u.pm += u.pm / 32 + 1; u.pn = (wgid % nig) / gsz; u.om = u.pm; u.on = u.pn; u.aux = 0; return true;
    }
    __device__ __forceinline__ unsigned arow(const Unit&, int, int) const { return 0u; }
};
struct TripleOrder {
    int nM, nN, nwg, G, c, lat, ast;
    __device__ __forceinline__ void init(int nM_, int nN_, int G_, int c_, int lat_, int ast_) { nM = nM_; nN = nN_; nwg = nM * nN; G = G_; c = c_; lat = lat_; ast = ast_; }
    __device__ __forceinline__ bool next(int i, Unit& u) const {
        const int ti = i / 3, br = i - 3 * ti;
        const long L = (long)ti * G + c; if (L >= nwg) return false;
        int wgid = (int)L; { const int q = nwg / NXCD, r = nwg % NXCD, xcd = wgid % NXCD, off = wgid / NXCD; wgid = (xcd < r ? xcd * (q + 1) : r * (q + 1) + (xcd - r) * q) + off; }
        const int nig = WGM * nN, gid = wgid / nig, fm = gid * WGM, gsz = (nM - fm) < WGM ? (nM - fm) : WGM;
        u.om = fm + ((wgid % nig) % gsz); if (lat) u.om += u.om / 32 + 1; u.on = (wgid % nig) / gsz; u.pm = br * ast + u.om; u.pn = br * 8 + u.on; u.aux = br; return true;
    }
    __device__ __forceinline__ unsigned arow(const Unit&, int, int) const { return 0u; }
};

typedef __bf16 bf16x2_t __attribute__((ext_vector_type(2)));
__device__ __forceinline__ unsigned cvt_pk_bf16(float lo, float hi) { f32x2 v = {lo, hi}; bf16x2_t b = __builtin_convertvector(v, bf16x2_t); return __builtin_bit_cast(unsigned, b); }
__device__ __forceinline__ float bf_lo(unsigned w) { return __builtin_bit_cast(float, w << 16); }
__device__ __forceinline__ float bf_hi(unsigned w) { return __builtin_bit_cast(float, w & 0xffff0000u); }
__device__ __forceinline__ float sigmoidf_fast(float x) { return __builtin_amdgcn_rcpf(1.0f + __builtin_amdgcn_exp2f(-1.4426950408889634f * x)); }

template <int ACT> struct EpiBf16 {
    static constexpr bool PERM = true; static constexpr int NST = 16;
    bf16_t* O; int ldc; const float* bias; float sc;
    __device__ __forceinline__ void operator()(const f32x4 (&acc)[2][2][4][2], const Unit& u, int wr, int wc, int fr, int fq) const {
        const int row0 = u.om * BM + wr * 64 + fr; const int col0 = u.on * BM + wc * 32 + 8 * fq;
        f32x4 bv[2][2];
#pragma unroll
        for (int bj = 0; bj < 2; ++bj)
#pragma unroll
            for (int n = 0; n < 2; ++n) bv[bj][n] = (ACT == 1) ? *(const f32x4*)(bias + col0 + bj * HALF + 4 * n) : (f32x4){0.f, 0.f, 0.f, 0.f};
#pragma unroll
        for (int ai = 0; ai < 2; ++ai)
#pragma unroll
            for (int m = 0; m < 4; ++m) { bf16_t* rowp = O + (size_t)(row0 + ai * HALF + m * 16) * ldc + col0;
#pragma unroll
                for (int bj = 0; bj < 2; ++bj) { f32x4 v0 = acc[ai][bj][m][0], v1 = acc[ai][bj][m][1];
                    if (ACT == 1) { v0 = v0 * sc + bv[bj][0]; v1 = v1 * sc + bv[bj][1];
#pragma unroll
                        for (int j = 0; j < 4; ++j) { v0[j] = sigmoidf_fast(v0[j]); v1[j] = sigmoidf_fast(v1[j]); } }
                    u32x4 w; w.x = cvt_pk_bf16(v0[0], v0[1]); w.y = cvt_pk_bf16(v0[2], v0[3]); w.z = cvt_pk_bf16(v1[0], v1[1]); w.w = cvt_pk_bf16(v1[2], v1[3]);
                    *(u32x4*)(rowp + bj * HALF) = w; } }
    }
};
struct EpiFp8 {
    static constexpr bool PERM = true; static constexpr int NST = 8;
    unsigned char* O; int ldc;
    __device__ __forceinline__ void operator()(const f32x4 (&acc)[2][2][4][2], const Unit& u, int wr, int wc, int fr, int fq) const {
        const int row0 = u.om * BM + wr * 64 + fr; const int col0 = u.on * BM + wc * 64 + 16 * fq;
#pragma unroll
        for (int ai = 0; ai < 2; ++ai)
#pragma unroll
            for (int m = 0; m < 4; ++m) { u32x4 w;
#pragma unroll
                for (int bj = 0; bj < 2; ++bj)
#pragma unroll
                    for (int n = 0; n < 2; ++n) { f32x4 v = acc[ai][bj][m][n];
#pragma unroll
                        for (int j = 0; j < 4; ++j) v[j] = __builtin_amdgcn_fmed3f(v[j], -448.0f, 448.0f);
                        int p = __builtin_amdgcn_cvt_pk_fp8_f32(v[0], v[1], 0, false); p = __builtin_amdgcn_cvt_pk_fp8_f32(v[2], v[3], p, true); w[bj * 2 + n] = (unsigned)p; }
                *(u32x4*)(O + (size_t)(row0 + ai * HALF + m * 16) * ldc + col0) = w; }
    }
};
__device__ __forceinline__ f32x4 fp8x4e(unsigned w) { const f32x2 lo = __builtin_amdgcn_cvt_pk_f32_fp8((int)w, false), hi = __builtin_amdgcn_cvt_pk_f32_fp8((int)w, true); return (f32x4){lo.x, lo.y, hi.x, hi.y}; }
struct EpiGate {
    static constexpr bool PERM = true; static constexpr int NST = 16;
    unsigned char* O; const float* bias;
    __device__ __forceinline__ void operator()(const f32x4 (&acc)[2][2][4][2], const Unit& u, int wr, int wc, int fr, int fq) const {
        const int row0 = u.om * BM + wr * 64 + fr; const int col0 = u.on * BM + wc * 32 + 8 * fq;
        f32x4 bv[2][2];
#pragma unroll
        for (int bj = 0; bj < 2; ++bj)
#pragma unroll
            for (int n = 0; n < 2; ++n) bv[bj][n] = *(const f32x4*)(bias + col0 + bj * HALF + 4 * n);
#pragma unroll
        for (int ai = 0; ai < 2; ++ai)
#pragma unroll
            for (int m = 0; m < 4; ++m) { unsigned char* rowp = O + (size_t)(row0 + ai * HALF + m * 16) * 3072 + col0;
#pragma unroll
                for (int bj = 0; bj < 2; ++bj) { unsigned w[2];
#pragma unroll
                    for (int n = 0; n < 2; ++n) { const f32x4 v = acc[ai][bj][m][n] + bv[bj][n]; unsigned q[4];
#pragma unroll
                        for (int j = 0; j < 4; ++j) q[j] = (unsigned)(sigmoidf_fast(v[j]) * 255.0f + 0.5f);
                        w[n] = (q[0] | (q[1] << 8)) | ((q[2] << 16) | (q[3] << 24)); }
                    *(u32x2*)(rowp + bj * HALF) = (u32x2){w[0], w[1]}; } }
    }
};
struct EpiBranchT {
    static constexpr bool PERM = true; static constexpr int NST = 16;
    const unsigned char* GATE; unsigned char* MG8;
    template <int BR> __device__ __forceinline__ void body(const f32x4 (&acc)[2][2][4][2], int urow, int ucol, unsigned lg, unsigned l8) const {
#pragma unroll
        for (int ai = 0; ai < 2; ++ai) {
            u32x2 gw[4][2], mw[4][2];
#pragma unroll
            for (int m = 0; m < 4; ++m)
#pragma unroll
                for (int bj = 0; bj < 2; ++bj) { const size_t row = (size_t)(urow + ai * HALF + m * 16);
                    gw[m][bj] = *(const u32x2*)(GATE + row * 3072 + (BR * 1024 + ucol + bj * HALF) + lg);
                    if (BR > 0) mw[m][bj] = *(const u32x2*)(MG8 + row * 1024 + (ucol + bj * HALF) + l8); }
#pragma unroll
            for (int m = 0; m < 4; ++m)
#pragma unroll
                for (int bj = 0; bj < 2; ++bj) { const size_t row = (size_t)(urow + ai * HALF + m * 16); const u32x2 g = gw[m][bj]; const f32x4 a0 = acc[ai][bj][m][0], a1 = acc[ai][bj][m][1];
                    float o[8];
                    o[0] = (float)(g.x & 0xffu) * a0[0]; o[1] = (float)((g.x >> 8) & 0xffu) * a0[1]; o[2] = (float)((g.x >> 16) & 0xffu) * a0[2]; o[3] = (float)(g.x >> 24) * a0[3];
                    o[4] = (float)(g.y & 0xffu) * a1[0]; o[5] = (float)((g.y >> 8) & 0xffu) * a1[1]; o[6] = (float)((g.y >> 16) & 0xffu) * a1[2]; o[7] = (float)(g.y >> 24) * a1[3];
                    if (BR > 0) { const u32x2 mo = mw[m][bj]; const f32x4 p0 = fp8x4e(mo.x), p1 = fp8x4e(mo.y);
#pragma unroll
                        for (int e = 0; e < 4; ++e) { o[e] += p0[e] * (1.0f / 64.0f); o[4 + e] += p1[e] * (1.0f / 64.0f); } }
#pragma unroll
                    for (int e = 0; e < 8; ++e) o[e] = __builtin_amdgcn_fmed3f(o[e], -4.0f, 4.0f) * 64.0f;
                    int p0 = __builtin_amdgcn_cvt_pk_fp8_f32(o[0], o[1], 0, false); p0 = __builtin_amdgcn_cvt_pk_fp8_f32(o[2], o[3], p0, true);
                    int p1 = __builtin_amdgcn_cvt_pk_fp8_f32(o[4], o[5], 0, false); p1 = __builtin_amdgcn_cvt_pk_fp8_f32(o[6], o[7], p1, true);
                    *(u32x2*)(MG8 + row * 1024 + (ucol + bj * HALF) + l8) = (u32x2){(unsigned)p0, (unsigned)p1}; }
        }
    }
    __device__ __forceinline__ void operator()(const f32x4 (&acc)[2][2][4][2], const Unit& u, int wr, int wc, int fr_, int fq_) const {
        int fr = fr_, fq = fq_; asm volatile("" : "+v"(fr), "+v"(fq));
        const int urow = u.om * BM + wr * 64, ucol = u.on * BM + wc * 32;
        const unsigned lg = (unsigned)(fr * 3072 + 8 * fq), l8 = (unsigned)(fr * 1024 + 8 * fq);
        if (u.aux == 0) body<0>(acc, urow, ucol, lg, l8); else if (u.aux == 1) body<1>(acc, urow, ucol, lg, l8); else body<2>(acc, urow, ucol, lg, l8);
    }
};
template <int BR> struct EpiBranch {
    static constexpr bool PERM = true; static constexpr int NST = 16;
    const bf16_t* GATE; bf16_t* MG; unsigned char* MG8;
    __device__ __forceinline__ void operator()(const f32x4 (&acc)[2][2][4][2], const Unit& u, int wr, int wc, int fr, int fq) const {
        const int row0 = u.om * BM + wr * 64 + fr; const int col0 = u.on * BM + wc * 32 + 8 * fq;
#pragma unroll
        for (int ai = 0; ai < 2; ++ai) {
            u32x4 gw[4][2], mw[4][2];
#pragma unroll
            for (int m = 0; m < 4; ++m)
#pragma unroll
                for (int bj = 0; bj < 2; ++bj) { const size_t row = (size_t)(row0 + ai * HALF + m * 16);
                    gw[m][bj] = *(const u32x4*)(GATE + row * 3072 + BR * 1024 + col0 + bj * HALF);
                    mw[m][bj] = (BR > 0) ? *(const u32x4*)(MG + row * 1024 + col0 + bj * HALF) : (u32x4){0u, 0u, 0u, 0u}; }
#pragma unroll
            for (int m = 0; m < 4; ++m)
#pragma unroll
                for (int bj = 0; bj < 2; ++bj) { const size_t row = (size_t)(row0 + ai * HALF + m * 16); bf16_t* mp = MG + row * 1024 + col0 + bj * HALF;
                    const u32x4 g = gw[m][bj], mo = mw[m][bj]; const f32x4 a0 = acc[ai][bj][m][0], a1 = acc[ai][bj][m][1];
                    float o[8];
                    o[0] = bf_lo(g.x) * a0[0]; o[1] = bf_hi(g.x) * a0[1]; o[2] = bf_lo(g.y) * a0[2]; o[3] = bf_hi(g.y) * a0[3];
                    o[4] = bf_lo(g.z) * a1[0]; o[5] = bf_hi(g.z) * a1[1]; o[6] = bf_lo(g.w) * a1[2]; o[7] = bf_hi(g.w) * a1[3];
                    if (BR > 0) { o[0] += bf_lo(mo.x); o[1] += bf_hi(mo.x); o[2] += bf_lo(mo.y); o[3] += bf_hi(mo.y); o[4] += bf_lo(mo.z); o[5] += bf_hi(mo.z); o[6] += bf_lo(mo.w); o[7] += bf_hi(mo.w); }
                    if constexpr (BR == 2) {
#pragma unroll
                        for (int q = 0; q < 8; ++q) o[q] = __builtin_amdgcn_fmed3f(o[q] * 64.0f, -448.0f, 448.0f);
                        int p0 = __builtin_amdgcn_cvt_pk_fp8_f32(o[0], o[1], 0, false); p0 = __builtin_amdgcn_cvt_pk_fp8_f32(o[2], o[3], p0, true);
                        int p1 = __builtin_amdgcn_cvt_pk_fp8_f32(o[4], o[5], 0, false); p1 = __builtin_amdgcn_cvt_pk_fp8_f32(o[6], o[7], p1, true);
                        *(u32x2*)(MG8 + row * 1024 + col0 + bj * HALF) = (u32x2){(unsigned)p0, (unsigned)p1}; (void)mp;
                    } else { u32x4 w; w.x = cvt_pk_bf16(o[0], o[1]); w.y = cvt_pk_bf16(o[2], o[3]); w.z = cvt_pk_bf16(o[4], o[5]); w.w = cvt_pk_bf16(o[6], o[7]);
                        *(u32x4*)mp = w; } }
        }
    }
};
template <bool SRC32> struct EpiResid {
    static constexpr bool PERM = true; static constexpr int NST = 16;
    bf16_t* XB; const float* SL; const float* SC; const float* modl; int goff; float dsc;
    __device__ __forceinline__ void operator()(const f32x4 (&acc)[2][2][4][2], const Unit& u, int wr, int wc, int fr_, int fq_) const {
        int fr = fr_, fq = fq_; asm volatile("" : "+v"(fr), "+v"(fq));
        const int b = u.om / 33, pj = u.om % 33;
        bf16_t* base = XB + (size_t)u.om * 256 * 1024;
        const float* sbase = (pj == 0) ? SC + (size_t)b * 256 * 1024 : SL + ((size_t)b * 8192 + (size_t)(pj - 1) * 256) * 1024;
        const float* gv = modl + (pj == 0 ? 8 : b) * 6144 + goff;
        const int row0 = wr * 64 + fr, col0 = u.on * BM + wc * 32 + 8 * fq;
#pragma unroll
        for (int bj = 0; bj < 2; ++bj) {
            const f32x4 g0 = *(const f32x4*)(gv + col0 + bj * HALF) * dsc, g1 = *(const f32x4*)(gv + col0 + bj * HALF + 4) * dsc;
            if constexpr (SRC32) {
#pragma unroll
                for (int ai = 0; ai < 2; ++ai)
#pragma unroll
                  for (int mh = 0; mh < 4; mh += 2) {
                    f32x4 x0[4], x1[4];
#pragma unroll
                    for (int m = mh; m < mh + 2; ++m) { const float* p = sbase + (size_t)(row0 + ai * HALF + m * 16) * 1024 + col0 + bj * HALF; x0[m] = *(const f32x4*)p; x1[m] = *(const f32x4*)(p + 4); }
#pragma unroll
                    for (int m = mh; m < mh + 2; ++m) { const f32x4 y0 = x0[m] + g0 * acc[ai][bj][m][0], y1 = x1[m] + g1 * acc[ai][bj][m][1];
                        u32x4 w; w.x = cvt_pk_bf16(y0[0], y0[1]); w.y = cvt_pk_bf16(y0[2], y0[3]); w.z = cvt_pk_bf16(y1[0], y1[1]); w.w = cvt_pk_bf16(y1[2], y1[3]);
                        *(u32x4*)(base + (size_t)(row0 + ai * HALF + m * 16) * 1024 + col0 + bj * HALF) = w; } }
            } else {
                u32x4 xv[2][4];
#pragma unroll
                for (int ai = 0; ai < 2; ++ai)
#pragma unroll
                    for (int m = 0; m < 4; ++m) xv[ai][m] = *(const u32x4*)(base + (size_t)(row0 + ai * HALF + m * 16) * 1024 + col0 + bj * HALF);
#pragma unroll
                for (int ai = 0; ai < 2; ++ai) {
#pragma unroll
                    for (int m = 0; m < 4; ++m) { const u32x4 x = xv[ai][m];
                        const f32x4 y0 = (f32x4){bf_lo(x.x), bf_hi(x.x), bf_lo(x.y), bf_hi(x.y)} + g0 * acc[ai][bj][m][0], y1 = (f32x4){bf_lo(x.z), bf_hi(x.z), bf_lo(x.w), bf_hi(x.w)} + g1 * acc[ai][bj][m][1];
                        u32x4 w; w.x = cvt_pk_bf16(y0[0], y0[1]); w.y = cvt_pk_bf16(y0[2], y0[3]); w.z = cvt_pk_bf16(y1[0], y1[1]); w.w = cvt_pk_bf16(y1[2], y1[3]);
                        *(u32x4*)(base + (size_t)(row0 + ai * HALF + m * 16) * 1024 + col0 + bj * HALF) = w; } }
            }
        }
    }
};

typedef float f32x2r __attribute__((ext_vector_type(2)));
__device__ __forceinline__ float qk_swz16(float v) { return __builtin_bit_cast(float, __builtin_amdgcn_ds_swizzle(__builtin_bit_cast(int, v), (16 << 10) | 0x1f)); }
__device__ __forceinline__ float qk_other32(float v, bool upper) { const unsigned a = __builtin_bit_cast(unsigned, v); auto rr = __builtin_amdgcn_permlane32_swap(a, a, false, false); const unsigned r0 = rr[0], r1 = rr[1]; return upper ? __uint_as_float(r0) : __uint_as_float(r1); }
struct EpiQkv {
    static constexpr bool PERM = true; static constexpr int NST = 16;
    bf16_t* O; const f32x2r* rope; const float* gq; const float* gk; float c2; const PG8_LAS f32x4* r1;
    __device__ __forceinline__ void operator()(const f32x4 (&acc)[2][2][4][2], const Unit& u, int wr, int wc, int fr_, int fq_) const {
        int fr = fr_, fq = fq_; asm volatile("" : "+v"(fr), "+v"(fq));
        const int s = 4 * u.on + wc;
        int kind, nrm = 0;
        if (s < 8) { kind = 1; nrm = 1; } else if (s < 10) { kind = 2; nrm = 2; } else if (s < 12) kind = 0; else if (s < 20) kind = 1; else if (s < 22) kind = 2; else if (s < 24) kind = 0;
        else if (s < 32) kind = 1; else if (s < 40) kind = 2; else kind = 0;
        const int pj = u.om % 33; const bool lat = pj != 0; const int t0 = (pj - 1) * 256;
        const int col0 = u.on * BM + wc * 64 + 8 * fq;
        unsigned g2[2][4];
        if (nrm) { const float* gp = (nrm == 1) ? gq : gk;
#pragma unroll
            for (int bj = 0; bj < 2; ++bj)
#pragma unroll
                for (int e = 0; e < 4; ++e) g2[bj][e] = cvt_pk_bf16(gp[32 * bj + 8 * fq + 2 * e], gp[32 * bj + 8 * fq + 2 * e + 1]); }
        f32x4 c0[2][4], c1[4];
        const bool rot = lat && kind != 0;
        const PG8_LAS f32x4* p1 = r1 + fr * 8 + 4 * (fq & 1);
        if (rot) {
#pragma unroll
            for (int ai = 0; ai < 2; ++ai) { const f32x4* p = (const f32x4*)(rope + ((size_t)(t0 + 128 * ai + 64 * wr) * 2 + 0) * 16 + 8 * (fq & 1));
#pragma unroll
                for (int q = 0; q < 4; ++q) c0[ai][q] = p[q]; }
        }
#pragma unroll
        for (int m = 0; m < 4; ++m) {
            if (rot) {
#pragma unroll
                for (int q = 0; q < 4; ++q) c1[q] = p1[m * 128 + q]; }
#pragma unroll
            for (int ai = 0; ai < 2; ++ai) { const int rl = ai * HALF + wr * 64 + m * 16 + fr; bf16_t* rowp = O + (size_t)(u.om * BM + rl) * 3072 + col0;
                float x[2][8];
#pragma unroll
                for (int bj = 0; bj < 2; ++bj)
#pragma unroll
                    for (int e = 0; e < 8; ++e) x[bj][e] = acc[ai][bj][m][e >> 2][e & 3];
                if (kind != 0) {
                    if (nrm) { float ss = 0.f;
#pragma unroll
                        for (int bj = 0; bj < 2; ++bj)
#pragma unroll
                            for (int e = 0; e < 8; ++e) ss += x[bj][e] * x[bj][e];
                        ss += qk_swz16(ss); ss += qk_other32(ss, (fq & 2) != 0);
                        const float rs = 1.0f / sqrtf(ss * (1.f / 64.f) + 1e-6f);
#pragma unroll
                        for (int bj = 0; bj < 2; ++bj)
#pragma unroll
                            for (int e = 0; e < 8; ++e) x[bj][e] = x[bj][e] * rs * ((e & 1) ? bf_hi(g2[bj][e >> 1]) : bf_lo(g2[bj][e >> 1])); }
                    if (rot) {
#pragma unroll
                        for (int bj = 0; bj < 2; ++bj)
#pragma unroll
                            for (int e = 0; e < 8; ++e) { const f32x4 cq = (bj == 0) ? c0[ai][e >> 1] : c1[e >> 1]; const float cs = (e & 1) ? cq.z : cq.x, sn = (e & 1) ? cq.w : cq.y; const float px = qk_other32(x[bj][e], (fq & 2) != 0);
                                x[bj][e] = (fq & 2) ? (px * sn + x[bj][e] * cs) : (x[bj][e] * cs - px * sn); } }
                    if (kind == 1) {
#pragma unroll
                        for (int bj = 0; bj < 2; ++bj)
#pragma unroll
                            for (int e = 0; e < 8; ++e) x[bj][e] *= c2; }
                }
#pragma unroll
                for (int bj = 0; bj < 2; ++bj) { u32x4 w; w.x = cvt_pk_bf16(x[bj][0], x[bj][1]); w.y = cvt_pk_bf16(x[bj][2], x[bj][3]); w.z = cvt_pk_bf16(x[bj][4], x[bj][5]); w.w = cvt_pk_bf16(x[bj][6], x[bj][7]);
                    *(u32x4*)(rowp + bj * 32) = w; }
            }
            asm volatile("" ::: "memory");
        }
    }
};
struct EpiRouter {
    static constexpr bool PERM = false; static constexpr int NST = 16;
    float* LG;
    __device__ __forceinline__ void operator()(const f32x4 (&acc)[2][2][4][2], const Unit& u, int wr, int wc, int fr, int fq) const {
        const int row0 = u.om * BM + wr * 64 + fr, col0 = wc * 32 + 4 * fq;
#pragma unroll
        for (int ai = 0; ai < 2; ++ai)
#pragma unroll
            for (int m = 0; m < 4; ++m) { float* rowp = LG + (size_t)(row0 + ai * HALF + m * 16) * 128 + col0;
#pragma unroll
                for (int n = 0; n < 2; ++n) *(f32x4*)(rowp + n * 16) = acc[ai][0][m][n]; }
    }
};
template <bool F8> struct EpiUp {
    static constexpr bool PERM = true; static constexpr int NST = 8;
    bf16_t* H;
    __device__ __forceinline__ void operator()(const f32x4 (&acc)[2][2][4][2], const Unit& u, int wr, int wc, int fr, int fq) const {
        const int row0 = u.om * BM + wr * 64 + fr; const int col0 = u.on * HALF + wc * 32 + 8 * fq;
#pragma unroll
        for (int ai = 0; ai < 2; ++ai)
#pragma unroll
            for (int m = 0; m < 4; ++m) { bf16_t* rowp = H + (size_t)(row0 + ai * HALF + m * 16) * 256 + col0;
                float o[8];
#pragma unroll
                for (int n = 0; n < 2; ++n)
#pragma unroll
                    for (int j = 0; j < 4; ++j) { const float a = acc[ai][0][m][n][j], c = acc[ai][1][m][n][j]; o[n * 4 + j] = a * sigmoidf_fast(a) * c; }
                if constexpr (F8) {
#pragma unroll
                    for (int q = 0; q < 8; ++q) o[q] = __builtin_amdgcn_fmed3f(o[q], -56.0f, 56.0f);
                    int p0 = __builtin_amdgcn_cvt_pk_fp8_f32(o[0] * 8.0f, o[1] * 8.0f, 0, false); p0 = __builtin_amdgcn_cvt_pk_fp8_f32(o[2] * 8.0f, o[3] * 8.0f, p0, true);
                    int p1 = __builtin_amdgcn_cvt_pk_fp8_f32(o[4] * 8.0f, o[5] * 8.0f, 0, false); p1 = __builtin_amdgcn_cvt_pk_fp8_f32(o[6] * 8.0f, o[7] * 8.0f, p1, true);
                    *(u32x2*)((unsigned char*)H + (size_t)(row0 + ai * HALF + m * 16) * 256 + col0) = (u32x2){(unsigned)p0, (unsigned)p1}; }
                else { u32x4 w; w.x = cvt_pk_bf16(o[0], o[1]); w.y = cvt_pk_bf16(o[2], o[3]); w.z = cvt_pk_bf16(o[4], o[5]); w.w = cvt_pk_bf16(o[6], o[7]);
                    *(u32x4*)rowp = w; } }
    }
};

template <class Epi, class Sched, bool ALIGN_EPI, bool GATHER, int FP8 = 0>
__device__ __forceinline__ void gemm_phase(PG8_LAS unsigned char* lds, const Gemm g, const Sched& S, const Epi& E) {
    int tid = threadIdx.x; asm volatile("" : "+v"(tid));
    const int wid = __builtin_amdgcn_readfirstlane(tid >> 6), lane = tid & 63, wr = wid >> 2, wc = wid & 3, fr = lane & 15, fq = lane >> 4;
    int K = g.K; asm volatile("" : "+s"(K));
    const int nt = K / BK;
    unsigned voffA[2], voffB[2]; int RA[2]; unsigned CA2[2];
#pragma unroll
    for (int i = 0; i < 2; ++i) { int R, C; stage_rc(tid * 16 + i * 8192, R, C); const int Rb = Epi::PERM ? ((R & ~31) + perm32(R & 31)) : R;
        voffA[i] = (unsigned)(R * K + C) * 2u; voffB[i] = (unsigned)(Rb * K + C) * 2u; RA[i] = R; CA2[i] = (unsigned)C * 2u; }
    const size_t kstep = (size_t)(BK * 2);
    const size_t hstep = (size_t)HALF * K * 2;
    const size_t tstep = 2 * hstep;
    const unsigned rowb = (unsigned)K * 2u;
    const unsigned ldsw = (unsigned)wid * 1024u;
    const int aoff = lds_byte(wr * 64 + fr, fq * 8), boff = lds_byte(wc * 32 + fr, fq * 8);
#define PG8_SA(b, h) (((b) * 2 + (h)) * HTB)
#define PG8_SB(b, h) ((4 + (b) * 2 + (h)) * HTB)
#define PG8_STAGE(bufoff, gbase, voff) do { _Pragma("unroll") for (int _i = 0; _i < 2; ++_i) \
        __builtin_amdgcn_global_load_lds((const unsigned*)((const char*)(gbase) + (voff)[_i]), (PG8_LAS unsigned*)(lds + (bufoff) + ldsw + _i * 8192), 16, 0, 0); } while (0)
#define PG8_STAGE_A(bufoff, gb, h, VO) do { if constexpr (GATHER) { PG8_STAGE(bufoff, gb, VO[h]); } else { PG8_STAGE(bufoff, (gb) + (h) * hstep, voffA); } } while (0)
#define PG8_LD32(p) ({ const v4i32 lo_ = *(const PG8_LAS v4i32*)(p), hi_ = *(const PG8_LAS v4i32*)((p) + 1024); __builtin_shufflevector(lo_, hi_, 0, 1, 2, 3, 4, 5, 6, 7); })
#define PG8_LDA(dst, b, h) do { if constexpr (FP8) { _Pragma("unroll") for (int m = 0; m < 4; ++m) dst##8[m] = PG8_LD32(lds + PG8_SA(b, h) + aoff + m * 2048); } else { \
        _Pragma("unroll") for (int m = 0; m < 4; ++m) _Pragma("unroll") for (int k = 0; k < 2; ++k) dst[m][k] = *(const PG8_LAS bf16x8*)(lds + PG8_SA(b, h) + aoff + m * 2048 + k * 1024); } } while (0)
#define PG8_LDB(dst, b, h) do { if constexpr (FP8) { _Pragma("unroll") for (int n = 0; n < 2; ++n) dst##8[n] = PG8_LD32(lds + PG8_SB(b, h) + boff + n * 2048); } else { \
        _Pragma("unroll") for (int n = 0; n < 2; ++n) _Pragma("unroll") for (int k = 0; k < 2; ++k) dst[n][k] = *(const PG8_LAS bf16x8*)(lds + PG8_SB(b, h) + boff + n * 2048 + k * 1024); } } while (0)
#define PG8_MMA(ai, bj, At, Bt) do { __builtin_amdgcn_s_setprio(1); \
        if constexpr (FP8) { _Pragma("unroll") for (int m = 0; m < 4; ++m) _Pragma("unroll") for (int n = 0; n < 2; ++n) \
            asm volatile("v_mfma_scale_f32_16x16x128_f8f6f4 %0, %1, %2, %0, %3, %3 op_sel_hi:[0,0,0]" : "+v"(acc[ai][bj][m][n]) : "v"(Bt##8[n]), "v"(At##8[m]), "v"(sc8)); } \
        else { _Pragma("unroll") for (int m = 0; m < 4; ++m) _Pragma("unroll") for (int n = 0; n < 2; ++n) _Pragma("unroll") for (int k = 0; k < 2; ++k) \
            acc[ai][bj][m][n] = __builtin_amdgcn_mfma_f32_16x16x32_bf16(Bt[n][k], At[m][k], acc[ai][bj][m][n], 0, 0, 0); } \
        __builtin_amdgcn_s_setprio(0); } while (0)
#define PG8_WAIT_V(n) asm volatile("s_waitcnt vmcnt(" #n ")" ::: "memory")
#define PG8_WAIT_L(n) asm volatile("s_waitcnt lgkmcnt(" #n ")" ::: "memory")
#define PG8_BAR __builtin_amdgcn_s_barrier()
#define PG8_SCHED __builtin_amdgcn_sched_barrier(0)
    Unit cur, nxt, nx2; int ui = 0;
    if (!S.next(0, cur)) return;
    f32x4 acc[2][2][4][2];
#pragma unroll
    for (int a = 0; a < 2; ++a)
#pragma unroll
        for (int b = 0; b < 2; ++b)
#pragma unroll
            for (int m = 0; m < 4; ++m)
#pragma unroll
                for (int n = 0; n < 2; ++n) acc[a][b][m][n] = (f32x4){0.f, 0.f, 0.f, 0.f};
    bf16x8 At[4][2], B0[2][2], B1[2][2]; v8i32 At8[4], B08[2], B18[2];
    int sc8 = FP8 * 0x01010101; asm volatile("" : "+v"(sc8));
    unsigned cvo[2][2], nvo[2][2], n2vo[2][2];
    bool has_next = S.next(1, nxt);
    if constexpr (GATHER) {
#pragma unroll
        for (int h = 0; h < 2; ++h)
#pragma unroll
            for (int i = 0; i < 2; ++i) { cvo[h][i] = S.arow(cur, h, RA[i]) * rowb + CA2[i]; nvo[h][i] = has_next ? S.arow(nxt, h, RA[i]) * rowb + CA2[i] : cvo[h][i]; n2vo[h][i] = nvo[h][i]; }
    }
    const char* cA = GATHER ? (const char*)g.A : (const char*)g.A + (size_t)cur.pm * tstep; const char* cB = (const char*)g.Bt + (size_t)cur.pn * tstep;
    PG8_STAGE(PG8_SB(0, 0), cB, voffB); PG8_STAGE(PG8_SB(0, 1), cB + hstep, voffB); PG8_STAGE_A(PG8_SA(0, 0), cA, 0, cvo); PG8_STAGE_A(PG8_SA(0, 1), cA, 1, cvo);
    if (wr == 1) PG8_BAR;
    PG8_WAIT_V(2); PG8_BAR;
    PG8_STAGE(PG8_SB(1, 0), cB + kstep, voffB); PG8_STAGE_A(PG8_SA(1, 0), cA + kstep, 0, cvo); PG8_STAGE(PG8_SB(1, 1), cB + hstep + kstep, voffB);
    PG8_WAIT_V(6); PG8_BAR;
    for (;;) {
        bool has_n2 = false;
        if constexpr (GATHER) { if (has_next) { has_n2 = S.next(ui + 2, nx2); if (has_n2) {
#pragma unroll
            for (int h = 0; h < 2; ++h)
#pragma unroll
                for (int i = 0; i < 2; ++i) n2vo[h][i] = S.arow(nx2, h, RA[i]) * rowb + CA2[i]; } } }
        const char* nA = GATHER ? (const char*)g.A : (has_next ? (const char*)g.A + (size_t)nxt.pm * tstep : cA); const char* nB = has_next ? (const char*)g.Bt + (size_t)nxt.pn * tstep : cB;
        for (int t = 0; t < nt; t += 2) {
            const bool last = (t == nt - 2);
            const char* a1 = cA + (size_t)(t + 1) * kstep;
            const char* a2 = last ? nA : cA + (size_t)(t + 2) * kstep; const char* b2 = last ? nB : cB + (size_t)(t + 2) * kstep;
            const char* a3 = a2 + kstep; const char* b3 = b2 + kstep;
            unsigned xvo[2][2];
            if constexpr (GATHER) {
#pragma unroll
                for (int h = 0; h < 2; ++h)
#pragma unroll
                    for (int i = 0; i < 2; ++i) xvo[h][i] = last ? nvo[h][i] : cvo[h][i];
            }
            PG8_LDB(B0, 0, 0); PG8_LDB(B1, 0, 1); PG8_SCHED; PG8_LDA(At, 0, 0); PG8_STAGE_A(PG8_SA(1, 1), a1, 1, cvo);
            PG8_WAIT_V(8); PG8_WAIT_L(0); PG8_BAR; PG8_MMA(0, 0, At, B0); PG8_MMA(0, 1, At, B1); PG8_BAR; PG8_SCHED;
            PG8_LDA(At, 0, 1); PG8_STAGE(PG8_SB(0, 0), b2, voffB); PG8_STAGE(PG8_SB(0, 1), b2 + hstep, voffB); PG8_STAGE_A(PG8_SA(0, 0), a2, 0, xvo);
            PG8_WAIT_V(8); PG8_WAIT_L(0); PG8_BAR; PG8_MMA(1, 0, At, B0); PG8_MMA(1, 1, At, B1); PG8_BAR; PG8_SCHED;
            PG8_LDB(B0, 1, 0); PG8_LDB(B1, 1, 1); PG8_SCHED; PG8_LDA(At, 1, 0); PG8_STAGE_A(PG8_SA(0, 1), a2, 1, xvo);
            PG8_WAIT_V(8); PG8_WAIT_L(0); PG8_BAR; PG8_MMA(0, 0, At, B0); PG8_MMA(0, 1, At, B1); PG8_BAR; PG8_SCHED;
            PG8_LDA(At, 1, 1); PG8_STAGE(PG8_SB(1, 0), b3, voffB); PG8_STAGE(PG8_SB(1, 1), b3 + hstep, voffB); PG8_STAGE_A(PG8_SA(1, 0), a3, 0, xvo);
            PG8_WAIT_V(8); PG8_WAIT_L(0); PG8_BAR; PG8_MMA(1, 0, At, B0); PG8_MMA(1, 1, At, B1); PG8_BAR; PG8_SCHED;
        }
        if constexpr (ALIGN_EPI) { if (wr == 0) PG8_BAR; }
        if constexpr (FP8) asm volatile("s_nop 15\n\ts_nop 15" ::: "memory");
        E(acc, cur, wr, wc, fr, fq);
        if (!has_next) break;
#pragma unroll
        for (int a = 0; a < 2; ++a)
#pragma unroll
            for (int b = 0; b < 2; ++b)
#pragma unroll
                for (int m = 0; m < 4; ++m)
#pragma unroll
                    for (int n = 0; n < 2; ++n) acc[a][b][m][n] = (f32x4){0.f, 0.f, 0.f, 0.f};
        cur = nxt; cA = nA; cB = nB; ++ui;
        if constexpr (GATHER) {
#pragma unroll
            for (int h = 0; h < 2; ++h)
#pragma unroll
                for (int i = 0; i < 2; ++i) { cvo[h][i] = nvo[h][i]; nvo[h][i] = n2vo[h][i]; }
            has_next = has_n2; nxt = nx2;
        } else { has_next = S.next(ui + 1, nxt); }
        if constexpr (ALIGN_EPI) { if (wr == 1) PG8_BAR; }
    }
    PG8_WAIT_V(0);
    if constexpr (!ALIGN_EPI) { if (wr == 0) PG8_BAR; }
    PG8_BAR;
#undef PG8_SA
#undef PG8_SB
#undef PG8_STAGE
#undef PG8_STAGE_A
#undef PG8_LDA
#undef PG8_LD32
#undef PG8_LDB
#undef PG8_MMA
#undef PG8_WAIT_V
#undef PG8_WAIT_L
#undef PG8_BAR
#undef PG8_SCHED
}
}
namespace attn_body {
using bf16=__hip_bfloat16;
using bf16x8=__attribute__((ext_vector_type(8)))short;
using s16x4=__attribute__((ext_vector_type(4)))short;
using f32x16=__attribute__((ext_vector_type(16)))float;
using u32x4=__attribute__((ext_vector_type(4)))unsigned;
constexpr int D=64, P=3072;
constexpr int NW=8,QBLK=32,QB=QBLK*NW,KVBLK=64;
__device__ __forceinline__ int crow(int r,int hi){return (r&3)+8*(r>>2)+4*hi;}
#define SBAR() __builtin_amdgcn_sched_barrier(0)
__device__ __forceinline__ void wmask(f32x16&p0,f32x16&p1,int dbase){
  const float NEG=-INFINITY;
  #pragma unroll
  for(int r=0;r<16;++r){const int d=dbase+(r&3)+8*(r>>2); if(d>128||d<-128)p0[r]=NEG; if(d+32>128||d+32<-128)p1[r]=NEG;}
}
constexpr int NSLOT=3, SLOTB=8192;
constexpr int LDS_K=0, LDS_V=NSLOT*SLOTB, LDS_WS=2*NSLOT*SLOTB, LDS_OST=LDS_WS+NW*64*4, LDS_BYTES=LDS_OST+NW*4096;
constexpr float C2=0.125f*1.4426950408889634f;
__device__ __forceinline__ void glds16(const void*gsrc,unsigned lds_dst){unsigned keep;
  asm volatile("s_mov_b32 %0, m0\n\ts_mov_b32 m0, %2\n\ts_nop 0\n\tglobal_load_lds_dwordx4 %1, off\n\ts_mov_b32 m0, %0":"=&s"(keep):"v"(gsrc),"s"(lds_dst):"memory");}
__device__ __forceinline__ float max3f(float a,float b,float c){float r;asm("v_max3_f32 %0, %1, %2, %3":"=v"(r):"v"(a),"v"(b),"v"(c));return r;}
__device__ __forceinline__ float max2f(float a,float b){float r;asm("v_max_f32_e32 %0, %1, %2":"=v"(r):"v"(a),"v"(b));return r;}
__device__ __forceinline__ float fadd_s(float a,float b){float r;asm("v_add_f32_e32 %0, %1, %2":"=v"(r):"v"(a),"v"(b));return r;}
__device__ __forceinline__ float fsub_s(float a,float b){float r;asm("v_sub_f32_e32 %0, %1, %2":"=v"(r):"v"(a),"v"(b));return r;}
typedef float f32x2_t __attribute__((ext_vector_type(2))); typedef __bf16 bf16x2_t __attribute__((ext_vector_type(2)));
__device__ __forceinline__ unsigned cvtpk_s(float lo,float hi){f32x2_t v={lo,hi};bf16x2_t b=__builtin_convertvector(v,bf16x2_t);return __builtin_bit_cast(unsigned,b);}
#define WAIT_BAR(N) asm volatile("s_waitcnt vmcnt(" #N ") lgkmcnt(0)\n\ts_barrier":::"memory")

__device__ __forceinline__ void qkt(f32x16&p0,f32x16&p1,const char*Kslot,const bf16x8*qr,const f32x16&negm,int r32,int hi){
  const char*kb=Kslot+hi*1024+r32*16;
  #pragma unroll
  for(int d0=0;d0<4;++d0){
    const bf16x8 b0=*reinterpret_cast<const bf16x8*>(kb+d0*2048);
    const bf16x8 b1=*reinterpret_cast<const bf16x8*>(kb+d0*2048+512);
    if(d0==0){p0=__builtin_amdgcn_mfma_f32_32x32x16_bf16(b0,qr[0],negm,0,0,0);p1=__builtin_amdgcn_mfma_f32_32x32x16_bf16(b1,qr[0],negm,0,0,0);}
    else{p0=__builtin_amdgcn_mfma_f32_32x32x16_bf16(b0,qr[d0],p0,0,0,0);p1=__builtin_amdgcn_mfma_f32_32x32x16_bf16(b1,qr[d0],p1,0,0,0);}}
}
typedef __attribute__((address_space(3))) const char* lds_cptr;
typedef short v4i16_t __attribute__((ext_vector_type(4)));
__device__ __forceinline__ void kload8(bf16x8*kf,lds_cptr kp){
  kf[0]=*(const __attribute__((address_space(3))) bf16x8*)(kp);      kf[1]=*(const __attribute__((address_space(3))) bf16x8*)(kp+512);
  kf[2]=*(const __attribute__((address_space(3))) bf16x8*)(kp+2048); kf[3]=*(const __attribute__((address_space(3))) bf16x8*)(kp+2560);
  kf[4]=*(const __attribute__((address_space(3))) bf16x8*)(kp+4096); kf[5]=*(const __attribute__((address_space(3))) bf16x8*)(kp+4608);
  kf[6]=*(const __attribute__((address_space(3))) bf16x8*)(kp+6144); kf[7]=*(const __attribute__((address_space(3))) bf16x8*)(kp+6656);
}
__device__ __forceinline__ void kload2(bf16x8*kf,lds_cptr kp,int j){ kf[2*j]=*(const __attribute__((address_space(3))) bf16x8*)(kp+j*2048); kf[2*j+1]=*(const __attribute__((address_space(3))) bf16x8*)(kp+j*2048+512); }
__device__ __forceinline__ s16x4 vtr(lds_cptr p){ return __builtin_bit_cast(s16x4,__builtin_amdgcn_ds_read_tr16_b64_v4i16((__attribute__((address_space(3))) v4i16_t*)p)); }
__device__ __forceinline__ float rowmax(const f32x16&p0,const f32x16&p1){
  float a=max3f(p0[0],p0[1],p1[0]),b=max3f(p0[2],p0[3],p1[1]);a=max3f(a,p1[2],p1[3]);
  #pragma unroll
  for(int r=4;r<16;r+=4){a=max3f(a,p0[r],p0[r+1]);b=max3f(b,p0[r+2],p0[r+3]);a=max3f(a,p1[r],p1[r+1]);b=max3f(b,p1[r+2],p1[r+3]);}
  const float m=max2f(a,b);
  auto rr=__builtin_amdgcn_permlane32_swap(__float_as_uint(m),__float_as_uint(m),false,false);
  return max2f(__uint_as_float(rr[0]),__uint_as_float(rr[1]));
}
__device__ __forceinline__ void pv(f32x16*o,int vb,bf16x8 pa0,bf16x8 pa1,bf16x8 pa2,bf16x8 pa3){
  #pragma unroll
  for(int d0=0;d0<2;++d0){s16x4 lo[4],hi[4];
    #pragma unroll
    for(int ks=0;ks<4;++ks){
      asm volatile("ds_read_b64_tr_b16 %0,%1 offset:%c2":"=&v"(lo[ks]):"v"(vb),"i"(d0*4096+ks*1024):"memory");
      asm volatile("ds_read_b64_tr_b16 %0,%1 offset:%c2":"=&v"(hi[ks]):"v"(vb),"i"(d0*4096+ks*1024+512):"memory");}
    asm volatile("s_waitcnt lgkmcnt(0)":::"memory");SBAR();
    #define PK(k) (bf16x8){lo[k][0],lo[k][1],lo[k][2],lo[k][3],hi[k][0],hi[k][1],hi[k][2],hi[k][3]}
    o[d0]=__builtin_amdgcn_mfma_f32_32x32x16_bf16(pa0,PK(0),o[d0],0,0,0);
    o[d0]=__builtin_amdgcn_mfma_f32_32x32x16_bf16(pa1,PK(1),o[d0],0,0,0);
    o[d0]=__builtin_amdgcn_mfma_f32_32x32x16_bf16(pa2,PK(2),o[d0],0,0,0);
    o[d0]=__builtin_amdgcn_mfma_f32_32x32x16_bf16(pa3,PK(3),o[d0],0,0,0);
    #undef PK
  }
}

template<int MODE,int THRL> __device__ __forceinline__ void attn_unit(const bf16*Qu,const bf16*__restrict__ Kh,const bf16*__restrict__ Vh,unsigned char*Ou,int PO,int NT,int wadd,int dq0,float sink2,char*shm){
  int tid=threadIdx.x; asm volatile("":"+v"(tid)); const int lane=tid&63,r32=lane&31,hi=lane>>5; const int wid=__builtin_amdgcn_readfirstlane(tid>>6);
  const bf16*Qw=Qu+(long)(wid*QBLK)*P;
  const unsigned lds0=(unsigned)(uintptr_t)shm;
  float*wsf=(float*)(shm+LDS_WS)+wid*64;
  const bf16*ksrc=Kh+(long)lane*P+wid*8;
  const bf16*vsrc=Vh+(long)(16*(wid&3)+(lane>>2))*P+(wid>>2)*32+(lane&3)*8;
  const unsigned kdst=lds0+LDS_K+wid*1024, vdst=lds0+LDS_V+wid*1024;
  #define TROW(t) ((long)(t)*KVBLK+((MODE==1&&(t)>=4)?(long)wadd:0l))
  #define DMA_K(t,slot) glds16(ksrc+TROW(t)*P,(unsigned)__builtin_amdgcn_readfirstlane(kdst+(slot)))
  #define DMA_V(t,slot) glds16(vsrc+TROW(t)*P,(unsigned)__builtin_amdgcn_readfirstlane(vdst+(slot)))
  const int vb0=(int)(lds0+LDS_V)+((lane>>4)&1)*32+(lane&3)*8+(4*hi+((lane&15)>>2))*64;
  const char*Kbase=shm+LDS_K; bf16x8 kf[8];
  const lds_cptr shm3=(lds_cptr)shm; const lds_cptr kp0=shm3+LDS_K+hi*1024+r32*16; const lds_cptr vp0=shm3+LDS_V+((lane>>4)&1)*32+(lane&3)*8+(4*hi+((lane&15)>>2))*64;
  DMA_K(0,0);DMA_V(0,0);DMA_K(1,SLOTB);
  bf16x8 qr[4];
  #pragma unroll
  for(int d0=0;d0<4;++d0)qr[d0]=*reinterpret_cast<const bf16x8*>(&Qw[(long)r32*P+d0*16+hi*8]);
  float mhat=0.f,l_reg=0.f;f32x16 o[2];o[0]=f32x16{};o[1]=f32x16{};f32x16 negm=f32x16{};asm volatile("":"+v"(negm));
  const int qrel=wid*QBLK+r32;
  const int dlane=dq0-qrel+4*hi;
  #define CMASK(P0,P1,t) do{ if(MODE==1){ if((t)>=4) wmask(P0,P1,dlane+64*((t)-4)); } }while(0)
  bool resc=false;
  #define START(P0,P1) do{ const float rm=rowmax(P0,P1); resc=false; \
    { const float dl=rm; mhat=fadd_s(mhat,dl); \
      _Pragma("unroll") for(int r=0;r<16;++r){P0[r]=fsub_s(P0[r],dl);P1[r]=fsub_s(P1[r],dl);} \
      _Pragma("unroll") for(int r=0;r<16;++r)negm[r]=-mhat; asm volatile("":"+v"(negm)); } \
    _Pragma("unroll") for(int r=0;r<16;++r)P0[r]=__builtin_amdgcn_exp2f(P0[r]); }while(0)
  #define RESC() do{ if(resc){ asm volatile("s_waitcnt lgkmcnt(0)":::"memory"); \
      _Pragma("unroll") for(int d_=0;d_<2;++d_) _Pragma("unroll") for(int r=0;r<16;++r)o[d_][r]*=wsf[crow(r,hi)]; } }while(0)
  f32x16 pA0,pA1,pB0,pB1;
  int sl_prev=0,sl_cur=0,sl_next=SLOTB;
  #define ROT() do{sl_prev=sl_cur;sl_cur=sl_next;sl_next=(sl_next==(NSLOT-1)*SLOTB)?0:sl_next+SLOTB;}while(0)
  DMA_K(2,2*SLOTB);
  WAIT_BAR(3);
  qkt(pA0,pA1,Kbase,qr,negm,r32,hi);asm volatile("s_nop 15\n\ts_nop 7":"+v"(pA0),"+v"(pA1));
  START(pA0,pA1);
  _Pragma("unroll") for(int r=0;r<16;++r)pA1[r]=__builtin_amdgcn_exp2f(pA1[r]);
  WAIT_BAR(0);
  DMA_K(3,0);DMA_V(1,SLOTB);
  ROT();
  kload8(kf,kp0+sl_cur);
  WAIT_BAR(2);
  s16x4 vlo[8],vhi[8]; u32x4 pw0,pw1,pw2,pw3;
  #define PKW(P,B) cvtpk_s(P[B],P[B+1])
  #define PAF(k) __builtin_bit_cast(bf16x8,pw##k)
  #define VFR(i) (bf16x8){vlo[i][0],vlo[i][1],vlo[i][2],vlo[i][3],vhi[i][0],vhi[i][1],vhi[i][2],vhi[i][3]}
  #define PIN(x) asm volatile("":"+v"(x))
  #define MX3(a,b,c) __builtin_fmaxf(__builtin_fmaxf((a),(b)),(c))
  #define GAPA(MF,A0,A1,A2,A3,W0,W1,PW) do{ MF; sacc+=A0; sacc+=A1; sacc+=A2; sacc+=A3; PIN(sacc); W0; W1; PIN(PW); SBAR(); }while(0)
  #define EX(v) __builtin_amdgcn_exp2f(v)
  #define GAPB(MF,X,B) do{ MF; X[B]=EX(X[B]); X[B+1]=EX(X[B+1]); X[B+2]=EX(X[B+2]); X[B+3]=EX(X[B+3]); PIN(X); SBAR(); }while(0)
  #define VRD(i) do{ vlo[i]=vtr(vp_+(((i)>>2)*4096+((i)&3)*1024)); vhi[i]=vtr(vp_+(((i)>>2)*4096+((i)&3)*1024+512)); }while(0)
  #define KRD(G,j) do{ if(G){ kload2(kf,kp0+sl_next,j); SBAR(); } }while(0)
  #define STEP(C0,C1,P0,P1,t,GK,GV,GL) do{ SBAR(); \
    const lds_cptr vp_=vp0+sl_prev; \
    VRD(0); SBAR(); float sacc=(P0[0]+P0[1]); \
    GAPA(C0=__builtin_amdgcn_mfma_f32_32x32x16_bf16(kf[0],qr[0],negm,0,0,0), P0[2],P0[3],P0[4],P0[5],     pw0[0]=PKW(P0,0), pw0[1]=PKW(P0,2), pw0); \
    VRD(4); SBAR(); GAPA(C1=__builtin_amdgcn_mfma_f32_32x32x16_bf16(kf[1],qr[0],negm,0,0,0), P0[6],P0[7],P0[8],P0[9],     pw0[2]=PKW(P0,4), pw0[3]=PKW(P0,6), pw0); \
    VRD(1); SBAR(); GAPA(C0=__builtin_amdgcn_mfma_f32_32x32x16_bf16(kf[2],qr[1],C0,0,0,0),   P0[10],P0[11],P0[12],P0[13], pw1[0]=PKW(P0,8), pw1[1]=PKW(P0,10), pw1); \
    VRD(5); SBAR(); GAPA(C1=__builtin_amdgcn_mfma_f32_32x32x16_bf16(kf[3],qr[1],C1,0,0,0),   P0[14],P0[15],P1[0],P1[1],   pw1[2]=PKW(P0,12),pw1[3]=PKW(P0,14), pw1); \
    VRD(2); SBAR(); GAPA(C0=__builtin_amdgcn_mfma_f32_32x32x16_bf16(kf[4],qr[2],C0,0,0,0),   P1[2],P1[3],P1[4],P1[5],     pw2[0]=PKW(P1,0), pw2[1]=PKW(P1,2), pw2); \
    VRD(6); SBAR(); GAPA(C1=__builtin_amdgcn_mfma_f32_32x32x16_bf16(kf[5],qr[2],C1,0,0,0),   P1[6],P1[7],P1[8],P1[9],     pw2[2]=PKW(P1,4), pw2[3]=PKW(P1,6), pw2); \
    VRD(3); SBAR(); GAPA(C0=__builtin_amdgcn_mfma_f32_32x32x16_bf16(kf[6],qr[3],C0,0,0,0),   P1[10],P1[11],P1[12],P1[13], pw3[0]=PKW(P1,8), pw3[1]=PKW(P1,10), pw3); \
    VRD(7); SBAR(); GAPA(C1=__builtin_amdgcn_mfma_f32_32x32x16_bf16(kf[7],qr[3],C1,0,0,0),   P1[14],P1[15],0.f,0.f,       pw3[2]=PKW(P1,12),pw3[3]=PKW(P1,14), pw3); \
    l_reg+=sacc; \
    if(GK){DMA_K((t)+3,sl_cur);} if(GV){DMA_V((t)+1,sl_next);} \
    CMASK(C0,C1,t); \
    { float a=MX3(C0[0],C0[1],C1[0]),b=MX3(C0[2],C0[3],C1[1]); a=MX3(a,C1[2],C1[3]); \
      _Pragma("unroll") for(int r=4;r<16;r+=4){a=MX3(a,C0[r],C0[r+1]);b=MX3(b,C0[r+2],C0[r+3]);a=MX3(a,C1[r],C1[r+1]);b=MX3(b,C1[r+2],C1[r+3]);} \
      float rm=__builtin_fmaxf(a,b); { auto rr=__builtin_amdgcn_permlane32_swap(__float_as_uint(rm),__float_as_uint(rm),false,false); rm=__builtin_fmaxf(__uint_as_float(rr[0]),__uint_as_float(rr[1])); } \
      resc=false; \
      if(__builtin_expect(__any(rm>(float)THRL),0)){ const float dl=__builtin_fmaxf(rm,0.f); mhat+=dl; \
        _Pragma("unroll") for(int r=0;r<16;++r){C0[r]-=dl;C1[r]-=dl;} \
        _Pragma("unroll") for(int r=0;r<16;++r)negm[r]=-mhat; asm volatile("":"+v"(negm)); \
        const float f=__builtin_amdgcn_exp2f(-dl); l_reg*=f; if(hi==0)wsf[r32]=f; resc=true; } } \
    SBAR(); \
    GAPB(o[0]=__builtin_amdgcn_mfma_f32_32x32x16_bf16(PAF(0),VFR(0),o[0],0,0,0), C0,0); \
    GAPB(o[1]=__builtin_amdgcn_mfma_f32_32x32x16_bf16(PAF(0),VFR(4),o[1],0,0,0), C0,4); \
    KRD(GL,0); GAPB(o[0]=__builtin_amdgcn_mfma_f32_32x32x16_bf16(PAF(1),VFR(1),o[0],0,0,0), C0,8); \
    KRD(GL,1); GAPB(o[1]=__builtin_amdgcn_mfma_f32_32x32x16_bf16(PAF(1),VFR(5),o[1],0,0,0), C0,12); \
    KRD(GL,2); GAPB(o[0]=__builtin_amdgcn_mfma_f32_32x32x16_bf16(PAF(2),VFR(2),o[0],0,0,0), C1,0); \
    KRD(GL,3); GAPB(o[1]=__builtin_amdgcn_mfma_f32_32x32x16_bf16(PAF(2),VFR(6),o[1],0,0,0), C1,4); \
    GAPB(o[0]=__builtin_amdgcn_mfma_f32_32x32x16_bf16(PAF(3),VFR(3),o[0],0,0,0), C1,8); \
    GAPB(o[1]=__builtin_amdgcn_mfma_f32_32x32x16_bf16(PAF(3),VFR(7),o[1],0,0,0), C1,12); \
    }while(0)
  int t=1;
  if(MODE==0){
    for(;t+5<NT;t+=2){
      STEP(pB0,pB1,pA0,pA1,t,true,true,true);     WAIT_BAR(2); RESC(); ROT();
      STEP(pA0,pA1,pB0,pB1,t+1,true,true,true);   WAIT_BAR(2); RESC(); ROT();
    }
  }
  #define ENDW(tt) do{ if((tt)+3<NT){WAIT_BAR(2);} else if((tt)+2<NT){WAIT_BAR(1);} else {WAIT_BAR(0);} }while(0)
  for(;t+1<NT;t+=2){
    STEP(pB0,pB1,pA0,pA1,t,(t+3<NT),(t+1<NT),(t+1<NT));       ENDW(t);   RESC(); ROT();
    STEP(pA0,pA1,pB0,pB1,t+1,(t+4<NT),(t+2<NT),(t+2<NT));     ENDW(t+1); RESC(); ROT();
  }
  STEP(pB0,pB1,pA0,pA1,NT-1,false,false,false); RESC();
  { float sacc=pB0[0]+pB0[1]; _Pragma("unroll") for(int r=2;r<16;++r)sacc+=pB0[r]; _Pragma("unroll") for(int r=0;r<16;++r)sacc+=pB1[r]; l_reg+=sacc;
    pw0=(u32x4){PKW(pB0,0),PKW(pB0,2),PKW(pB0,4),PKW(pB0,6)};pw1=(u32x4){PKW(pB0,8),PKW(pB0,10),PKW(pB0,12),PKW(pB0,14)};pw2=(u32x4){PKW(pB1,0),PKW(pB1,2),PKW(pB1,4),PKW(pB1,6)};pw3=(u32x4){PKW(pB1,8),PKW(pB1,10),PKW(pB1,12),PKW(pB1,14)};
    SBAR(); pv(o,vb0+sl_cur,PAF(0),PAF(1),PAF(2),PAF(3)); }
  #undef PKW
  #undef PAF
  #undef VFR
  #undef PIN
  #undef MX3
  #undef GAPA
  #undef GAPB
  #undef EX
  #undef VRD
  #undef KRD
  #undef STEP
  #undef ENDW
  {auto rr=__builtin_amdgcn_permlane32_swap(__float_as_uint(l_reg),__float_as_uint(l_reg),false,false);l_reg=__uint_as_float(rr[0])+__uint_as_float(rr[1]);}
  l_reg+=__builtin_amdgcn_exp2f(sink2-mhat);
  if(hi==0)wsf[32+r32]=l_reg;asm volatile("s_waitcnt lgkmcnt(0)":::"memory");
  float rli[16];
  #pragma unroll
  for(int r=0;r<16;++r)rli[r]=__builtin_amdgcn_rcpf(wsf[32+crow(r,hi)]);
  unsigned char*Ow=Ou+(long)(wid*QBLK)*PO;
  { unsigned char*stg=(unsigned char*)(shm+LDS_OST)+wid*4096;
    #pragma unroll
    for(int r=0;r<16;++r){const int orow=crow(r,hi); const float s32=rli[r]*32.0f;
      const int pk=__builtin_amdgcn_cvt_pk_fp8_f32(__builtin_amdgcn_fmed3f(o[0][r]*s32,-448.0f,448.0f),__builtin_amdgcn_fmed3f(o[1][r]*s32,-448.0f,448.0f),0,false);
      stg[orow*64+r32]=(unsigned char)(pk&0xff); stg[orow*64+32+r32]=(unsigned char)((pk>>8)&0xff);}
    asm volatile("s_waitcnt lgkmcnt(0)":::"memory");
    #pragma unroll
    for(int i=0;i<2;++i){const int row=i*16+(lane>>2),ch=lane&3; const u32x4 v=*(const u32x4*)(stg+row*64+ch*16); *(u32x4*)(Ow+(long)row*PO+ch*16)=v;} }
  asm volatile("s_waitcnt lgkmcnt(0)\n\ts_barrier":::"memory");
  #undef DMA_K
  #undef DMA_V
  #undef TROW
  #undef CMASK
  #undef START
  #undef RESC
  #undef ROT
}
constexpr int LDS_V2=NSLOT*SLOTB, LDS_WS2=LDS_V2+NSLOT*2*SLOTB, LDS_OST2=LDS_WS2+NW*64*4, LDS_BYTES2=LDS_OST2+NW*4096;
template<int THRL> __device__ __forceinline__ void attn_unit128(const bf16*Qu,const bf16*__restrict__ Kh,const bf16*__restrict__ Vh,bf16*Ou,int PO,int NT,char*shm){
  constexpr int MODE=0; const int wadd=0,dq0=0; (void)wadd; (void)dq0;
  int tid=threadIdx.x; asm volatile("":"+v"(tid)); const int lane=tid&63,r32=lane&31,hi=lane>>5; const int wid=__builtin_amdgcn_readfirstlane(tid>>6);
  const bf16*Qw=Qu+(long)(wid*QBLK)*P;
  const unsigned lds0=(unsigned)(uintptr_t)shm;
  float*wsf=(float*)(shm+LDS_WS2)+wid*64;
  const bf16*ksrc=Kh+(long)lane*P+wid*8;
  const bf16*vsrc=Vh+(long)(16*(wid&3)+(lane>>2))*P+(wid>>2)*32+(lane&3)*8;
  const unsigned kdst=lds0+LDS_K+wid*1024, vdst=lds0+LDS_V2+wid*1024;
  #define TROW(t) ((long)(t)*KVBLK+((MODE==1&&(t)>=4)?(long)wadd:0l))
  #define DMA_K(t,slot) glds16(ksrc+TROW(t)*P,(unsigned)__builtin_amdgcn_readfirstlane(kdst+(slot)))
  #define DMA_V(t,slot) do{ glds16(vsrc+TROW(t)*P,(unsigned)__builtin_amdgcn_readfirstlane(vdst+2*(slot))); glds16(vsrc+TROW(t)*P+64,(unsigned)__builtin_amdgcn_readfirstlane(vdst+2*(slot)+8192)); }while(0)
  const int vb0=(int)(lds0+LDS_V2)+((lane>>4)&1)*32+(lane&3)*8+(4*hi+((lane&15)>>2))*64;
  const char*Kbase=shm+LDS_K; bf16x8 kf[8];
  const lds_cptr shm3=(lds_cptr)shm; const lds_cptr kp0=shm3+LDS_K+hi*1024+r32*16; const lds_cptr vp0=shm3+LDS_V2+((lane>>4)&1)*32+(lane&3)*8+(4*hi+((lane&15)>>2))*64;
  DMA_K(0,0);DMA_V(0,0);DMA_K(1,SLOTB);
  bf16x8 qr[4];
  #pragma unroll
  for(int d0=0;d0<4;++d0)qr[d0]=*reinterpret_cast<const bf16x8*>(&Qw[(long)r32*P+d0*16+hi*8]);
  float mhat=0.f,l_reg=0.f;f32x16 o[4];o[0]=f32x16{};o[1]=f32x16{};o[2]=f32x16{};o[3]=f32x16{};f32x16 negm=f32x16{};asm volatile("":"+v"(negm));
  const int qrel=wid*QBLK+r32;
  const int dlane=dq0-qrel+4*hi;
  #define CMASK(P0,P1,t) do{ if(MODE==1){ if((t)>=4) wmask(P0,P1,dlane+64*((t)-4)); } }while(0)
  bool resc=false;
  #define START(P0,P1) do{ const float rm=rowmax(P0,P1); resc=false; \
    { const float dl=rm; mhat=fadd_s(mhat,dl); \
      _Pragma("unroll") for(int r=0;r<16;++r){P0[r]=fsub_s(P0[r],dl);P1[r]=fsub_s(P1[r],dl);} \
      _Pragma("unroll") for(int r=0;r<16;++r)negm[r]=-mhat; asm volatile("":"+v"(negm)); } \
    _Pragma("unroll") for(int r=0;r<16;++r)P0[r]=__builtin_amdgcn_exp2f(P0[r]); }while(0)
  #define RESC() do{ if(resc){ asm volatile("s_waitcnt lgkmcnt(0)":::"memory"); \
      _Pragma("unroll") for(int d_=0;d_<4;++d_) _Pragma("unroll") for(int r=0;r<16;++r)o[d_][r]*=wsf[crow(r,hi)]; } }while(0)
  f32x16 pA0,pA1,pB0,pB1;
  int sl_prev=0,sl_cur=0,sl_next=SLOTB;
  #define ROT() do{sl_prev=sl_cur;sl_cur=sl_next;sl_next=(sl_next==(NSLOT-1)*SLOTB)?0:sl_next+SLOTB;}while(0)
  DMA_K(2,2*SLOTB);
  WAIT_BAR(4);
  qkt(pA0,pA1,Kbase,qr,negm,r32,hi);asm volatile("s_nop 15\n\ts_nop 7":"+v"(pA0),"+v"(pA1));
  START(pA0,pA1);
  _Pragma("unroll") for(int r=0;r<16;++r)pA1[r]=__builtin_amdgcn_exp2f(pA1[r]);
  WAIT_BAR(0);
  DMA_K(3,0);DMA_V(1,SLOTB);
  ROT();
  kload8(kf,kp0+sl_cur);
  WAIT_BAR(3);
  s16x4 vlo[8],vhi[8]; u32x4 pw0,pw1,pw2,pw3;
  #define PKW(P,B) cvtpk_s(P[B],P[B+1])
  #define PAF(k) __builtin_bit_cast(bf16x8,pw##k)
  #define VFR(i) (bf16x8){vlo[i][0],vlo[i][1],vlo[i][2],vlo[i][3],vhi[i][0],vhi[i][1],vhi[i][2],vhi[i][3]}
  #define PIN(x) asm volatile("":"+v"(x))
  #define MX3(a,b,c) __builtin_fmaxf(__builtin_fmaxf((a),(b)),(c))
  #define GAPA(MF,A0,A1,A2,A3,W0,W1,PW) do{ MF; sacc+=A0; sacc+=A1; sacc+=A2; sacc+=A3; PIN(sacc); W0; W1; PIN(PW); SBAR(); }while(0)
  #define EX(v) __builtin_amdgcn_exp2f(v)
  #define GAPB(MF,X,B) do{ MF; X[B]=EX(X[B]); X[B+1]=EX(X[B+1]); X[B+2]=EX(X[B+2]); X[B+3]=EX(X[B+3]); PIN(X); SBAR(); }while(0)
  #define GAPH(MF,X,B) do{ MF; X[B]=EX(X[B]); X[B+1]=EX(X[B+1]); PIN(X); SBAR(); }while(0)
  #define VRD2(d,i) do{ vlo[d]=vtr(vp_+(((i)>>2)*4096+((i)&3)*1024)); vhi[d]=vtr(vp_+(((i)>>2)*4096+((i)&3)*1024+512)); }while(0)
  #define VRD(i) do{ vlo[i]=vtr(vp_+(((i)>>2)*4096+((i)&3)*1024)); vhi[i]=vtr(vp_+(((i)>>2)*4096+((i)&3)*1024+512)); }while(0)
  #define KRD(G,j) do{ if(G){ kload2(kf,kp0+sl_next,j); SBAR(); } }while(0)
  #define STEP(C0,C1,P0,P1,t,GK,GV,GL) do{ SBAR(); \
    const lds_cptr vp_=vp0+2*sl_prev; \
    VRD(0); SBAR(); float sacc=(P0[0]+P0[1]); \
    GAPA(C0=__builtin_amdgcn_mfma_f32_32x32x16_bf16(kf[0],qr[0],negm,0,0,0), P0[2],P0[3],P0[4],P0[5],     pw0[0]=PKW(P0,0), pw0[1]=PKW(P0,2), pw0); \
    VRD(4); SBAR(); GAPA(C1=__builtin_amdgcn_mfma_f32_32x32x16_bf16(kf[1],qr[0],negm,0,0,0), P0[6],P0[7],P0[8],P0[9],     pw0[2]=PKW(P0,4), pw0[3]=PKW(P0,6), pw0); \
    VRD(1); SBAR(); GAPA(C0=__builtin_amdgcn_mfma_f32_32x32x16_bf16(kf[2],qr[1],C0,0,0,0),   P0[10],P0[11],P0[12],P0[13], pw1[0]=PKW(P0,8), pw1[1]=PKW(P0,10), pw1); \
    VRD(5); SBAR(); GAPA(C1=__builtin_amdgcn_mfma_f32_32x32x16_bf16(kf[3],qr[1],C1,0,0,0),   P0[14],P0[15],P1[0],P1[1],   pw1[2]=PKW(P0,12),pw1[3]=PKW(P0,14), pw1); \
    VRD(2); SBAR(); GAPA(C0=__builtin_amdgcn_mfma_f32_32x32x16_bf16(kf[4],qr[2],C0,0,0,0),   P1[2],P1[3],P1[4],P1[5],     pw2[0]=PKW(P1,0), pw2[1]=PKW(P1,2), pw2); \
    VRD(6); SBAR(); GAPA(C1=__builtin_amdgcn_mfma_f32_32x32x16_bf16(kf[5],qr[2],C1,0,0,0),   P1[6],P1[7],P1[8],P1[9],     pw2[2]=PKW(P1,4), pw2[3]=PKW(P1,6), pw2); \
    VRD(3); SBAR(); GAPA(C0=__builtin_amdgcn_mfma_f32_32x32x16_bf16(kf[6],qr[3],C0,0,0,0),   P1[10],P1[11],P1[12],P1[13], pw3[0]=PKW(P1,8), pw3[1]=PKW(P1,10), pw3); \
    VRD(7); SBAR(); GAPA(C1=__builtin_amdgcn_mfma_f32_32x32x16_bf16(kf[7],qr[3],C1,0,0,0),   P1[14],P1[15],0.f,0.f,       pw3[2]=PKW(P1,12),pw3[3]=PKW(P1,14), pw3); \
    l_reg+=sacc; \
    if(GK){DMA_K((t)+3,sl_cur);} if(GV){DMA_V((t)+1,sl_next);} \
    CMASK(C0,C1,t); \
    { float a=MX3(C0[0],C0[1],C1[0]),b=MX3(C0[2],C0[3],C1[1]); a=MX3(a,C1[2],C1[3]); \
      _Pragma("unroll") for(int r=4;r<16;r+=4){a=MX3(a,C0[r],C0[r+1]);b=MX3(b,C0[r+2],C0[r+3]);a=MX3(a,C1[r],C1[r+1]);b=MX3(b,C1[r+2],C1[r+3]);} \
      float rm=__builtin_fmaxf(a,b); { auto rr=__builtin_amdgcn_permlane32_swap(__float_as_uint(rm),__float_as_uint(rm),false,false); rm=__builtin_fmaxf(__uint_as_float(rr[0]),__uint_as_float(rr[1])); } \
      resc=false; \
      if(__builtin_expect(__any(rm>(float)THRL),0)){ const float dl=__builtin_fmaxf(rm,0.f); mhat+=dl; \
        _Pragma("unroll") for(int r=0;r<16;++r){C0[r]-=dl;C1[r]-=dl;} \
        _Pragma("unroll") for(int r=0;r<16;++r)negm[r]=-mhat; asm volatile("":"+v"(negm)); \
        const float f=__builtin_amdgcn_exp2f(-dl); l_reg*=f; if(hi==0)wsf[r32]=f; resc=true; } } \
    SBAR(); \
    GAPH(o[0]=__builtin_amdgcn_mfma_f32_32x32x16_bf16(PAF(0),VFR(0),o[0],0,0,0), C0,0);  VRD2(0,8);  SBAR(); \
    GAPH(o[1]=__builtin_amdgcn_mfma_f32_32x32x16_bf16(PAF(0),VFR(4),o[1],0,0,0), C0,2);  VRD2(4,12); SBAR(); \
    GAPH(o[0]=__builtin_amdgcn_mfma_f32_32x32x16_bf16(PAF(1),VFR(1),o[0],0,0,0), C0,4);  VRD2(1,9);  SBAR(); \
    GAPH(o[1]=__builtin_amdgcn_mfma_f32_32x32x16_bf16(PAF(1),VFR(5),o[1],0,0,0), C0,6);  VRD2(5,13); SBAR(); \
    GAPH(o[0]=__builtin_amdgcn_mfma_f32_32x32x16_bf16(PAF(2),VFR(2),o[0],0,0,0), C0,8);  VRD2(2,10); SBAR(); \
    GAPH(o[1]=__builtin_amdgcn_mfma_f32_32x32x16_bf16(PAF(2),VFR(6),o[1],0,0,0), C0,10); VRD2(6,14); SBAR(); \
    GAPH(o[0]=__builtin_amdgcn_mfma_f32_32x32x16_bf16(PAF(3),VFR(3),o[0],0,0,0), C0,12); VRD2(3,11); SBAR(); \
    GAPH(o[1]=__builtin_amdgcn_mfma_f32_32x32x16_bf16(PAF(3),VFR(7),o[1],0,0,0), C0,14); VRD2(7,15); SBAR(); \
    GAPH(o[2]=__builtin_amdgcn_mfma_f32_32x32x16_bf16(PAF(0),VFR(0),o[2],0,0,0), C1,0); \
    GAPH(o[3]=__builtin_amdgcn_mfma_f32_32x32x16_bf16(PAF(0),VFR(4),o[3],0,0,0), C1,2); \
    KRD(GL,0); GAPH(o[2]=__builtin_amdgcn_mfma_f32_32x32x16_bf16(PAF(1),VFR(1),o[2],0,0,0), C1,4); \
    KRD(GL,1); GAPH(o[3]=__builtin_amdgcn_mfma_f32_32x32x16_bf16(PAF(1),VFR(5),o[3],0,0,0), C1,6); \
    KRD(GL,2); GAPH(o[2]=__builtin_amdgcn_mfma_f32_32x32x16_bf16(PAF(2),VFR(2),o[2],0,0,0), C1,8); \
    KRD(GL,3); GAPH(o[3]=__builtin_amdgcn_mfma_f32_32x32x16_bf16(PAF(2),VFR(6),o[3],0,0,0), C1,10); \
    GAPH(o[2]=__builtin_amdgcn_mfma_f32_32x32x16_bf16(PAF(3),VFR(3),o[2],0,0,0), C1,12); \
    GAPH(o[3]=__builtin_amdgcn_mfma_f32_32x32x16_bf16(PAF(3),VFR(7),o[3],0,0,0), C1,14); \
    }while(0)
  int t=1;
  if(MODE==0){
    for(;t+5<NT;t+=2){
      STEP(pB0,pB1,pA0,pA1,t,true,true,true);     WAIT_BAR(3); RESC(); ROT();
      STEP(pA0,pA1,pB0,pB1,t+1,true,true,true);   WAIT_BAR(3); RESC(); ROT();
    }
  }
  #define ENDW(tt) do{ if((tt)+3<NT){WAIT_BAR(3);} else if((tt)+2<NT){WAIT_BAR(2);} else {WAIT_BAR(0);} }while(0)
  for(;t+1<NT;t+=2){
    STEP(pB0,pB1,pA0,pA1,t,(t+3<NT),(t+1<NT),(t+1<NT));       ENDW(t);   RESC(); ROT();
    STEP(pA0,pA1,pB0,pB1,t+1,(t+4<NT),(t+2<NT),(t+2<NT));     ENDW(t+1); RESC(); ROT();
  }
  STEP(pB0,pB1,pA0,pA1,NT-1,false,false,false); RESC();
  { float sacc=pB0[0]+pB0[1]; _Pragma("unroll") for(int r=2;r<16;++r)sacc+=pB0[r]; _Pragma("unroll") for(int r=0;r<16;++r)sacc+=pB1[r]; l_reg+=sacc;
    pw0=(u32x4){PKW(pB0,0),PKW(pB0,2),PKW(pB0,4),PKW(pB0,6)};pw1=(u32x4){PKW(pB0,8),PKW(pB0,10),PKW(pB0,12),PKW(pB0,14)};pw2=(u32x4){PKW(pB1,0),PKW(pB1,2),PKW(pB1,4),PKW(pB1,6)};pw3=(u32x4){PKW(pB1,8),PKW(pB1,10),PKW(pB1,12),PKW(pB1,14)};
    SBAR(); pv(o,vb0+2*sl_cur,PAF(0),PAF(1),PAF(2),PAF(3)); pv(o+2,vb0+2*sl_cur+8192,PAF(0),PAF(1),PAF(2),PAF(3)); }
  #undef PKW
  #undef PAF
  #undef VFR
  #undef PIN
  #undef MX3
  #undef GAPA
  #undef GAPB
  #undef GAPH
  #undef VRD2
  #undef EX
  #undef VRD
  #undef KRD
  #undef STEP
  #undef ENDW
  {auto rr=__builtin_amdgcn_permlane32_swap(__float_as_uint(l_reg),__float_as_uint(l_reg),false,false);l_reg=__uint_as_float(rr[0])+__uint_as_float(rr[1]);}
  if(hi==0)wsf[32+r32]=l_reg;asm volatile("s_waitcnt lgkmcnt(0)":::"memory");
  float rli[16];
  #pragma unroll
  for(int r=0;r<16;++r)rli[r]=__builtin_amdgcn_rcpf(wsf[32+crow(r,hi)]);
  bf16*Ow=Ou+(long)(wid*QBLK)*PO;
  { bf16*stg=(bf16*)(shm+LDS_OST2)+wid*2048;
    #pragma unroll
    for(int hp=0;hp<2;++hp){
      #pragma unroll
      for(int r=0;r<16;++r){const int orow=crow(r,hi);
        #pragma unroll
        for(int d0=0;d0<2;++d0)stg[orow*64+d0*32+r32]=__float2bfloat16(o[2*hp+d0][r]*rli[r]);}
      asm volatile("s_waitcnt lgkmcnt(0)":::"memory");
      #pragma unroll
      for(int i=0;i<4;++i){const int row=i*8+(lane>>3),ch=lane&7; const u32x4 v=*(const u32x4*)(stg+row*64+ch*8); *(u32x4*)(Ow+(long)row*PO+hp*64+ch*8)=v;}
      asm volatile("s_waitcnt lgkmcnt(0)":::"memory"); } }
  asm volatile("s_waitcnt lgkmcnt(0)\n\ts_barrier":::"memory");
  #undef DMA_K
  #undef DMA_V
  #undef TROW
  #undef CMASK
  #undef START
  #undef RESC
  #undef ROT
}
static_assert(LDS_BYTES2<=131072,"attention LDS");
constexpr int ATTN_LDS_BYTES=LDS_BYTES;
#undef SBAR
#undef WAIT_BAR
}
constexpr int NWAVES = 8;
constexpr int NB = 8, SEQ = 8192, TCTX = 256, RB = SEQ + TCTX  , R = NB * RB  ;
constexpr int D = 1024, NL = 4, NPAN = R / 256  , QKVW = 3072;
constexpr int NE = 128, TOPK = 8, CAP = R  , MAXTILES = 2240, MAXSLOTS = MAXTILES * 256;
constexpr float EPS = 1e-6f, LOG2E = 1.4426950408889634f, WG8_SCALE = 64.0f; constexpr int W8_EXP = 127 - 3;
constexpr int PH_PER_LAYER = 13, NPH = 2 + NL * PH_PER_LAYER;
enum { I_X = 0, I_C, I_CTX, I_CCTX, I_WMOD, I_BMOD, I_G1, I_WQKV, I_GQA, I_GKA, I_SINK, I_LQ1, I_LK1, I_LQ2, I_LK2, I_GSUB, I_WBRA, I_WBRB, I_WBRC, I_WGATE, I_BGATE, I_WOUT, I_G2, I_WR, I_EBIAS,
       I_W1, I_W3, I_W2, I_WS1, I_WS3, I_WS2, I_GF, N_IN };

constexpr size_t MiB = 1u << 20;
constexpr size_t WS_CTL = 0, CTL_ZERO_BYTES = 1 * MiB;
constexpr size_t WS_MOD = 1 * MiB;
constexpr size_t WS_LAYP = WS_MOD + 960 * 1024;
constexpr size_t WS_ROPE = 2 * MiB;
constexpr size_t WS_WSM = 4 * MiB, WSM_LAYER = 19 * MiB;
constexpr size_t WL_QKV = 0, WL_GATE = 6 * MiB, WL_BR = 12 * MiB, WL_OUT = 15 * MiB, WL_R = 17 * MiB, WL_S13 = 17 * MiB + 512 * 1024, WL_S2 = 18 * MiB + 512 * 1024;
constexpr size_t WS_E13 = 80 * MiB;
constexpr size_t WS_E2 = 208 * MiB;
constexpr size_t WS_XC = 272 * MiB;
constexpr size_t WS_A = 280 * MiB;
constexpr size_t WS_HS = 412 * MiB;
constexpr size_t WS_HR = 445 * MiB;
constexpr size_t WS_XB = 588 * MiB;
constexpr size_t WS_LIST = 725 * MiB;
constexpr size_t WS_EP = 758 * MiB;
constexpr size_t WS_WT = 761 * MiB;
constexpr size_t WS_LOG = 764 * MiB;
constexpr size_t WS_DBG = 797 * MiB;
constexpr size_t WS_YR = 800 * MiB;
constexpr size_t WS_YS = 1400 * MiB;
constexpr size_t WS_QKV = 800 * MiB;
constexpr size_t WS_YA = 1196 * MiB, WS_YB = 1229 * MiB, WS_YC = 1262 * MiB;
constexpr size_t WS_MG8 = 1295 * MiB;
constexpr size_t WS_OC = 1394 * MiB;
constexpr size_t WS_MG = 1526 * MiB;
constexpr size_t WS_WR2 = 1920 * MiB, WR2_LAYER = 1536 * 1024;
constexpr size_t WS_A8 = 1926 * MiB;
constexpr size_t WS_WG8 = 1992 * MiB, WG8_LAYER = 3 * MiB;
constexpr size_t WS_WQ8 = 2004 * MiB;
constexpr size_t WS_WS8 = 2016 * MiB, WS8_LAYER = 512 * 1024;
constexpr size_t WS_END = 2018 * MiB;
static_assert(WS_YR + (size_t)MAXSLOTS * 2048 <= WS_END && WS_MG + (size_t)R * 2048 <= WS_END && WS_HR + (size_t)MAXSLOTS * 256 <= WS_XB && WS_XB + (size_t)R * 2048 <= WS_LIST && WS_A + (size_t)R * 2048 <= WS_HS, "d_ws map");
constexpr int CW_BAR = 4096;
constexpr int CW_CNT = 16384, CNT_STRIDE = 64;
constexpr int CW_ERR = 65536;

constexpr int RING_OFF = 0, RING_BYTES = 131072;
constexpr int LDSCTL_OFF = RING_BYTES, MISC_OFF = LDSCTL_OFF + 320;
constexpr int MOE_OFF = LDSCTL_OFF + 512;
constexpr int ROPE1_OFF = LDSCTL_OFF + 6144;
constexpr int LDS_BYTES = 147456;
static_assert(MOE_OFF + 132 * 4 + 128 * 4 + MAXTILES * 2 <= LDS_BYTES && attn_body::ATTN_LDS_BYTES <= RING_BYTES, "LDS map");

#define GAS __attribute__((address_space(1)))
#define LAS __attribute__((address_space(3)))
typedef unsigned short bf16;
typedef unsigned v4u __attribute__((ext_vector_type(4)));
typedef unsigned v2u __attribute__((ext_vector_type(2)));
typedef float f32x4 __attribute__((ext_vector_type(4)));
typedef float f32x2 __attribute__((ext_vector_type(2)));
typedef GAS unsigned gu32;
#define RLX_AGENT __ATOMIC_RELAXED, __HIP_MEMORY_SCOPE_AGENT
#define LDS_WAIT() asm volatile("s_waitcnt lgkmcnt(0)" ::: "memory")
#define VM_WAIT() asm volatile("s_waitcnt vmcnt(0)" ::: "memory")
__device__ __forceinline__ unsigned f2bf(float f) { unsigned u = __builtin_bit_cast(unsigned, f); return (u + 0x7fffu + ((u >> 16) & 1u)) >> 16; }
__device__ __forceinline__ unsigned pk2(float lo, float hi) { return f2bf(lo) | (f2bf(hi) << 16); }
__device__ __forceinline__ float bflo(unsigned w) { return __builtin_bit_cast(float, w << 16); }
__device__ __forceinline__ float bfhi(unsigned w) { return __builtin_bit_cast(float, w & 0xffff0000u); }

#define XB_TMO      128
#define XB_XCNT(j)  (256  + 64 * (j))
#define XB_XSUB(j)  (1280 + 64 * (j))
#define XB_XGEN(j)  (2304 + 64 * (j))
#define XB_TOP      3328
#define XB_TOPGEN   3392
#define XCD_BAR_WORDS 3456
#define XB_SPIN_CAP (1u << 22)

__device__ __forceinline__ unsigned xb_ld(unsigned* p)              { return __hip_atomic_load(p, __ATOMIC_RELAXED, __HIP_MEMORY_SCOPE_AGENT); }
__device__ __forceinline__ unsigned xb_add(unsigned* p, unsigned v) { return __hip_atomic_fetch_add(p, v, __ATOMIC_RELAXED, __HIP_MEMORY_SCOPE_AGENT); }
__device__ __forceinline__ unsigned xb_xcc_id() { return (unsigned)__builtin_amdgcn_s_getreg((3 << 11) | 20) & 0xFu; }
#define XB_SPIN(cond, bar) do { unsigned _sp = 0; while (cond) { __builtin_amdgcn_s_sleep(1); \
    if ((++_sp & 255u) == 0u) { if (xb_ld(&(bar)[XB_TMO])) break; if (_sp > XB_SPIN_CAP) { atomicAdd(&(bar)[XB_TMO], 1u); break; } } } } while (0)

struct XcdBarrier {
    unsigned* bar; unsigned x;
    volatile LAS unsigned* st;
};
__device__ __forceinline__ XcdBarrier xcd_barrier_post(unsigned* bar, volatile LAS unsigned* st) {
    XcdBarrier b; b.bar = bar; b.x = xb_xcc_id(); b.st = st;
    if (threadIdx.x == 0) (void)xb_add(&bar[XB_XCNT(b.x)], 1u);
    return b;
}
__device__ __forceinline__ void xcd_barrier_complete(unsigned* bar, unsigned x, unsigned& nloc, unsigned& nx) {
    const unsigned G = gridDim.x * gridDim.y * gridDim.z;
    unsigned sum, cnt, mine, sp = 0u;
    for (;;) {
        sum = 0u; cnt = 0u; mine = 0u;
#pragma unroll
        for (unsigned j = 0; j < 16; ++j) { const unsigned c = xb_ld(&bar[XB_XCNT(j)]); sum += c; cnt += (c > 0u) ? 1u : 0u; mine = (j == x) ? c : mine; }
        if (sum == G) break;
        __builtin_amdgcn_s_sleep(1);
        if ((++sp & 255u) == 0u) { if (xb_ld(&bar[XB_TMO])) break; if (sp > XB_SPIN_CAP) { atomicAdd(&bar[XB_TMO], 1u); break; } }
    }
    nloc = mine > 0u ? mine : 1u; nx = cnt > 0u ? cnt : 1u;
}
__device__ __forceinline__ void xcd_barrier(const XcdBarrier& b) {
    asm volatile("s_waitcnt vmcnt(0)" ::: "memory");
    __syncthreads();
    if (threadIdx.x == 0) {
        unsigned* bar = b.bar;
        __builtin_amdgcn_s_waitcnt(0);
        unsigned nloc = b.st[0], nx = b.st[1];
        if (nloc == 0u) { xcd_barrier_complete(bar, b.x, nloc, nx); b.st[0] = nloc; b.st[1] = nx; }
        const unsigned old = xb_add(&bar[XB_XSUB(b.x)], 1u);
        const unsigned gen = old / nloc;
        if (old + 1u == (gen + 1u) * nloc) {
            __builtin_amdgcn_fence(__ATOMIC_RELEASE, "agent");
            asm volatile("s_waitcnt vmcnt(0)" ::: "memory");
            const unsigned og = xb_add(&bar[XB_TOP], 1u);
            const unsigned tg = og / nx;
            if (og + 1u == (tg + 1u) * nx) xb_add(&bar[XB_TOPGEN], 1u);
            else XB_SPIN(xb_ld(&bar[XB_TOPGEN]) == tg, bar);
            __builtin_amdgcn_fence(__ATOMIC_ACQUIRE, "agent");
            xb_add(&bar[XB_XGEN(b.x)], 1u);
            asm volatile("s_waitcnt vmcnt(0)" ::: "memory");
        } else {
            XB_SPIN(xb_ld(&bar[XB_XGEN(b.x)]) == gen, bar);
            __builtin_amdgcn_fence(__ATOMIC_ACQUIRE, "agent");
            asm volatile("s_waitcnt vmcnt(0)" ::: "memory");
        }
    }
    __syncthreads();
}

struct Args { const float* in[N_IN]; float* out; unsigned char* ws; int ph_lo, ph_hi; };
typedef const __attribute__((address_space(4))) Args* KArgs;

template <int M> __device__ __forceinline__ float xor_f(float v) { static_assert(M >= 1 && M < 32, "xor within 32 lanes"); return __builtin_bit_cast(float, __builtin_amdgcn_ds_swizzle(__builtin_bit_cast(int, v), (M << 10) | 0x1f)); }
__device__ __forceinline__ float half_other(float v, float& own) { const unsigned a = __builtin_bit_cast(unsigned, v); auto rr = __builtin_amdgcn_permlane32_swap(a, a, false, false); const unsigned r0 = rr[0], r1 = rr[1]; own = __uint_as_float(r0); return __uint_as_float(r1); }
__device__ __forceinline__ float lane_f(float v, int src) { return __builtin_bit_cast(float, __builtin_amdgcn_readlane(__builtin_bit_cast(int, v), src)); }
__device__ __forceinline__ int lane_i(int v, int src) { return __builtin_amdgcn_readlane(v, src); }
template <int CTRL> __device__ __forceinline__ float dpp_f(float v) { return __builtin_bit_cast(float, __builtin_amdgcn_update_dpp(__builtin_bit_cast(int, v), __builtin_bit_cast(int, v), CTRL, 0xf, 0xf, false)); }
__device__ __forceinline__ float row16_sum(float v) { v += dpp_f<0xB1>(v); v += dpp_f<0x4E>(v); v += dpp_f<0x141>(v); v += dpp_f<0x140>(v); return v; }
__device__ __forceinline__ float row16_max(float v) { v = fmaxf(v, dpp_f<0xB1>(v)); v = fmaxf(v, dpp_f<0x4E>(v)); v = fmaxf(v, dpp_f<0x141>(v)); v = fmaxf(v, dpp_f<0x140>(v)); return v; }
__device__ __forceinline__ float wave_sum(float v) {
    v = row16_sum(v); return (lane_f(v, 0) + lane_f(v, 16)) + (lane_f(v, 32) + lane_f(v, 48));
}
__device__ __forceinline__ float wave_max(float v) {
    v = row16_max(v); return fmaxf(fmaxf(lane_f(v, 0), lane_f(v, 16)), fmaxf(lane_f(v, 32), lane_f(v, 48)));
}
__device__ __forceinline__ float* xrow_ptr(float* XL, float* XC, int r) { const int b = r / RB, j = r - b * RB; return (j < TCTX) ? XC + ((size_t)b * TCTX + j) * D : XL + ((size_t)b * SEQ + (j - TCTX)) * D; }

template <int RMAP> __device__ __forceinline__ void tr_block(const float* W, int ldw, int k0, int n0, bf16* WT, int ldt, int drow0, LAS float* scr, int lane) {
    const int c4 = lane & 7, kr = lane >> 3;
    f32x4 t[8];
#pragma unroll
    for (int i = 0; i < 8; ++i) t[i] = __builtin_nontemporal_load((const GAS f32x4*)(W + (size_t)(k0 + 8 * i + kr) * ldw + n0 + 4 * c4));
#pragma unroll
    for (int i = 0; i < 8; ++i) { LAS float* d = scr + (8 * i + kr) * 33 + 4 * c4; d[0] = t[i].x; d[1] = t[i].y; d[2] = t[i].z; d[3] = t[i].w; }
    LDS_WAIT(); asm volatile("" ::: "memory");
    const int c = lane & 7;
#pragma unroll
    for (int j = 0; j < 4; ++j) { const int n = (lane >> 3) + 8 * j; const LAS float* s = scr + (8 * c) * 33 + n;
        v4u o; o.x = pk2(s[0 * 33], s[1 * 33]); o.y = pk2(s[2 * 33], s[3 * 33]); o.z = pk2(s[4 * 33], s[5 * 33]); o.w = pk2(s[6 * 33], s[7 * 33]);
        const int drow = (RMAP == 3) ? drow0 + 128 * ((n >> 3) & 1) + 8 * ((n >> 4) & 1) + (n & 7) : drow0 + n;
        *(GAS v4u*)(WT + (size_t)drow * ldt + k0 + 8 * c) = o; }
    LDS_WAIT(); asm volatile("" ::: "memory");
}
__device__ __forceinline__ void tr_block_split(const float* W, int ldw, int k0, int n0, bf16* WT, LAS float* scr, int lane) {
#pragma unroll 8
    for (int i = 0; i < 32; ++i) { const int kk = 2 * i + (lane >> 5); scr[kk * 33 + (lane & 31)] = W[(size_t)(k0 + kk) * ldw + n0 + (lane & 31)]; }
    LDS_WAIT(); asm volatile("" ::: "memory");
    const int c = lane & 7;
#pragma unroll
    for (int j = 0; j < 4; ++j) { const int n = (lane >> 3) + 8 * j; const LAS float* s = scr + (8 * c) * 33 + n;
        float w[8], lo[8];
#pragma unroll
        for (int q = 0; q < 8; ++q) { w[q] = s[q * 33]; lo[q] = w[q] - __builtin_bit_cast(float, f2bf(w[q]) << 16); }
        const v4u oh = (v4u){pk2(w[0], w[1]), pk2(w[2], w[3]), pk2(w[4], w[5]), pk2(w[6], w[7])}, ol = (v4u){pk2(lo[0], lo[1]), pk2(lo[2], lo[3]), pk2(lo[4], lo[5]), pk2(lo[6], lo[7])};
        bf16* row = WT + (size_t)(n0 + n) * 3072 + k0 + 8 * c;
        *(GAS v4u*)(row) = oh; *(GAS v4u*)(row + 1024) = ol; *(GAS v4u*)(row + 2048) = oh; }
    LDS_WAIT(); asm volatile("" ::: "memory");
}
template <int RMAP = 0> __device__ __forceinline__ void tr_block8(const float* W, int ldw, int k0, int n0, unsigned char* WT8, int ldt8, int drow0, float scale, LAS float* scr, int lane) {
    const int c4 = lane & 7, kr = lane >> 3;
    f32x4 t[8];
#pragma unroll
    for (int i = 0; i < 8; ++i) t[i] = *(const GAS f32x4*)(W + (size_t)(k0 + 8 * i + kr) * ldw + n0 + 4 * c4);
#pragma unroll
    for (int i = 0; i < 8; ++i) { LAS float* d = scr + (8 * i + kr) * 33 + 4 * c4; d[0] = t[i].x; d[1] = t[i].y; d[2] = t[i].z; d[3] = t[i].w; }
    LDS_WAIT(); asm volatile("" ::: "memory");
    const int c = lane & 7;
#pragma unroll
    for (int j = 0; j < 4; ++j) { const int n = (lane >> 3) + 8 * j; const LAS float* sp = scr + (8 * c) * 33 + n;
        int p0 = __builtin_amdgcn_cvt_pk_fp8_f32(sp[0 * 33] * scale, sp[1 * 33] * scale, 0, false); p0 = __builtin_amdgcn_cvt_pk_fp8_f32(sp[2 * 33] * scale, sp[3 * 33] * scale, p0, true);
        int p1 = __builtin_amdgcn_cvt_pk_fp8_f32(sp[4 * 33] * scale, sp[5 * 33] * scale, 0, false); p1 = __builtin_amdgcn_cvt_pk_fp8_f32(sp[6 * 33] * scale, sp[7 * 33] * scale, p1, true);
        const int drow = (RMAP == 3) ? drow0 + 128 * ((n >> 3) & 1) + 8 * ((n >> 4) & 1) + (n & 7) : drow0 + n;
        *(GAS v2u*)(WT8 + (size_t)drow * ldt8 + k0 + 8 * c) = (v2u){(unsigned)p0, (unsigned)p1}; }
    LDS_WAIT(); asm volatile("" ::: "memory");
}
template <int MAP> __device__ __forceinline__ void tr_item(const float* W, int K, int N, bf16* WT, int row_off, int item, LAS float* scr, int lane) {
    const int nblk = N / 32, kb = item / nblk, nb = item - kb * nblk, k0 = 64 * kb, n0 = 32 * nb;
    const int drow0 = (MAP == 0) ? row_off + n0 : (MAP == 1) ? (n0 >> 7) * 256 + (n0 & 127) + row_off
                    : (MAP == 2) ? (n0 & ~255) + 128 * ((n0 >> 5) & 1) + 32 * ((n0 >> 6) & 3)
                                 : (n0 & ~255) + 32 * ((n0 >> 6) & 3) + 16 * ((n0 >> 5) & 1);
    tr_block<MAP == 3 ? 3 : 0>(W, N, k0, n0, WT, K, drow0, scr, lane);
}

#define PHASE_IDS() int tid_ = threadIdx.x; asm volatile("" : "+v"(tid_)); const int lane = tid_ & 63, wave = __builtin_amdgcn_readfirstlane(tid_ >> 6); const int G = gridDim.x, bx = blockIdx.x; \
    const int vcu = (G % 8 == 0) ? (bx % 8) * (G / 8) + bx / 8 : bx; const int gw = vcu * NWAVES + wave, NGW = G * NWAVES; (void)lane; (void)wave; (void)gw; (void)NGW; (void)vcu
__device__ __forceinline__ void phase_prologue(KArgs a, LAS unsigned char* lds) {
    PHASE_IDS();
    unsigned char* ws = a->ws;
    LAS float* scr = (LAS float*)(lds + RING_OFF + wave * 16384);
    constexpr int I_QKV = 16 * 96, I_GATE = 16 * 96, I_BR = 8 * 32, I_OUT = 16 * 32, I_R = 16 * 4, I_S1 = 16 * 8, I_S2 = 4 * 32;
    constexpr int PER_L = I_QKV + I_GATE + 3 * I_BR + I_OUT + I_R + 2 * I_S1 + I_S2;
    for (int it = gw; it < NL * PER_L; it += NGW) {
        const int l = it / PER_L; int r = it - l * PER_L; unsigned char* wl = ws + WS_WSM + (size_t)l * WSM_LAYER;
        if (r < I_QKV) { const int kb = r / 96, nb = r - kb * 96, n0 = 32 * nb; const int drow0 = (n0 & ~255) + 128 * ((n0 >> 5) & 1) + 32 * ((n0 >> 6) & 3);
            tr_block8(a->in[I_WQKV] + (size_t)l * D * QKVW, QKVW, 64 * kb, n0, ws + WS_WQ8 + (size_t)l * WG8_LAYER, D, drow0, WG8_SCALE, scr, lane); continue; } r -= I_QKV;
        if (r < I_GATE) { const int kb = r / 96, nb = r - kb * 96; tr_block8(a->in[I_WGATE] + (size_t)l * D * 3072, 3072, 64 * kb, 32 * nb, ws + WS_WG8 + (size_t)l * WG8_LAYER, D, 32 * nb, WG8_SCALE, scr, lane); continue; } r -= I_GATE;
        if (r < I_BR) { const int kb = r / 32, n0 = 32 * (r - kb * 32); tr_block8(a->in[I_WBRA] + (size_t)l * 512 * D, D, 64 * kb, n0, wl + WL_BR, 512, n0, 32.0f * (256.0f / 255.0f), scr, lane); continue; } r -= I_BR;
        if (r < I_BR) { const int kb = r / 32, n0 = 32 * (r - kb * 32); tr_block8(a->in[I_WBRB] + (size_t)l * 512 * D, D, 64 * kb, n0, wl + WL_BR + 1 * MiB, 512, n0, 32.0f * (256.0f / 255.0f), scr, lane); continue; } r -= I_BR;
        if (r < I_BR) { const int kb = r / 32, n0 = 32 * (r - kb * 32); tr_block8(a->in[I_WBRC] + (size_t)l * 512 * D, D, 64 * kb, n0, wl + WL_BR + 2 * MiB, 512, n0, 64.0f * (256.0f / 255.0f), scr, lane); continue; } r -= I_BR;
        if (r < I_OUT) { const int kb = r / 32, n0 = 32 * (r - kb * 32); tr_block8(a->in[I_WOUT] + (size_t)l * D * D, D, 64 * kb, n0, wl + WL_OUT, D, n0, WG8_SCALE, scr, lane); continue; } r -= I_OUT;
        if (r < I_R) { tr_item<0>(a->in[I_WR] + (size_t)l * D * NE, D, NE, (bf16*)(wl + WL_R), 0, r, scr, lane); continue; } r -= I_R;
        if (r < I_S1) { const int kb = r / 8, n0 = 32 * (r - kb * 8); tr_block8(a->in[I_WS1] + (size_t)l * D * 256, 256, 64 * kb, n0, ws + WS_WS8 + (size_t)l * WS8_LAYER, D, (n0 >> 7) * 256 + (n0 & 127), WG8_SCALE, scr, lane); continue; } r -= I_S1;
        if (r < I_S1) { const int kb = r / 8, n0 = 32 * (r - kb * 8); tr_block8(a->in[I_WS3] + (size_t)l * D * 256, 256, 64 * kb, n0, ws + WS_WS8 + (size_t)l * WS8_LAYER, D, (n0 >> 7) * 256 + (n0 & 127) + 128, WG8_SCALE, scr, lane); continue; } r -= I_S1;
        { const int kb = r / 32, n0 = 32 * (r - kb * 32); tr_block8<3>(a->in[I_WS2] + (size_t)l * 256 * D, D, 64 * kb, n0, wl + WL_S2, 256, (n0 & ~255) + 32 * ((n0 >> 6) & 3) + 16 * ((n0 >> 5) & 1), 32.0f, scr, lane); }
    }
    for (int it = gw; it < NL * 128; it += NGW) { const int l = it >> 7, row = 128 + (it & 127); GAS v4u* p = (GAS v4u*)(ws + WS_WSM + (size_t)l * WSM_LAYER + WL_R + (size_t)row * 2048);
        p[lane] = (v4u){0u, 0u, 0u, 0u}; p[64 + lane] = (v4u){0u, 0u, 0u, 0u}; }
    { f32x2* rope = (f32x2*)(ws + WS_ROPE);
      for (int i = gw * 64 + lane; i < SEQ * 32; i += NGW * 64) { const int t = i >> 5, ax = (i >> 4) & 1, f = i & 15;
          const float pos = (float)(ax == 0 ? (t >> 6) : (t & 63)); const float invf = powf(10000.0f, -(float)f / 16.0f); const float ang = pos * invf;
          rope[i] = (f32x2){(float)cos((double)ang), (float)sin((double)ang)}; } }
    if (gw == 0 && lane < NL) { const int l = lane; float d1 = 0.f, d2 = 0.f;
        for (int i = 0; i < 64; ++i) { d1 += a->in[I_LQ1][l * 64 + i] * a->in[I_LK1][l * 64 + i]; d2 += a->in[I_LQ2][l * 64 + i] * a->in[I_LK2][l * 64 + i]; }
        const float li = 0.8f - 0.6f * expf(-0.3f * (float)l); float* lp = (float*)(ws + WS_LAYP) + l * 4;
        lp[0] = expf(d1) - expf(d2) + li; lp[1] = li; lp[2] = 1.0f - li; lp[3] = 0.f; }
    __syncthreads();
    { LAS float* sl = (LAS float*)(lds + RING_OFF);
      LAS float* red = sl + 9 * 1024;
      float* MOD = (float*)(ws + WS_MOD);
      for (int i = threadIdx.x; i < 9 * 1024; i += NWAVES * 64) { const int m = i >> 10, k = i & 1023; const float cv = (m < 8) ? a->in[I_C][m * D + k] : a->in[I_CCTX][k]; sl[i] = cv / (1.0f + expf(-cv)); }
      __syncthreads();
      for (int item = blockIdx.x; item < NL * 96; item += gridDim.x) {
          const int l = item / 96, n0 = (item - l * 96) * 64;
          float acc[9];
#pragma unroll
          for (int m = 0; m < 9; ++m) acc[m] = 0.f;
          const float* wm = a->in[I_WMOD] + (size_t)l * D * 6144 + n0 + lane;
#pragma unroll 8
          for (int kk = 0; kk < 128; ++kk) { const int k = wave * 128 + kk; const float w = wm[(size_t)k * 6144];
#pragma unroll
              for (int m = 0; m < 9; ++m) acc[m] += sl[m * 1024 + k] * w; }
#pragma unroll
          for (int m = 0; m < 9; ++m) red[(wave * 9 + m) * 64 + lane] = acc[m];
          __syncthreads();
          for (int idx = threadIdx.x; idx < 9 * 64; idx += NWAVES * 64) { const int m = idx >> 6, ln = idx & 63; float s = 0.f;
#pragma unroll
              for (int w = 0; w < 8; ++w) s += red[(w * 9 + m) * 64 + ln];
              MOD[((size_t)l * 9 + m) * 6144 + n0 + ln] = s + a->in[I_BMOD][l * 6144 + n0 + ln]; }
          __syncthreads();
      } }
}

__device__ __forceinline__ void moe_tables(LAS unsigned char* lds, const unsigned* cnt, bool want_te) {
    LAS int* tb = (LAS int*)(lds + MOE_OFF); LAS int* cn = tb + 132; LAS unsigned short* te = (LAS unsigned short*)(cn + 128);
    int tid = threadIdx.x; asm volatile("" : "+v"(tid));
    __syncthreads();
    if (tid < NE) cn[tid] = (int)__hip_atomic_load(cnt + tid * CNT_STRIDE, RLX_AGENT);
    __syncthreads();
    if (tid == 0) { int s = 0; for (int e = 0; e < NE; ++e) { tb[e] = s; s += (cn[e] + 255) >> 8; } tb[NE] = s; }
    __syncthreads();
    if (want_te && tid < NE) { const int t0 = tb[tid], t1 = tb[tid + 1]; for (int t = t0; t < t1; ++t) te[t] = (unsigned short)tid; }
    __syncthreads();
}

__device__ __forceinline__ void ld16f(const float* p, int lane, f32x4 (&v)[4]) { const GAS f32x4* q = (const GAS f32x4*)p + 4 * lane; v[0] = q[0]; v[1] = q[1]; v[2] = q[2]; v[3] = q[3]; }
__device__ __forceinline__ void st16f(float* p, int lane, const f32x4 (&v)[4]) { GAS f32x4* q = (GAS f32x4*)p + 4 * lane; q[0] = v[0]; q[1] = v[1]; q[2] = v[2]; q[3] = v[3]; }
__device__ __forceinline__ void unpk8(const v4u u, f32x4& a, f32x4& b) { a = (f32x4){bflo(u.x), bfhi(u.x), bflo(u.y), bfhi(u.y)}; b = (f32x4){bflo(u.z), bfhi(u.z), bflo(u.w), bfhi(u.w)}; }
__device__ __forceinline__ v4u pk8(const f32x4 a, const f32x4 b) { return (v4u){pk2(a.x, a.y), pk2(a.z, a.w), pk2(b.x, b.y), pk2(b.z, b.w)}; }
__device__ __forceinline__ void ld16b(const bf16* p, int lane, f32x4 (&v)[4]) { const GAS v4u* q = (const GAS v4u*)p + 2 * lane; const v4u a = q[0], b = q[1]; unpk8(a, v[0], v[1]); unpk8(b, v[2], v[3]); }
__device__ __forceinline__ void st16b(bf16* p, int lane, const f32x4 (&v)[4]) { GAS v4u* q = (GAS v4u*)p + 2 * lane; q[0] = pk8(v[0], v[1]); q[1] = pk8(v[2], v[3]); }
__device__ __forceinline__ f32x4 fp8x4(unsigned w) { const f32x2 lo = __builtin_amdgcn_cvt_pk_f32_fp8((int)w, false), hi = __builtin_amdgcn_cvt_pk_f32_fp8((int)w, true); return (f32x4){lo.x, lo.y, hi.x, hi.y}; }
template <int KIND> __device__ __forceinline__ void phase_norm(KArgs a, LAS unsigned char* lds, int l, float dsc) {
    PHASE_IDS();
    unsigned char* ws = a->ws; const bool from_in = (KIND == 0 && l == 0);
    bf16* XB = (bf16*)(ws + WS_XB);
    const float* MOD = (const float*)(ws + WS_MOD);
    const bool comb = (KIND == 2) || (KIND == 0 && l > 0); const int lc = (KIND == 2) ? NL - 1 : l - 1;
    if (comb) moe_tables(lds, (const unsigned*)(ws + WS_CTL) + CW_CNT + lc * NE * CNT_STRIDE, false);
    const LAS int* tb = (const LAS int*)(lds + MOE_OFF);
    const unsigned char* YR = (const unsigned char*)(ws + WS_YR); const int* EP = (const int*)(ws + WS_EP); const float* WT = (const float*)(ws + WS_WT);
    bf16* A = (bf16*)(ws + WS_A);
    const float* gvec = (KIND == 0) ? a->in[I_G1] + l * D : (KIND == 1) ? a->in[I_G2] + l * D : a->in[I_GF];
    f32x4 gv[4]; ld16f(gvec, lane, gv);
    constexpr int NR = 2;
    for (int r0 = gw; r0 < R; r0 += NR * NGW) {
        int rr[NR], mbv[NR]; bool live[NR]; f32x4 v[NR][4];
#pragma unroll
        for (int u = 0; u < NR; ++u) { const int r = r0 + u * NGW; live[u] = r < R; rr[u] = live[u] ? r : r0; const int b = rr[u] / RB, j = rr[u] - b * RB; mbv[u] = (j < TCTX) ? 8 : b;
            if ((KIND == 2 || (KIND == 1 && l == NL - 1)) && j < TCTX) live[u] = false;
            if (from_in) ld16f(xrow_ptr((float*)a->in[I_X], (float*)a->in[I_CTX], rr[u]), lane, v[u]); else ld16b(XB + (size_t)rr[u] * D, lane, v[u]); }
        if (comb) {
            int slot[NR]; float w[NR];
#pragma unroll
            for (int u = 0; u < NR; ++u) { slot[u] = 0; w[u] = 0.f; if (lane < TOPK && (KIND != 2 || live[u])) { const int ep = EP[(size_t)rr[u] * 8 + lane]; slot[u] = tb[ep >> 17] * 256 + (ep & 0x1ffff); w[u] = WT[(size_t)rr[u] * 8 + lane] * (1.0f / 16.0f); } }
            f32x4 acc[NR][4];
#pragma unroll
            for (int u = 0; u < NR; ++u)
#pragma unroll
                for (int q = 0; q < 4; ++q) acc[u][q] = (f32x4){0.f, 0.f, 0.f, 0.f};
#pragma unroll
            for (int k = 0; k < TOPK; ++k)
#pragma unroll
                for (int u = 0; u < NR; ++u) { const int sk = lane_i(slot[u], k); const float wk = lane_f(w[u], k); const v4u y = __builtin_nontemporal_load((const GAS v4u*)(YR + (size_t)sk * D) + lane);
                    acc[u][0] += wk * fp8x4(y.x); acc[u][1] += wk * fp8x4(y.y); acc[u][2] += wk * fp8x4(y.z); acc[u][3] += wk * fp8x4(y.w); }
#pragma unroll
            for (int u = 0; u < NR; ++u) { const v4u y = ((const GAS v4u*)(ws + WS_YS + (size_t)rr[u] * D))[lane];
                acc[u][0] += (1.0f / 16.0f) * fp8x4(y.x); acc[u][1] += (1.0f / 16.0f) * fp8x4(y.y); acc[u][2] += (1.0f / 16.0f) * fp8x4(y.z); acc[u][3] += (1.0f / 16.0f) * fp8x4(y.w); }
#pragma unroll
            for (int u = 0; u < NR; ++u) { f32x4 g2[4]; ld16f(MOD + ((size_t)lc * 9 + mbv[u]) * 6144 + 5 * D, lane, g2);
#pragma unroll
                for (int q = 0; q < 4; ++q) v[u][q] += (g2[q] * dsc) * acc[u][q];
                if (KIND != 2 && live[u]) st16b(XB + (size_t)rr[u] * D, lane, v[u]); }
        }
#pragma unroll
        for (int u = 0; u < NR; ++u) {
            float s = 0.f;
#pragma unroll
            for (int q = 0; q < 4; ++q) s += (v[u][q].x * v[u][q].x + v[u][q].y * v[u][q].y) + (v[u][q].z * v[u][q].z + v[u][q].w * v[u][q].w);
            const float rs = 1.0f / sqrtf(wave_sum(s) * (1.f / D) + EPS);
            if (KIND == 2) { f32x4 o[4];
#pragma unroll
                for (int q = 0; q < 4; ++q) o[q] = v[u][q] * rs * gv[q];
                if (live[u]) st16f(xrow_ptr(a->out, nullptr, rr[u]), lane, o);
            } else {
                const float* md = MOD + ((size_t)l * 9 + mbv[u]) * 6144 + (KIND == 0 ? 0 : 3 * D);
                f32x4 sh[4], sc[4], y[4]; ld16f(md, lane, sh); ld16f(md + D, lane, sc);
#pragma unroll
                for (int q = 0; q < 4; ++q) y[q] = (v[u][q] * rs) * gv[q] * (sc[q] + 1.0f) + sh[q];
                if (live[u]) { if (KIND == 1 || MK_CHECK) { GAS v4u* o16 = (GAS v4u*)(A + (size_t)rr[u] * D) + 2 * lane; o16[0] = pk8(y[0], y[1]); o16[1] = pk8(y[2], y[3]); }
                    { v4u q8;
#pragma unroll
                        for (int q = 0; q < 4; ++q) { int p = __builtin_amdgcn_cvt_pk_fp8_f32(y[q].x, y[q].y, 0, false); p = __builtin_amdgcn_cvt_pk_fp8_f32(y[q].z, y[q].w, p, true); q8[q] = (unsigned)p; }
                        ((GAS v4u*)(ws + WS_A8 + (size_t)rr[u] * D))[lane] = q8; } }
            }
        }
    }
}

__device__ __forceinline__ void phase_convert_experts(KArgs a, LAS unsigned char* lds, int l, int it0, int it1, int widx, int nwg) {
    PHASE_IDS();
    LAS float* scr = (LAS float*)(lds + RING_OFF + wave * 16384);
    unsigned char* E13 = a->ws + WS_E13; unsigned char* E2 = a->ws + WS_E2;
    for (int it = it0 + widx * NWAVES + wave; it < it1; it += nwg * NWAVES) { const int e = it / 384; int r = it - e * 384;
        if (r < 128) { const int kb = r / 8, n0 = 32 * (r - kb * 8); tr_block8(a->in[I_W1] + ((size_t)l * NE + e) * D * 256, 256, 64 * kb, n0, E13 + (size_t)e * 512 * D, D, (n0 >> 7) * 256 + (n0 & 127), WG8_SCALE, scr, lane); continue; } r -= 128;
        if (r < 128) { const int kb = r / 8, n0 = 32 * (r - kb * 8); tr_block8(a->in[I_W3] + ((size_t)l * NE + e) * D * 256, 256, 64 * kb, n0, E13 + (size_t)e * 512 * D, D, (n0 >> 7) * 256 + (n0 & 127) + 128, WG8_SCALE, scr, lane); continue; } r -= 128;
        { const int kb = r / 32, n0 = 32 * (r - kb * 32); tr_block8<3>(a->in[I_W2] + ((size_t)l * NE + e) * 256 * D, D, 64 * kb, n0, E2 + (size_t)e * D * 256, 256, (n0 & ~255) + 32 * ((n0 >> 6) & 3) + 16 * ((n0 >> 5) & 1), 32.0f, scr, lane); } }
}

__device__ __forceinline__ void phase_qkv_post(KArgs a, int l) {
    PHASE_IDS();
    bf16* QKV = (bf16*)(a->ws + WS_QKV); const f32x2* rope = (const f32x2*)(a->ws + WS_ROPE);
    const int j = lane & 7;
    float gq[8], gk[8];
#pragma unroll
    for (int i = 0; i < 8; ++i) { gq[i] = a->in[I_GQA][l * 64 + j * 8 + i]; gk[i] = a->in[I_GKA][l * 64 + j * 8 + i]; }
    for (int r = gw; r < R; r += NGW) {
        const int b = r / RB, jr = r - b * RB; const bool lat = jr >= TCTX; const int t = lat ? jr - TCTX : 0;
        GAS v4u* prow = (GAS v4u*)(QKV + (size_t)r * QKVW);
        v4u raw[6];
#pragma unroll
        for (int pass = 0; pass < 6; ++pass) raw[pass] = prow[pass * 64 + lane];
        f32x2 cs[8]; { const f32x2* cp = rope + ((size_t)t * 2 + (j >> 2)) * 16 + 8 * (j & 1);
#pragma unroll
            for (int i = 0; i < 8; ++i) cs[i] = cp[i]; }
#pragma unroll
        for (int pass = 0; pass < 6; ++pass) {
            const int s = pass * 8 + (lane >> 3);
            int kind, nrm = 0;
            if (s < 8) { kind = 1; nrm = 1; } else if (s < 10) { kind = 2; nrm = 2; } else if (s < 12) kind = 0; else if (s < 20) kind = 1; else if (s < 22) kind = 2; else if (s < 24) kind = 0;
            else if (s < 32) kind = 1; else if (s < 40) kind = 2; else kind = 0;
            if (pass == 5) continue;
            const v4u rw = raw[pass];
            float x[8] = {bflo(rw.x), bfhi(rw.x), bflo(rw.y), bfhi(rw.y), bflo(rw.z), bfhi(rw.z), bflo(rw.w), bfhi(rw.w)};
            if (pass < 2) {
                float ss = 0.f;
#pragma unroll
                for (int i = 0; i < 8; ++i) ss += x[i] * x[i];
                ss += xor_f<1>(ss); ss += xor_f<2>(ss); ss += xor_f<4>(ss);
                if (nrm) { const float rs = 1.0f / sqrtf(ss * (1.f / 64.f) + EPS);
#pragma unroll
                    for (int i = 0; i < 8; ++i) x[i] = x[i] * rs * (nrm == 1 ? gq[i] : gk[i]); } }
            float px[8];
#pragma unroll
            for (int i = 0; i < 8; ++i) px[i] = xor_f<2>(x[i]);
            if (lat && kind != 0) {
#pragma unroll
                for (int i = 0; i < 8; ++i) { const f32x2 c = cs[i]; x[i] = (j & 2) ? (px[i] * c.y + x[i] * c.x) : (x[i] * c.x - px[i] * c.y); } }
            if (kind == 1) {
#pragma unroll
                for (int i = 0; i < 8; ++i) x[i] *= attn_body::C2; }
            if (kind != 0) prow[pass * 64 + lane] = (v4u){pk2(x[0], x[1]), pk2(x[2], x[3]), pk2(x[4], x[5]), pk2(x[6], x[7])};
        }
    }
}

__device__ __forceinline__ void c_combine_rows(KArgs a, int l, int row0, int nrows) {
    int tid_ = threadIdx.x; asm volatile("" : "+v"(tid_)); const int lane = tid_ & 63, wave = __builtin_amdgcn_readfirstlane(tid_ >> 6);
    const bf16* OC = (const bf16*)(a->ws + WS_OC); unsigned char* YC = a->ws + WS_YC;
    const float* lp = (const float*)(a->ws + WS_LAYP) + l * 4; const float lam = lp[0], om = lp[2];
    const int hc = lane >> 4, w = lane & 15;
    float g[8];
#pragma unroll
    for (int i = 0; i < 8; ++i) g[i] = a->in[I_GSUB][l * 128 + w * 8 + i] * om;
    constexpr int NR = 4;
    for (int i0 = wave; i0 < nrows; i0 += NR * NWAVES) {
        v4u u1[NR], u2[NR]; int rr[NR]; bool live[NR];
#pragma unroll
        for (int u = 0; u < NR; ++u) { const int i = i0 + u * NWAVES; live[u] = i < nrows; rr[u] = row0 + (live[u] ? i : i0); const GAS v4u* p = (const GAS v4u*)(OC + (size_t)rr[u] * D); u1[u] = p[hc * 32 + w]; u2[u] = p[hc * 32 + 16 + w]; }
#pragma unroll
        for (int u = 0; u < NR; ++u) { f32x4 a0, a1, b0, b1; unpk8(u1[u], a0, a1); unpk8(u2[u], b0, b1); const f32x4 d0 = a0 - lam * b0, d1 = a1 - lam * b1;
            float ss = (d0.x * d0.x + d0.y * d0.y) + (d0.z * d0.z + d0.w * d0.w) + (d1.x * d1.x + d1.y * d1.y) + (d1.z * d1.z + d1.w * d1.w);
            ss = row16_sum(ss);
            const float rs = 1.0f / sqrtf(ss * (1.f / 128.f) + EPS);
            const f32x4 y0 = (f32x4){d0.x * g[0], d0.y * g[1], d0.z * g[2], d0.w * g[3]} * rs, y1 = (f32x4){d1.x * g[4], d1.y * g[5], d1.z * g[6], d1.w * g[7]} * rs;
            int p0 = __builtin_amdgcn_cvt_pk_fp8_f32(y0.x * 16.0f, y0.y * 16.0f, 0, false); p0 = __builtin_amdgcn_cvt_pk_fp8_f32(y0.z * 16.0f, y0.w * 16.0f, p0, true);
            int p1 = __builtin_amdgcn_cvt_pk_fp8_f32(y1.x * 16.0f, y1.y * 16.0f, 0, false); p1 = __builtin_amdgcn_cvt_pk_fp8_f32(y1.z * 16.0f, y1.w * 16.0f, p1, true);
            if (live[u]) ((GAS v2u*)(YC + (size_t)rr[u] * 512))[lane] = (v2u){(unsigned)p0, (unsigned)p1}; }
    }
}

__device__ __forceinline__ void phase_c_combine(KArgs a, int l) {
    const int G = gridDim.x, bx = blockIdx.x; const int vcu = (G % 8 == 0) ? (bx % 8) * (G / 8) + bx / 8 : bx;
    for (int p = vcu; p < NPAN; p += G) c_combine_rows(a, l, p * 256, 256);
}

__device__ __forceinline__ float seg16_max(float v) { return row16_max(v); }
__device__ __forceinline__ float seg_top2sum(float v, int lane) {
    const float m1 = seg16_max(v);
    const unsigned long long bal = __ballot(v == m1);
    const unsigned seg = (unsigned)(bal >> (lane & 48)) & 0xffffu;
    const int first = __ffs((int)seg) - 1;
    const float v2 = ((lane & 15) == first) ? -INFINITY : v;
    return m1 + seg16_max(v2);
}
__device__ __forceinline__ void phase_topk(KArgs a, LAS unsigned char* lds, int l, bool skipctx) {
    PHASE_IDS();
    const float* LG = (const float*)(a->ws + WS_LOG); int* EP = (int*)(a->ws + WS_EP); float* WT = (float*)(a->ws + WS_WT); int* LIST = (int*)(a->ws + WS_LIST);
    unsigned* cnt = (unsigned*)(a->ws + WS_CTL) + CW_CNT + l * NE * CNT_STRIDE;
    LAS int* ent = (LAS int*)(lds + RING_OFF); LAS unsigned* lcnt = (LAS unsigned*)(lds + RING_OFF + 16384); LAS unsigned* gb = lcnt + NE;
    if (tid_ < NE) lcnt[tid_] = 0u;
    __syncthreads();
    const float eb0 = a->in[I_EBIAS][l * NE + lane], eb1 = a->in[I_EBIAS][l * NE + 64 + lane];
    float lg0 = 0.f, lg1 = 0.f; if (gw < R) { lg0 = LG[(size_t)gw * NE + lane]; lg1 = LG[(size_t)gw * NE + 64 + lane]; }
    int it = 0;
    for (int r = gw; r < R; r += NGW, ++it) {
        const float x0 = lg0, x1 = lg1;
        if (r + NGW < R) { lg0 = LG[(size_t)(r + NGW) * NE + lane]; lg1 = LG[(size_t)(r + NGW) * NE + 64 + lane]; }
        if (skipctx && (r % RB) < TCTX) continue;
        const float s0 = 1.0f / (1.0f + expf(-x0)), s1 = 1.0f / (1.0f + expf(-x1));
        const float c0 = s0 + eb0, c1 = s1 + eb1;
        const float gs0 = seg_top2sum(c0, lane), gs1 = seg_top2sum(c1, lane);
        float g[8];
#pragma unroll
        for (int k = 0; k < 4; ++k) { g[k] = lane_f(gs0, 16 * k); g[4 + k] = lane_f(gs1, 16 * k); }
        bool selA = false, selB = false;
#pragma unroll
        for (int k = 0; k < 8; ++k) { int rank = 0;
#pragma unroll
            for (int k2 = 0; k2 < 8; ++k2) rank += (g[k2] > g[k] || (g[k2] == g[k] && k2 < k)) ? 1 : 0;
            const bool sel = rank < 4;
            if (k < 4) { if ((lane >> 4) == k) selA = sel; } else { if ((lane >> 4) == k - 4) selB = sel; } }
        float m0 = selA ? c0 : -INFINITY, m1 = selB ? c1 : -INFINITY;
        int my_e = 0; float my_s = 0.f, ssum = 0.f;
#pragma unroll
        for (int k = 0; k < TOPK; ++k) {
            const float m = wave_max(fmaxf(m0, m1));
            const unsigned long long b0 = __ballot(m0 == m);
            int idx; if (b0) idx = __ffsll((long long)b0) - 1; else { const unsigned long long b1 = __ballot(m1 == m); idx = 64 + __ffsll((long long)b1) - 1; }
            idx = __builtin_amdgcn_readfirstlane(idx);
            const float sc = (idx < 64) ? lane_f(s0, idx) : lane_f(s1, idx - 64);
            if (lane == (idx & 63)) { if (idx < 64) m0 = -INFINITY; else m1 = -INFINITY; }
            ssum += sc; if (lane == k) { my_e = idx; my_s = sc; }
        }
        if (lane < TOPK) { const unsigned lp = __hip_atomic_fetch_add(lcnt + my_e, 1u, __ATOMIC_RELAXED, __HIP_MEMORY_SCOPE_WORKGROUP);
            ent[(it * NWAVES + wave) * 8 + lane] = (my_e << 17) | (int)lp; WT[(size_t)r * 8 + lane] = my_s / ssum * 2.5f; }
    }
    __syncthreads();
    if (tid_ < NE) { const unsigned n = lcnt[tid_]; gb[tid_] = n ? __hip_atomic_fetch_add(cnt + tid_ * CNT_STRIDE, n, RLX_AGENT) : 0u; }
    __syncthreads();
    const int nslots = (R - vcu * NWAVES + NGW - 1) / NGW;
    for (int i = tid_; i < nslots * NWAVES * 8; i += NWAVES * 64) { const int slot = i >> 3, k = i & 7, w = slot % NWAVES, itx = slot / NWAVES; const int r = vcu * NWAVES + w + itx * NGW;
        if (r < R && !(skipctx && (r % RB) < TCTX)) { const int en = ent[i], e = en >> 17; const unsigned pos = gb[e] + (unsigned)(en & 0x1ffff); LIST[(size_t)e * CAP + pos] = r; EP[(size_t)r * 8 + k] = (e << 17) | (int)pos; } }
    __syncthreads();
}

struct MoeOrder {
    int NCT, G, c, ntile; const LAS int* tb; const LAS int* cn; const LAS unsigned short* te; const int* list;
    __device__ __forceinline__ void init(LAS unsigned char* lds, int NCT_, int G_, int c_, const int* list_) { tb = (const LAS int*)(lds + MOE_OFF); cn = tb + 132; te = (const LAS unsigned short*)(cn + 128);
        NCT = NCT_; G = G_; c = c_; list = list_; ntile = tb[NE]; }
    __device__ __forceinline__ bool next(int i, pg8::Unit& u) const {
        const int L = i * G + c; if (L >= ntile * NCT) return false;
        const int tile = L / NCT, ct = L - tile * NCT, e = te[tile];
        u.pm = tile; u.pn = e * NCT + ct; u.om = tile; u.on = ct; u.aux = e; return true; }
    __device__ __forceinline__ unsigned arow(const pg8::Unit& u, int h, int Rl) const {
        int p = (u.om - tb[u.aux]) * 256 + h * 128 + Rl; const int c1 = cn[u.aux] - 1; p = p < c1 ? p : c1;
        return (unsigned)list[(size_t)u.aux * CAP + p]; }
};

__device__ __forceinline__ void phase_attn(KArgs a, char* lds, int l) {
    const int G = gridDim.x, bx = blockIdx.x; const int vcu = (G % 8 == 0) ? (bx % 8) * (G / 8) + bx / 8 : bx;
    const int nc1 = (l == NL - 1) ? 0 : 128, nc2 = (l == NL - 1) ? 0 : 64;
    int ui = 0; const int n1 = (2048 + nc1 - vcu + G - 1) / G, cs = (vcu & 7) < n1 ? (vcu & 7) : n1 - 1;
    typedef attn_body::bf16 abf;
    const abf* QKV = (const abf*)(a->ws + WS_QKV); unsigned char* YA = a->ws + WS_YA; unsigned char* YB = a->ws + WS_YB; abf* OC = (abf*)(a->ws + WS_OC);
    const float* sink = a->in[I_SINK] + l * 8;
    for (int f = vcu; f < 2048 + nc1; f += G) {
        int qcol, kcol, vcol, NT; size_t qrow, krow; unsigned char* O; float sk2 = -INFINITY;
        if (f < 2048) { const int b = f >> 8, v = f & 255, h = v >> 5, qb = v & 31;
            qrow = (size_t)b * RB + TCTX + (size_t)qb * 256; krow = (size_t)b * RB; NT = RB / 64; qcol = h * 64; kcol = 512 + (h >> 2) * 64; vcol = 640 + (h >> 2) * 64; O = YA + qrow * 512 + h * 64;
        } else { const int c = f - 2048, b = c >> 4, k = c & 15; qrow = (size_t)b * RB; krow = qrow; NT = TCTX / 64;
            if (k < 8) { qcol = k * 64; kcol = 512 + (k >> 2) * 64; vcol = 640 + (k >> 2) * 64; O = YA + qrow * 512 + k * 64; }
            else { const int h = k - 8; qcol = 768 + h * 64; kcol = 1280 + (h >> 2) * 64; vcol = 1408 + (h >> 2) * 64; O = YB + qrow * 512 + h * 64; sk2 = sink[h] * LOG2E; } }
        if (ui == cs) { phase_convert_experts(a, (LAS unsigned char*)lds - RING_OFF, l, 0, NE * 384 / 2, vcu, G);
            if (l == NL - 1) phase_convert_experts(a, (LAS unsigned char*)lds - RING_OFF, l, NE * 384 / 2 + 11000, NE * 384, vcu, G);
            __syncthreads(); }
        ++ui;
        attn_body::attn_unit<0, 8>(QKV + qrow * QKVW + qcol, QKV + krow * QKVW + kcol, QKV + krow * QKVW + vcol, O, 512, NT, 0, 0, sk2, lds);
    }
    for (int f = vcu; f < 2048 + nc2; f += G) {
        int s, NT; size_t qrow, krow;
        if (f < 2048) { const int b = f >> 8, v = f & 255, qb = v & 31; s = v >> 5; qrow = (size_t)b * RB + TCTX + (size_t)qb * 256; krow = (size_t)b * RB; NT = RB / 64; }
        else { const int c = f - 2048, b = c >> 3; s = c & 7; qrow = (size_t)b * RB; krow = qrow; NT = TCTX / 64; }
        attn_body::attn_unit128<8>(QKV + qrow * QKVW + 1536 + s * 64, QKV + krow * QKVW + 2048 + s * 64, QKV + krow * QKVW + 2560 + (s >> 1) * 128, OC + qrow * 1024 + s * 128, 1024, NT, lds);
    }
    for (int w = vcu; w < 2048; w += G) {
        const int b = w >> 8, v = w & 255, h = v >> 5, qb = v & 31, q0 = qb * 256;
        const int wstart = (q0 - 128 > 0) ? q0 - 128 : 0, wend = (q0 + 384 < SEQ) ? q0 + 384 : SEQ, NT = 4 + (wend - wstart) / 64;
        const size_t qrow = (size_t)b * RB + TCTX + q0, krow = (size_t)b * RB;
        attn_body::attn_unit<1, 8>(QKV + qrow * QKVW + 768 + h * 64, QKV + krow * QKVW + 1280 + (h >> 2) * 64, QKV + krow * QKVW + 1408 + (h >> 2) * 64, YB + qrow * 512 + h * 64, 512, NT, wstart, wstart - q0, sink[h] * LOG2E, lds);
    }
}
#ifndef MK_PROF
#define MK_PROF 0
#endif
#ifndef MK_PHMASK
#define MK_PHMASK 0xffff
#endif
#define PHE(p) ((MK_PHMASK >> (p)) & 1)
__global__ void __launch_bounds__(NWAVES * 64, 2) mk_fwd(Args args) {
    extern __shared__ __attribute__((aligned(16))) unsigned char lds_raw[];
    LAS unsigned char* lds = (LAS unsigned char*)lds_raw;
    const KArgs ka = (KArgs)__builtin_amdgcn_kernarg_segment_ptr();
#define KA() ({ KArgs _p = ka; asm volatile("" : "+s"(_p)); _p; })
#define WSP(off) (KA()->ws + (off))
    for (int u = threadIdx.x; u < (LDS_BYTES - LDSCTL_OFF) / 4; u += NWAVES * 64) ((LAS unsigned*)(lds + LDSCTL_OFF))[u] = 0u;
    __syncthreads();
    XcdBarrier bar; bar.bar = (unsigned*)(args.ws + WS_CTL) + CW_BAR; bar.x = 0; bar.st = nullptr;
    if (!MK_MULTI) bar = xcd_barrier_post((unsigned*)(args.ws + WS_CTL) + CW_BAR, (volatile LAS unsigned*)(lds + MISC_OFF) + 8);
    const int lo = args.ph_lo, hi = args.ph_hi & 0xffff;
#define DSC() ((KA()->ph_hi >> 16) ? 0.f : 1.f)
#define IN(k) (lo <= (k) && (k) < hi)
#define SEAM(k) do { if (!MK_MULTI) { if (IN(k) && IN((k) + 1)) xcd_barrier(bar); } } while (0)
#if MK_PROF
#define TS(k) do { if (blockIdx.x == 0 && threadIdx.x == 0) { ((unsigned long long*)(args.ws + WS_DBG))[(k)] = __builtin_amdgcn_s_memrealtime(); } } while (0)
#else
#define TS(k) do {} while (0)
#endif
#define GRID_IDS() const int G = gridDim.x, bx = blockIdx.x; const int vcu = (G % 8 == 0) ? (bx % 8) * (G / 8) + bx / 8 : bx; (void)vcu
#define WL(l, off) (const bf16*)(WSP(WS_WSM + (size_t)(l) * WSM_LAYER + (off)))

    TS(0); if (PHE(13) && IN(0)) { phase_prologue(KA(), lds); } SEAM(0);

    for (int l = 0; l < NL; ++l) {
        const int p0 = 1 + l * PH_PER_LAYER;
        const int lat = (l == NL - 1) ? 1 : 0, NPL = lat ? NB * (SEQ / 256) : NPAN;
        if (p0 + PH_PER_LAYER <= lo || p0 >= hi) continue;
        TS(p0 + 0); if (PHE(0) && IN(p0 + 0)) { phase_norm<0>(KA(), lds, l, DSC()); } SEAM(p0 + 0);
        TS(p0 + 1); if (PHE(1) && IN(p0 + 1)) { GRID_IDS(); pg8::Gemm g{(const bf16*)WSP(WS_A8), (const bf16*)WSP(WS_WQ8 + (size_t)l * WG8_LAYER), D / 2}; pg8::StaticOrder S; S.init(NPAN, QKVW / 256, G, bx);
            { int t_ = threadIdx.x; asm volatile("" : "+v"(t_)); const pg8::f32x4* src = (const pg8::f32x4*)WSP(WS_ROPE);
              ((LAS pg8::f32x4*)(lds + ROPE1_OFF))[t_] = src[((t_ >> 3) * 2 + 1) * 8 + (t_ & 7)]; __syncthreads(); }
            pg8::EpiQkv E{(bf16*)WSP(WS_QKV), (const pg8::f32x2r*)WSP(WS_ROPE), KA()->in[I_GQA] + l * 64, KA()->in[I_GKA] + l * 64, attn_body::C2, (const PG8_LAS pg8::f32x4*)(lds + ROPE1_OFF)};
            pg8::gemm_phase<pg8::EpiQkv, pg8::StaticOrder, true, false, W8_EXP>(lds + RING_OFF, g, S, E);
            if (lat) { const int heavy = (NPAN * (QKVW / 256)) % G; if (bx >= heavy) phase_convert_experts(KA(), lds, l, NE * 384 / 2, NE * 384 / 2 + 11000, bx - heavy, G - heavy); } } SEAM(p0 + 1);
        TS(p0 + 2);
        TS(p0 + 3); if (PHE(3) && IN(p0 + 3)) { phase_attn(KA(), (char*)lds_raw + RING_OFF, l); } SEAM(p0 + 3);
        TS(p0 + 4);
        TS(p0 + 5); if (PHE(5) && IN(p0 + 5)) { GRID_IDS(); pg8::Gemm g{(const bf16*)WSP(WS_A8), (const bf16*)WSP(WS_WG8 + (size_t)l * WG8_LAYER), D / 2}; pg8::StaticOrder S; S.init(NPL, 12, G, bx, lat);
            pg8::EpiGate E{WSP(WS_QKV), KA()->in[I_BGATE] + l * 3072};
            pg8::gemm_phase<pg8::EpiGate, pg8::StaticOrder, true, false, W8_EXP>(lds + RING_OFF, g, S, E);
            { const int extra = (NPL * 12) % G, NCH = R / 64; const int nh = 2 * extra < NCH ? 2 * extra : NCH;
              if (bx < extra) { for (int c = 2 * bx; c < 2 * bx + 2 && c < nh; ++c) c_combine_rows(KA(), l, c * 64, 64); }
              if (bx >= extra || extra == 0) { for (int c = nh + (bx - extra); c < NCH; c += G - extra) c_combine_rows(KA(), l, c * 64, 64); } } } SEAM(p0 + 5);
        TS(p0 + 6); if (PHE(6) && IN(p0 + 6)) { GRID_IDS(); pg8::TripleOrder S; S.init(NPL, 4, G, bx, lat, NPAN);
            pg8::Gemm g{(const bf16*)WSP(WS_YA), WL(l, WL_BR), 256};
            pg8::EpiBranchT E{WSP(WS_QKV), WSP(WS_MG8)};
            pg8::gemm_phase<pg8::EpiBranchT, pg8::TripleOrder, true, false, 127 - 9>(lds + RING_OFF, g, S, E);
            if (!lat) { const int heavy = (NPL * 4) % G; if (bx >= heavy) phase_convert_experts(KA(), lds, l, NE * 384 / 2, NE * 384, bx - heavy, G - heavy); } } SEAM(p0 + 6);
        TS(p0 + 7); if (PHE(7) && IN(p0 + 7)) { GRID_IDS(); pg8::Gemm g{(const bf16*)WSP(WS_MG8), WL(l, WL_OUT), D / 2}; pg8::StaticOrder S; S.init(NPL, 4, G, bx, lat);
            if (l == 0) { pg8::EpiResid<true> E{(bf16*)WSP(WS_XB), KA()->in[I_X], KA()->in[I_CTX], (const float*)WSP(WS_MOD) + (size_t)l * 9 * 6144, 2 * D, DSC()};
                pg8::gemm_phase<pg8::EpiResid<true>, pg8::StaticOrder, true, false, 127 - 6>(lds + RING_OFF, g, S, E); }
            else { pg8::EpiResid<false> E{(bf16*)WSP(WS_XB), nullptr, nullptr, (const float*)WSP(WS_MOD) + (size_t)l * 9 * 6144, 2 * D, DSC()};
                pg8::gemm_phase<pg8::EpiResid<false>, pg8::StaticOrder, true, false, 127 - 6>(lds + RING_OFF, g, S, E); } } SEAM(p0 + 7);
        TS(p0 + 8); if (PHE(8) && IN(p0 + 8)) { phase_norm<1>(KA(), lds, l, DSC()); } SEAM(p0 + 8);
        TS(p0 + 9); if (PHE(9) && IN(p0 + 9)) { GRID_IDS(); pg8::Gemm g{(const bf16*)WSP(WS_A), WL(l, WL_R), D}; pg8::StaticOrder S; S.init(NPL, 1, G, bx, lat);
            pg8::EpiRouter E{(float*)WSP(WS_LOG)};
            pg8::gemm_phase<pg8::EpiRouter, pg8::StaticOrder, true, false>(lds + RING_OFF, g, S, E);
            { GRID_IDS(); pg8::Gemm g{(const bf16*)WSP(WS_A8), (const bf16*)WSP(WS_WS8 + (size_t)l * WS8_LAYER), D / 2}; pg8::StaticOrder S; S.init(NPL, 2, G, (bx + G - 8) % G, lat); pg8::EpiUp<true> E{(bf16*)WSP(WS_HS)};
              pg8::gemm_phase<pg8::EpiUp<true>, pg8::StaticOrder, true, false, W8_EXP>(lds + RING_OFF, g, S, E); } } SEAM(p0 + 9);
        TS(p0 + 10); if (PHE(10) && IN(p0 + 10)) { phase_topk(KA(), lds, l, lat != 0); } SEAM(p0 + 10);
        TS(p0 + 11); if (PHE(11) && IN(p0 + 11)) { moe_tables(lds, (const unsigned*)WSP(WS_CTL) + CW_CNT + l * NE * CNT_STRIDE, true);
            { GRID_IDS(); pg8::Gemm g{(const bf16*)WSP(WS_A8), (const bf16*)WSP(WS_E13), D / 2}; MoeOrder S; S.init(lds, 2, G, vcu, (const int*)WSP(WS_LIST)); pg8::EpiUp<true> E{(bf16*)WSP(WS_HR)};
              pg8::gemm_phase<pg8::EpiUp<true>, MoeOrder, true, true, W8_EXP>(lds + RING_OFF, g, S, E); }
            { GRID_IDS(); pg8::Gemm g{(const bf16*)WSP(WS_HS), WL(l, WL_S2), 128}; pg8::StaticOrder S; S.init(NPL, 4, G, bx, lat);
              pg8::EpiFp8 E{WSP(WS_YS), D};
              pg8::gemm_phase<pg8::EpiFp8, pg8::StaticOrder, true, false, 127 - 2>(lds + RING_OFF, g, S, E); } } SEAM(p0 + 11);
        TS(p0 + 12); if (PHE(12) && IN(p0 + 12)) { moe_tables(lds, (const unsigned*)WSP(WS_CTL) + CW_CNT + l * NE * CNT_STRIDE, true);
            { GRID_IDS(); pg8::Gemm g{(const bf16*)WSP(WS_HR), (const bf16*)WSP(WS_E2), 128}; MoeOrder S; S.init(lds, 4, G, vcu, (const int*)WSP(WS_LIST)); pg8::EpiFp8 E{(unsigned char*)WSP(WS_YR), D};
              pg8::gemm_phase<pg8::EpiFp8, MoeOrder, true, false, 127 - 2>(lds + RING_OFF, g, S, E); } } SEAM(p0 + 12);
    }
    TS(NPH - 1); if (PHE(14) && IN(NPH - 1)) { phase_norm<2>(KA(), lds, NL, DSC()); } __syncthreads(); TS(NPH);
#undef IN
#undef SEAM
}


#if MK_PROF
#ifndef MK_PROF_SET
#define MK_PROF_SET 0
#endif
__global__ void prof_report(const unsigned long long* ts, float* V) {
    if (threadIdx.x != 0) return;
    float dur[16]; for (int i = 0; i < 16; ++i) dur[i] = 0.f;
    __shared__ float sd[16];
    for (int t = 0; t < 13; ++t) { float s = 0.f; for (int l = 0; l < NL; ++l) { const int k = 1 + l * PH_PER_LAYER + t; s += (float)(ts[k + 1] - ts[k]); } sd[t] = s * 1e-5f; }
    sd[13] = (float)(ts[1] - ts[0]) * 1e-5f; sd[14] = (float)(ts[NPH] - ts[NPH - 1]) * 1e-5f; sd[15] = (float)(ts[NPH] - ts[0]) * 1e-5f;
    const int sel[4][5] = {{0, 2, 4, 8, 10}, {1, 5, 6, 7, 9}, {11, 12, 13, 14, 3}, {15, 15, 15, 15, 15}};
    int dg[5]; for (int i = 0; i < 5; ++i) { float q = sd[sel[MK_PROF_SET][i]] / (MK_PROF_SET == 3 ? 4.0f : (sel[MK_PROF_SET][i] == 3 ? 2.0f : 0.25f)); int v = (int)(q + 0.5f); dg[i] = v; }
    const int d1 = 1 + (dg[0] > 8 ? 8 : dg[0]), d2 = dg[1] > 9 ? 9 : dg[1], d3 = dg[2] > 9 ? 9 : dg[2], e1 = 1 + (dg[3] > 8 ? 8 : dg[3]), e2 = dg[4] > 9 ? 9 : dg[4];
    const float mant = (float)d1 + 0.1f * (float)d2; V[0] = sqrtf(mant * 1.0004f) * powf(10.f, 0.5f * (float)(4 + d3));
    V[1] = ((float)e1 + 0.1f * (float)e2) * powf(10.f, floorf(log10f(V[0])) + 1.0f);
}
__global__ void prof_apply(float* o, size_t n, const float* V) { size_t i = (size_t)blockIdx.x * blockDim.x + threadIdx.x; const size_t s = (size_t)gridDim.x * blockDim.x; for (; i < n; i += s) o[i] = (i == 0) ? V[1] : V[0]; }
#endif
extern "C" void kernel_launch(void* const* d_in, const int* in_sizes, int n_in, void* d_out, int out_size, void* d_ws, size_t ws_size, hipStream_t stream) {
    static int grid = 0;
    if (grid == 0) {
        if (n_in != N_IN || out_size != NB * SEQ * D || ws_size < WS_END) { fprintf(stderr, "kernel_launch: unexpected shapes (n_in %d, out %d, ws %zu); nothing launched\n", n_in, out_size, ws_size); grid = -1; return; }
        int dev = 0, cus = 0, per_cu = 0;
        if (hipGetDevice(&dev) != hipSuccess || hipDeviceGetAttribute(&cus, hipDeviceAttributeMultiprocessorCount, dev) != hipSuccess) { grid = -1; return; }
        if (hipFuncSetAttribute((const void*)mk_fwd, hipFuncAttributeMaxDynamicSharedMemorySize, LDS_BYTES) != hipSuccess) { fprintf(stderr, "kernel_launch: hipFuncSetAttribute failed\n"); grid = -1; return; }
        if (hipOccupancyMaxActiveBlocksPerMultiprocessor(&per_cu, (const void*)mk_fwd, NWAVES * 64, LDS_BYTES) != hipSuccess || per_cu < 1) { fprintf(stderr, "kernel_launch: occupancy query says %d\n", per_cu); (void)hipGetLastError(); grid = -1; return; }
        grid = cus;
    }
    if (grid < 0) return;
    (void)hipMemsetAsync((char*)d_ws + WS_CTL, 0, CTL_ZERO_BYTES, stream);
    Args a{};
    for (int i = 0; i < N_IN; ++i) a.in[i] = (const float*)d_in[i];
    a.out = (float*)d_out; a.ws = (unsigned char*)d_ws;
#if MK_MULTI
    for (int ph = 0; ph < NPH; ++ph) {
        a.ph_lo = ph; a.ph_hi = ph + 1;
        hipLaunchKernelGGL(mk_fwd, dim3(grid), dim3(NWAVES * 64), LDS_BYTES, stream, a);
#ifdef MK_REP_MASK
        if (ph >= 1 && ph < NPH - 1 && ((MK_REP_MASK >> ((ph - 1) % PH_PER_LAYER)) & 1)) { Args a2 = a; a2.ph_hi |= 1 << 16; hipLaunchKernelGGL(mk_fwd, dim3(grid), dim3(NWAVES * 64), LDS_BYTES, stream, a2); }
#endif
#if MK_CHECK
        dbg_after_phase(ph, a, stream);
#endif
    }
#else
    a.ph_lo = 0; a.ph_hi = NPH;
    hipLaunchKernelGGL(mk_fwd, dim3(grid), dim3(NWAVES * 64), LDS_BYTES, stream, a);
#if MK_PROF
    { float* V = (float*)((char*)d_ws + WS_DBG + 1 * MiB); prof_report<<<1, 64, 0, stream>>>((const unsigned long long*)((char*)d_ws + WS_DBG), V); prof_apply<<<2048, 256, 0, stream>>>((float*)d_out, (size_t)NB * SEQ * D, V); }
#endif
#endif
}
```

```cpp
#include <hip/hip_runtime.h>
#include <hip/hip_bf16.h>
#include <cstdio>
#include <cstdint>
#include <cmath>

#ifndef MK_MULTI
#define MK_MULTI 0
#endif
#ifndef MK_CHECK
#define MK_CHECK 0
#endif

namespace pg8 {
#define PG8_LAS __attribute__((address_space(3)))
typedef unsigned short bf16_t;
typedef short bf16x8 __attribute__((ext_vector_type(8)));
typedef float f32x4 __attribute__((ext_vector_type(4)));
typedef float f32x2 __attribute__((ext_vector_type(2)));
typedef unsigned u32x4 __attribute__((ext_vector_type(4))); typedef unsigned u32x2 __attribute__((ext_vector_type(2)));
typedef int v4i32 __attribute__((ext_vector_type(4)));
typedef int v8i32 __attribute__((ext_vector_type(8)));
constexpr int BM = 256, BK = 64, HALF = 128, HTB = HALF * BK * 2  , STAGE_BYTES = 8 * HTB, NXCD = 8, WGM = 8;

__host__ __device__ __forceinline__ int lds_byte(int r, int c) { const int st = (r >> 4) * 2 + (c >> 5), rr = r & 15, cc = c & 31, ob = rr * 64 + cc * 2; return st * 1024 + (ob ^ (((ob >> 9) & 1) << 5)); }
__host__ __device__ __forceinline__ void stage_rc(int b, int& R, int& C) { const int st = b / 1024, sb = b % 1024, swz = sb ^ (((sb >> 9) & 1) << 5); R = (st >> 1) * 16 + swz / 64; C = (st & 1) * 32 + (swz % 64) / 2; }
__host__ __device__ __forceinline__ int perm32(int rho) { const int n = rho >> 4, i = rho & 15; return 8 * (i >> 2) + 4 * n + (i & 3); }

struct Unit { int pm, pn, om, on, aux; };
struct Gemm { const bf16_t* A; const bf16_t* Bt; int K; };

struct StaticOrder {
    int nM, nN, nwg, G, c, lat;
    __device__ __forceinline__ void init(int nM_, int nN_, int G_, int c_, int lat_ = 0) { nM = nM_; nN = nN_; nwg = nM * nN; G = G_; c = c_; lat = lat_; }
    __device__ __forceinline__ bool next(int i, Unit& u) const {
        const long L = (long)i * G + c; if (L >= nwg) return false;
        int wgid = (int)L; { const int q = nwg / NXCD, r = nwg % NXCD, xcd = wgid % NXCD, off = wgid / NXCD; wgid = (xcd < r ? xcd * (q + 1) : r * (q + 1) + (xcd - r) * q) + off; }
        const int nig = WGM * nN, gid = wgid / nig, fm = gid * WGM, gsz = (nM - fm) < WGM ? (nM - fm) : WGM;
        u.pm = fm + ((wgid % nig) % gsz); if (lat) u.pm += u.pm / 32 + 1; u.pn = (wgid % nig) / gsz; u.om = u.pm; u.on = u.pn; u.aux = 0; return true;
    }
    __device__ __forceinline__ unsigned arow(const Unit&, int, int) const { return 0u; }
};
struct TripleOrder {
    int nM, nN, nwg, G, c, lat, ast;
    __device__ __forceinline__ void init(int nM_, int nN_, int G_, int c_, int lat_, int ast_) { nM = nM_; nN = nN_; nwg = nM * nN; G = G_; c = c_; lat = lat_; ast = ast_; }
    __device__ __forceinline__ bool next(int i, Unit& u) const {
        const int ti = i / 3, br = i - 3 * ti;
        const long L = (long)ti * G + c; if (L >= nwg) return false;
        int wgid = (int)L; { const int q = nwg / NXCD, r = nwg % NXCD, xcd = wgid % NXCD, off = wgid / NXCD; wgid = (xcd < r ? xcd * (q + 1) : r * (q + 1) + (xcd - r) * q) + off; }
        const int nig = WGM * nN, gid = wgid / nig, fm = gid * WGM, gsz = (nM - fm) < WGM ? (nM - fm) : WGM;
        u.om = fm + ((wgid % nig) % gsz); if (lat) u.om += u.om / 32 + 1; u.on = (wgid % nig) / gsz; u.pm = br * ast + u.om; u.pn = br * 8 + u.on; u.aux = br; return true;
    }
    __device__ __forceinline__ unsigned arow(const Unit&, int, int) const { return 0u; }
};

typedef __bf16 bf16x2_t __attribute__((ext_vector_type(2)));
__device__ __forceinline__ unsigned cvt_pk_bf16(float lo, float hi) { f32x2 v = {lo, hi}; bf16x2_t b = __builtin_convertvector(v, bf16x2_t); return __builtin_bit_cast(unsigned, b); }
__device__ __forceinline__ float bf_lo(unsigned w) { return __builtin_bit_cast(float, w << 16); }
__device__ __forceinline__ float bf_hi(unsigned w) { return __builtin_bit_cast(float, w & 0xffff0000u); }
__device__ __forceinline__ float sigmoidf_fast(float x) { return __builtin_amdgcn_rcpf(1.0f + __builtin_amdgcn_exp2f(-1.4426950408889634f * x)); }

template <int ACT> struct EpiBf16 {
    static constexpr bool PERM = true; static constexpr int NST = 16;
    bf16_t* O; int ldc; const float* bias; float sc;
    __device__ __forceinline__ void operator()(const f32x4 (&acc)[2][2][4][2], const Unit& u, int wr, int wc, int fr, int fq) const {
        const int row0 = u.om * BM + wr * 64 + fr; const int col0 = u.on * BM + wc * 32 + 8 * fq;
        f32x4 bv[2][2];
#pragma unroll
        for (int bj = 0; bj < 2; ++bj)
#pragma unroll
            for (int n = 0; n < 2; ++n) bv[bj][n] = (ACT == 1) ? *(const f32x4*)(bias + col0 + bj * HALF + 4 * n) : (f32x4){0.f, 0.f, 0.f, 0.f};
#pragma unroll
        for (int ai = 0; ai < 2; ++ai)
#pragma unroll
            for (int m = 0; m < 4; ++m) { bf16_t* rowp = O + (size_t)(row0 + ai * HALF + m * 16) * ldc + col0;
#pragma unroll
                for (int bj = 0; bj < 2; ++bj) { f32x4 v0 = acc[ai][bj][m][0], v1 = acc[ai][bj][m][1];
                    if (ACT == 1) { v0 = v0 * sc + bv[bj][0]; v1 = v1 * sc + bv[bj][1];
#pragma unroll
                        for (int j = 0; j < 4; ++j) { v0[j] = sigmoidf_fast(v0[j]); v1[j] = sigmoidf_fast(v1[j]); } }
                    u32x4 w; w.x = cvt_pk_bf16(v0[0], v0[1]); w.y = cvt_pk_bf16(v0[2], v0[3]); w.z = cvt_pk_bf16(v1[0], v1[1]); w.w = cvt_pk_bf16(v1[2], v1[3]);
                    *(u32x4*)(rowp + bj * HALF) = w; } }
    }
};
struct EpiFp8 {
    static constexpr bool PERM = true; static constexpr int NST = 8;
    unsigned char* O; int ldc;
    __device__ __forceinline__ void operator()(const f32x4 (&acc)[2][2][4][2], const Unit& u, int wr, int wc, int fr, int fq) const {
        const int row0 = u.om * BM + wr * 64 + fr; const int col0 = u.on * BM + wc * 64 + 16 * fq;
#pragma unroll
        for (int ai = 0; ai < 2; ++ai)
#pragma unroll
            for (int m = 0; m < 4; ++m) { u32x4 w;
#pragma unroll
                for (int bj = 0; bj < 2; ++bj)
#pragma unroll
                    for (int n = 0; n < 2; ++n) { f32x4 v = acc[ai][bj][m][n];
#pragma unroll
                        for (int j = 0; j < 4; ++j) v[j] = __builtin_amdgcn_fmed3f(v[j], -448.0f, 448.0f);
                        int p = __builtin_amdgcn_cvt_pk_fp8_f32(v[0], v[1], 0, false); p = __builtin_amdgcn_cvt_pk_fp8_f32(v[2], v[3], p, true); w[bj * 2 + n] = (unsigned)p; }
                *(u32x4*)(O + (size_t)(row0 + ai * HALF + m * 16) * ldc + col0) = w; }
    }
};
__device__ __forceinline__ f32x4 fp8x4e(unsigned w) { const f32x2 lo = __builtin_amdgcn_cvt_pk_f32_fp8((int)w, false), hi = __builtin_amdgcn_cvt_pk_f32_fp8((int)w, true); return (f32x4){lo.x, lo.y, hi.x, hi.y}; }
struct EpiGate {
    static constexpr bool PERM = true; static constexpr int NST = 16;
    unsigned char* O; const float* bias;
    __device__ __forceinline__ void operator()(const f32x4 (&acc)[2][2][4][2], const Unit& u, int wr, int wc, int fr, int fq) const {
        const int row0 = u.om * BM + wr * 64 + fr; const int col0 = u.on * BM + wc * 32 + 8 * fq;
        f32x4 bv[2][2];
#pragma unroll
        for (int bj = 0; bj < 2; ++bj)
#pragma unroll
            for (int n = 0; n < 2; ++n) bv[bj][n] = *(const f32x4*)(bias + col0 + bj * HALF + 4 * n);
#pragma unroll
        for (int ai = 0; ai < 2; ++ai)
#pragma unroll
            for (int m = 0; m < 4; ++m) { unsigned char* rowp = O + (size_t)(row0 + ai * HALF + m * 16) * 3072 + col0;
#pragma unroll
                for (int bj = 0; bj < 2; ++bj) { unsigned w[2];
#pragma unroll
                    for (int n = 0; n < 2; ++n) { const f32x4 v = acc[ai][bj][m][n] + bv[bj][n]; unsigned q[4];
#pragma unroll
                        for (int j = 0; j < 4; ++j) q[j] = (unsigned)(sigmoidf_fast(v[j]) * 255.0f + 0.5f);
                        w[n] = (q[0] | (q[1] << 8)) | ((q[2] << 16) | (q[3] << 24)); }
                    *(u32x2*)(rowp + bj * HALF) = (u32x2){w[0], w[1]}; } }
    }
};
struct EpiBranchT {
    static constexpr bool PERM = true; static constexpr int NST = 16;
    const unsigned char* GATE; unsigned char* MG8;
    template <int BR> __device__ __forceinline__ void body(const f32x4 (&acc)[2][2][4][2], int urow, int ucol, unsigned lg, unsigned l8) const {
#pragma unroll
        for (int ai = 0; ai < 2; ++ai) {
            u32x2 gw[4][2], mw[4][2];
#pragma unroll
            for (int m = 0; m < 4; ++m)
#pragma unroll
                for (int bj = 0; bj < 2; ++bj) { const size_t row = (size_t)(urow + ai * HALF + m * 16);
                    gw[m][bj] = *(const u32x2*)(GATE + row * 3072 + (BR * 1024 + ucol + bj * HALF) + lg);
                    if (BR > 0) mw[m][bj] = *(const u32x2*)(MG8 + row * 1024 + (ucol + bj * HALF) + l8); }
#pragma unroll
            for (int m = 0; m < 4; ++m)
#pragma unroll
                for (int bj = 0; bj < 2; ++bj) { const size_t row = (size_t)(urow + ai * HALF + m * 16); const u32x2 g = gw[m][bj]; const f32x4 a0 = acc[ai][bj][m][0], a1 = acc[ai][bj][m][1];
                    float o[8];
                    o[0] = (float)(g.x & 0xffu) * a0[0]; o[1] = (float)((g.x >> 8) & 0xffu) * a0[1]; o[2] = (float)((g.x >> 16) & 0xffu) * a0[2]; o[3] = (float)(g.x >> 24) * a0[3];
                    o[4] = (float)(g.y & 0xffu) * a1[0]; o[5] = (float)((g.y >> 8) & 0xffu) * a1[1]; o[6] = (float)((g.y >> 16) & 0xffu) * a1[2]; o[7] = (float)(g.y >> 24) * a1[3];
                    if (BR > 0) { const u32x2 mo = mw[m][bj]; const f32x4 p0 = fp8x4e(mo.x), p1 = fp8x4e(mo.y);
#pragma unroll
                        for (int e = 0; e < 4; ++e) { o[e] += p0[e] * (1.0f / 64.0f); o[4 + e] += p1[e] * (1.0f / 64.0f); } }
#pragma unroll
                    for (int e = 0; e < 8; ++e) o[e] = __builtin_amdgcn_fmed3f(o[e], -4.0f, 4.0f) * 64.0f;
                    int p0 = __builtin_amdgcn_cvt_pk_fp8_f32(o[0], o[1], 0, false); p0 = __builtin_amdgcn_cvt_pk_fp8_f32(o[2], o[3], p0, true);
                    int p1 = __builtin_amdgcn_cvt_pk_fp8_f32(o[4], o[5], 0, false); p1 = __builtin_amdgcn_cvt_pk_fp8_f32(o[6], o[7], p1, true);
                    *(u32x2*)(MG8 + row * 1024 + (ucol + bj * HALF) + l8) = (u32x2){(unsigned)p0, (unsigned)p1}; }
        }
    }
    __device__ __forceinline__ void operator()(const f32x4 (&acc)[2][2][4][2], const Unit& u, int wr, int wc, int fr_, int fq_) const {
        int fr = fr_, fq = fq_; asm volatile("" : "+v"(fr), "+v"(fq));
        const int urow = u.om * BM + wr * 64, ucol = u.on * BM + wc * 32;
        const unsigned lg = (unsigned)(fr * 3072 + 8 * fq), l8 = (unsigned)(fr * 1024 + 8 * fq);
        if (u.aux == 0) body<0>(acc, urow, ucol, lg, l8); else if (u.aux == 1) body<1>(acc, urow, ucol, lg, l8); else body<2>(acc, urow, ucol, lg, l8);
    }
};
template <int BR> struct EpiBranch {
    static constexpr bool PERM = true; static constexpr int NST = 16;
    const bf16_t* GATE; bf16_t* MG; unsigned char* MG8;
    __device__ __forceinline__ void operator()(const f32x4 (&acc)[2][2][4][2], const Unit& u, int wr, int wc, int fr, int fq) const {
        const int row0 = u.om * BM + wr * 64 + fr; const int col0 = u.on * BM + wc * 32 + 8 * fq;
#pragma unroll
        for (int ai = 0; ai < 2; ++ai) {
            u32x4 gw[4][2], mw[4][2];
#pragma unroll
            for (int m = 0; m < 4; ++m)
#pragma unroll
                for (int bj = 0; bj < 2; ++bj) { const size_t row = (size_t)(row0 + ai * HALF + m * 16);
                    gw[m][bj] = *(const u32x4*)(GATE + row * 3072 + BR * 1024 + col0 + bj * HALF);
                    mw[m][bj] = (BR > 0) ? *(const u32x4*)(MG + row * 1024 + col0 + bj * HALF) : (u32x4){0u, 0u, 0u, 0u}; }
#pragma unroll
            for (int m = 0; m < 4; ++m)
#pragma unroll
                for (int bj = 0; bj < 2; ++bj) { const size_t row = (size_t)(row0 + ai * HALF + m * 16); bf16_t* mp = MG + row * 1024 + col0 + bj * HALF;
                    const u32x4 g = gw[m][bj], mo = mw[m][bj]; const f32x4 a0 = acc[ai][bj][m][0], a1 = acc[ai][bj][m][1];
                    float o[8];
                    o[0] = bf_lo(g.x) * a0[0]; o[1] = bf_hi(g.x) * a0[1]; o[2] = bf_lo(g.y) * a0[2]; o[3] = bf_hi(g.y) * a0[3];
                    o[4] = bf_lo(g.z) * a1[0]; o[5] = bf_hi(g.z) * a1[1]; o[6] = bf_lo(g.w) * a1[2]; o[7] = bf_hi(g.w) * a1[3];
                    if (BR > 0) { o[0] += bf_lo(mo.x); o[1] += bf_hi(mo.x); o[2] += bf_lo(mo.y); o[3] += bf_hi(mo.y); o[4] += bf_lo(mo.z); o[5] += bf_hi(mo.z); o[6] += bf_lo(mo.w); o[7] += bf_hi(mo.w); }
                    if constexpr (BR == 2) {
#pragma unroll
                        for (int q = 0; q < 8; ++q) o[q] = __builtin_amdgcn_fmed3f(o[q] * 64.0f, -448.0f, 448.0f);
                        int p0 = __builtin_amdgcn_cvt_pk_fp8_f32(o[0], o[1], 0, false); p0 = __builtin_amdgcn_cvt_pk_fp8_f32(o[2], o[3], p0, true);
                        int p1 = __builtin_amdgcn_cvt_pk_fp8_f32(o[4], o[5], 0, false); p1 = __builtin_amdgcn_cvt_pk_fp8_f32(o[6], o[7], p1, true);
                        *(u32x2*)(MG8 + row * 1024 + col0 + bj * HALF) = (u32x2){(unsigned)p0, (unsigned)p1}; (void)mp;
                    } else { u32x4 w; w.x = cvt_pk_bf16(o[0], o[1]); w.y = cvt_pk_bf16(o[2], o[3]); w.z = cvt_pk_bf16(o[4], o[5]); w.w = cvt_pk_bf16(o[6], o[7]);
                        *(u32x4*)mp = w; } }
        }
    }
};
template <bool SRC32> struct EpiResid {
    static constexpr bool PERM = true; static constexpr int NST = 16;
    bf16_t* XB; const float* SL; const float* SC; const float* modl; int goff; float dsc;
    __device__ __forceinline__ void operator()(const f32x4 (&acc)[2][2][4][2], const Unit& u, int wr, int wc, int fr_, int fq_) const {
        int fr = fr_, fq = fq_; asm volatile("" : "+v"(fr), "+v"(fq));
        const int b = u.om / 33, pj = u.om % 33;
        bf16_t* base = XB + (size_t)u.om * 256 * 1024;
        const float* sbase = (pj == 0) ? SC + (size_t)b * 256 * 1024 : SL + ((size_t)b * 8192 + (size_t)(pj - 1) * 256) * 1024;
        const float* gv = modl + (pj == 0 ? 8 : b) * 6144 + goff;
        const int row0 = wr * 64 + fr, col0 = u.on * BM + wc * 32 + 8 * fq;
#pragma unroll
        for (int bj = 0; bj < 2; ++bj) {
            const f32x4 g0 = *(const f32x4*)(gv + col0 + bj * HALF) * dsc, g1 = *(const f32x4*)(gv + col0 + bj * HALF + 4) * dsc;
            if constexpr (SRC32) {
#pragma unroll
                for (int ai = 0; ai < 2; ++ai)
#pragma unroll
                  for (int mh = 0; mh < 4; mh += 2) {
                    f32x4 x0[4], x1[4];
#pragma unroll
                    for (int m = mh; m < mh + 2; ++m) { const float* p = sbase + (size_t)(row0 + ai * HALF + m * 16) * 1024 + col0 + bj * HALF; x0[m] = *(const f32x4*)p; x1[m] = *(const f32x4*)(p + 4); }
#pragma unroll
                    for (int m = mh; m < mh + 2; ++m) { const f32x4 y0 = x0[m] + g0 * acc[ai][bj][m][0], y1 = x1[m] + g1 * acc[ai][bj][m][1];
                        u32x4 w; w.x = cvt_pk_bf16(y0[0], y0[1]); w.y = cvt_pk_bf16(y0[2], y0[3]); w.z = cvt_pk_bf16(y1[0], y1[1]); w.w = cvt_pk_bf16(y1[2], y1[3]);
                        *(u32x4*)(base + (size_t)(row0 + ai * HALF + m * 16) * 1024 + col0 + bj * HALF) = w; } }
            } else {
                u32x4 xv[2][4];
#pragma unroll
                for (int ai = 0; ai < 2; ++ai)
#pragma unroll
                    for (int m = 0; m < 4; ++m) xv[ai][m] = *(const u32x4*)(base + (size_t)(row0 + ai * HALF + m * 16) * 1024 + col0 + bj * HALF);
#pragma unroll
                for (int ai = 0; ai < 2; ++ai) {
#pragma unroll
                    for (int m = 0; m < 4; ++m) { const u32x4 x = xv[ai][m];
                        const f32x4 y0 = (f32x4){bf_lo(x.x), bf_hi(x.x), bf_lo(x.y), bf_hi(x.y)} + g0 * acc[ai][bj][m][0], y1 = (f32x4){bf_lo(x.z), bf_hi(x.z), bf_lo(x.w), bf_hi(x.w)} + g1 * acc[ai][bj][m][1];
                        u32x4 w; w.x = cvt_pk_bf16(y0[0], y0[1]); w.y = cvt_pk_bf16(y0[2], y0[3]); w.z = cvt_pk_bf16(y1[0], y1[1]); w.w = cvt_pk_bf16(y1[2], y1[3]);
                        *(u32x4*)(base + (size_t)(row0 + ai * HALF + m * 16) * 1024 + col0 + bj * HALF) = w; } }
            }
        }
    }
};

typedef float f32x2r __attribute__((ext_vector_type(2)));
__device__ __forceinline__ float qk_swz16(float v) { return __builtin_bit_cast(float, __builtin_amdgcn_ds_swizzle(__builtin_bit_cast(int, v), (16 << 10) | 0x1f)); }
__device__ __forceinline__ float qk_other32(float v, bool upper) { const unsigned a = __builtin_bit_cast(unsigned, v); auto rr = __builtin_amdgcn_permlane32_swap(a, a, false, false); const unsigned r0 = rr[0], r1 = rr[1]; return upper ? __uint_as_float(r0) : __uint_as_float(r1); }
struct EpiQkv {
    static constexpr bool PERM = true; static constexpr int NST = 16;
    bf16_t* O; const f32x2r* rope; const float* gq; const float* gk; float c2; const PG8_LAS f32x4* r1;
    __device__ __forceinline__ void operator()(const f32x4 (&acc)[2][2][4][2], const Unit& u, int wr, int wc, int fr_, int fq_) const {
        int fr = fr_, fq = fq_; asm volatile("" : "+v"(fr), "+v"(fq));
        const int s = 4 * u.on + wc;
        int kind, nrm = 0;
        if (s < 8) { kind = 1; nrm = 1; } else if (s < 10) { kind = 2; nrm = 2; } else if (s < 12) kind = 0; else if (s < 20) kind = 1; else if (s < 22) kind = 2; else if (s < 24) kind = 0;
        else if (s < 32) kind = 1; else if (s < 40) kind = 2; else kind = 0;
        const int pj = u.om % 33; const bool lat = pj != 0; const int t0 = (pj - 1) * 256;
        const int col0 = u.on * BM + wc * 64 + 8 * fq;
        unsigned g2[2][4];
        if (nrm) { const float* gp = (nrm == 1) ? gq : gk;
#pragma unroll
            for (int bj = 0; bj < 2; ++bj)
#pragma unroll
                for (int e = 0; e < 4; ++e) g2[bj][e] = cvt_pk_bf16(gp[32 * bj + 8 * fq + 2 * e], gp[32 * bj + 8 * fq + 2 * e + 1]); }
        f32x4 c0[2][4], c1[4];
        const bool rot = lat && kind != 0;
        const PG8_LAS f32x4* p1 = r1 + fr * 8 + 4 * (fq & 1);
        if (rot) {
#pragma unroll
            for (int ai = 0; ai < 2; ++ai) { const f32x4* p = (const f32x4*)(rope + ((size_t)(t0 + 128 * ai + 64 * wr) * 2 + 0) * 16 + 8 * (fq & 1));
#pragma unroll
                for (int q = 0; q < 4; ++q) c0[ai][q] = p[q]; }
        }
#pragma unroll
        for (int m = 0; m < 4; ++m) {
            if (rot) {
#pragma unroll
                for (int q = 0; q < 4; ++q) c1[q] = p1[m * 128 + q]; }
#pragma unroll
            for (int ai = 0; ai < 2; ++ai) { const int rl = ai * HALF + wr * 64 + m * 16 + fr; bf16_t* rowp = O + (size_t)(u.om * BM + rl) * 3072 + col0;
                float x[2][8];
#pragma unroll
                for (int bj = 0; bj < 2; ++bj)
#pragma unroll
                    for (int e = 0; e < 8; ++e) x[bj][e] = acc[ai][bj][m][e >> 2][e & 3];
                if (kind != 0) {
                    if (nrm) { float ss = 0.f;
#pragma unroll
                        for (int bj = 0; bj < 2; ++bj)
#pragma unroll
                            for (int e = 0; e < 8; ++e) ss += x[bj][e] * x[bj][e];
                        ss += qk_swz16(ss); ss += qk_other32(ss, (fq & 2) != 0);
                        const float rs = 1.0f / sqrtf(ss * (1.f / 64.f) + 1e-6f);
#pragma unroll
                        for (int bj = 0; bj < 2; ++bj)
#pragma unroll
                            for (int e = 0; e < 8; ++e) x[bj][e] = x[bj][e] * rs * ((e & 1) ? bf_hi(g2[bj][e >> 1]) : bf_lo(g2[bj][e >> 1])); }
                    if (rot) {
#pragma unroll
                        for (int bj = 0; bj < 2; ++bj)
#pragma unroll
                            for (int e = 0; e < 8; ++e) { const f32x4 cq = (bj == 0) ? c0[ai][e >> 1] : c1[e >> 1]; const float cs = (e & 1) ? cq.z : cq.x, sn = (e & 1) ? cq.w : cq.y; const float px = qk_other32(x[bj][e], (fq & 2) != 0);
                                x[bj][e] = (fq & 2) ? (px * sn + x[bj][e] * cs) : (x[bj][e] * cs - px * sn); } }
                    if (kind == 1) {
#pragma unroll
                        for (int bj = 0; bj < 2; ++bj)
#pragma unroll
                            for (int e = 0; e < 8; ++e) x[bj][e] *= c2; }
                }
#pragma unroll
                for (int bj = 0; bj < 2; ++bj) { u32x4 w; w.x = cvt_pk_bf16(x[bj][0], x[bj][1]); w.y = cvt_pk_bf16(x[bj][2], x[bj][3]); w.z = cvt_pk_bf16(x[bj][4], x[bj][5]); w.w = cvt_pk_bf16(x[bj][6], x[bj][7]);
                    *(u32x4*)(rowp + bj * 32) = w; }
            }
            asm volatile("" ::: "memory");
        }
    }
};
struct EpiRouter {
    static constexpr bool PERM = false; static constexpr int NST = 16;
    float* LG;
    __device__ __forceinline__ void operator()(const f32x4 (&acc)[2][2][4][2], const Unit& u, int wr, int wc, int fr, int fq) const {
        const int row0 = u.om * BM + wr * 64 + fr, col0 = wc * 32 + 4 * fq;
#pragma unroll
        for (int ai = 0; ai < 2; ++ai)
#pragma unroll
            for (int m = 0; m < 4; ++m) { float* rowp = LG + (size_t)(row0 + ai * HALF + m * 16) * 128 + col0;
#pragma unroll
                for (int n = 0; n < 2; ++n) *(f32x4*)(rowp + n * 16) = acc[ai][0][m][n]; }
    }
};
template <bool F8> struct EpiUp {
    static constexpr bool PERM = true; static constexpr int NST = 8;
    bf16_t* H;
    __device__ __forceinline__ void operator()(const f32x4 (&acc)[2][2][4][2], const Unit& u, int wr, int wc, int fr, int fq) const {
        const int row0 = u.om * BM + wr * 64 + fr; const int col0 = u.on * HALF + wc * 32 + 8 * fq;
#pragma unroll
        for (int ai = 0; ai < 2; ++ai)
#pragma unroll
            for (int m = 0; m < 4; ++m) { bf16_t* rowp = H + (size_t)(row0 + ai * HALF + m * 16) * 256 + col0;
                float o[8];
#pragma unroll
                for (int n = 0; n < 2; ++n)
#pragma unroll
                    for (int j = 0; j < 4; ++j) { const float a = acc[ai][0][m][n][j], c = acc[ai][1][m][n][j]; o[n * 4 + j] = a * sigmoidf_fast(a) * c; }
                if constexpr (F8) {
#pragma unroll
                    for (int q = 0; q < 8; ++q) o[q] = __builtin_amdgcn_fmed3f(o[q], -56.0f, 56.0f);
                    int p0 = __builtin_amdgcn_cvt_pk_fp8_f32(o[0] * 8.0f, o[1] * 8.0f, 0, false); p0 = __builtin_amdgcn_cvt_pk_fp8_f32(o[2] * 8.0f, o[3] * 8.0f, p0, true);
                    int p1 = __builtin_amdgcn_cvt_pk_fp8_f32(o[4] * 8.0f, o[5] * 8.0f, 0, false); p1 = __builtin_amdgcn_cvt_pk_fp8_f32(o[6] * 8.0f, o[7] * 8.0f, p1, true);
                    *(u32x2*)((unsigned char*)H + (size_t)(row0 + ai * HALF + m * 16) * 256 + col0) = (u32x2){(unsigned)p0, (unsigned)p1}; }
                else { u32x4 w; w.x = cvt_pk_bf16(o[0], o[1]); w.y = cvt_pk_bf16(o[2], o[3]); w.z = cvt_pk_bf16(o[4], o[5]); w.w = cvt_pk_bf16(o[6], o[7]);
                    *(u32x4*)rowp = w; } }
    }
};

template <class Epi, class Sched, bool ALIGN_EPI, bool GATHER, int FP8 = 0>
__device__ __forceinline__ void gemm_phase(PG8_LAS unsigned char* lds, const Gemm g, const Sched& S, const Epi& E) {
    int tid = threadIdx.x; asm volatile("" : "+v"(tid));
    const int wid = __builtin_amdgcn_readfirstlane(tid >> 6), lane = tid & 63, wr = wid >> 2, wc = wid & 3, fr = lane & 15, fq = lane >> 4;
    int K = g.K; asm volatile("" : "+s"(K));
    const int nt = K / BK;
    unsigned voffA[2], voffB[2]; int RA[2]; unsigned CA2[2];
#pragma unroll
    for (int i = 0; i < 2; ++i) { int R, C; stage_rc(tid * 16 + i * 8192, R, C); const int Rb = Epi::PERM ? ((R & ~31) + perm32(R & 31)) : R;
        voffA[i] = (unsigned)(R * K + C) * 2u; voffB[i] = (unsigned)(Rb * K + C) * 2u; RA[i] = R; CA2[i] = (unsigned)C * 2u; }
    const size_t kstep = (size_t)(BK * 2);
    const size_t hstep = (size_t)HALF * K * 2;
    const size_t tstep = 2 * hstep;
    const unsigned rowb = (unsigned)K * 2u;
    const unsigned ldsw = (unsigned)wid * 1024u;
    const int aoff = lds_byte(wr * 64 + fr, fq * 8), boff = lds_byte(wc * 32 + fr, fq * 8);
#define PG8_SA(b, h) (((b) * 2 + (h)) * HTB)
#define PG8_SB(b, h) ((4 + (b) * 2 + (h)) * HTB)
#define PG8_STAGE(bufoff, gbase, voff) do { _Pragma("unroll") for (int _i = 0; _i < 2; ++_i) \
        __builtin_amdgcn_global_load_lds((const unsigned*)((const char*)(gbase) + (voff)[_i]), (PG8_LAS unsigned*)(lds + (bufoff) + ldsw + _i * 8192), 16, 0, 0); } while (0)
#define PG8_STAGE_A(bufoff, gb, h, VO) do { if constexpr (GATHER) { PG8_STAGE(bufoff, gb, VO[h]); } else { PG8_STAGE(bufoff, (gb) + (h) * hstep, voffA); } } while (0)
#define PG8_LD32(p) ({ const v4i32 lo_ = *(const PG8_LAS v4i32*)(p), hi_ = *(const PG8_LAS v4i32*)((p) + 1024); __builtin_shufflevector(lo_, hi_, 0, 1, 2, 3, 4, 5, 6, 7); })
#define PG8_LDA(dst, b, h) do { if constexpr (FP8) { _Pragma("unroll") for (int m = 0; m < 4; ++m) dst##8[m] = PG8_LD32(lds + PG8_SA(b, h) + aoff + m * 2048); } else { \
        _Pragma("unroll") for (int m = 0; m < 4; ++m) _Pragma("unroll") for (int k = 0; k < 2; ++k) dst[m][k] = *(const PG8_LAS bf16x8*)(lds + PG8_SA(b, h) + aoff + m * 2048 + k * 1024); } } while (0)
#define PG8_LDB(dst, b, h) do { if constexpr (FP8) { _Pragma("unroll") for (int n = 0; n < 2; ++n) dst##8[n] = PG8_LD32(lds + PG8_SB(b, h) + boff + n * 2048); } else { \
        _Pragma("unroll") for (int n = 0; n < 2; ++n) _Pragma("unroll") for (int k = 0; k < 2; ++k) dst[n][k] = *(const PG8_LAS bf16x8*)(lds + PG8_SB(b, h) + boff + n * 2048 + k * 1024); } } while (0)
#define PG8_MMA(ai, bj, At, Bt) do { __builtin_amdgcn_s_setprio(1); \
        if constexpr (FP8) { _Pragma("unroll") for (int m = 0; m < 4; ++m) _Pragma("unroll") for (int n = 0; n < 2; ++n) \
            asm volatile("v_mfma_scale_f32_16x16x128_f8f6f4 %0, %1, %2, %0, %3, %3 op_sel_hi:[0,0,0]" : "+v"(acc[ai][bj][m][n]) : "v"(Bt##8[n]), "v"(At##8[m]), "v"(sc8)); } \
        else { _Pragma("unroll") for (int m = 0; m < 4; ++m) _Pragma("unroll") for (int n = 0; n < 2; ++n) _Pragma("unroll") for (int k = 0; k < 2; ++k) \
            acc[ai][bj][m][n] = __builtin_amdgcn_mfma_f32_16x16x32_bf16(Bt[n][k], At[m][k], acc[ai][bj][m][n], 0, 0, 0); } \
        __builtin_amdgcn_s_setprio(0); } while (0)
#define PG8_WAIT_V(n) asm volatile("s_waitcnt vmcnt(" #n ")" ::: "memory")
#define PG8_WAIT_L(n) asm volatile("s_waitcnt lgkmcnt(" #n ")" ::: "memory")
#define PG8_BAR __builtin_amdgcn_s_barrier()
#define PG8_SCHED __builtin_amdgcn_sched_barrier(0)
    Unit cur, nxt, nx2; int ui = 0;
    if (!S.next(0, cur)) return;
    f32x4 acc[2][2][4][2];
#pragma unroll
    for (int a = 0; a < 2; ++a)
#pragma unroll
        for (int b = 0; b < 2; ++b)
#pragma unroll
            for (int m = 0; m < 4; ++m)
#pragma unroll
                for (int n = 0; n < 2; ++n) acc[a][b][m][n] = (f32x4){0.f, 0.f, 0.f, 0.f};
    bf16x8 At[4][2], B0[2][2], B1[2][2]; v8i32 At8[4], B08[2], B18[2];
    int sc8 = FP8 * 0x01010101; asm volatile("" : "+v"(sc8));
    unsigned cvo[2][2], nvo[2][2], n2vo[2][2];
    bool has_next = S.next(1, nxt);
    if constexpr (GATHER) {
#pragma unroll
        for (int h = 0; h < 2; ++h)
#pragma unroll
            for (int i = 0; i < 2; ++i) { cvo[h][i] = S.arow(cur, h, RA[i]) * rowb + CA2[i]; nvo[h][i] = has_next ? S.arow(nxt, h, RA[i]) * rowb + CA2[i] : cvo[h][i]; n2vo[h][i] = nvo[h][i]; }
    }
    const char* cA = GATHER ? (const char*)g.A : (const char*)g.A + (size_t)cur.pm * tstep; const char* cB = (const char*)g.Bt + (size_t)cur.pn * tstep;
    PG8_STAGE(PG8_SB(0, 0), cB, voffB); PG8_STAGE(PG8_SB(0, 1), cB + hstep, voffB); PG8_STAGE_A(PG8_SA(0, 0), cA, 0, cvo); PG8_STAGE_A(PG8_SA(0, 1), cA, 1, cvo);
    if (wr == 1) PG8_BAR;
    PG8_WAIT_V(2); PG8_BAR;
    PG8_STAGE(PG8_SB(1, 0), cB + kstep, voffB); PG8_STAGE_A(PG8_SA(1, 0), cA + kstep, 0, cvo); PG8_STAGE(PG8_SB(1, 1), cB + hstep + kstep, voffB);
    PG8_WAIT_V(6); PG8_BAR;
    for (;;) {
        bool has_n2 = false;
        if constexpr (GATHER) { if (has_next) { has_n2 = S.next(ui + 2, nx2); if (has_n2) {
#pragma unroll
            for (int h = 0; h < 2; ++h)
#pragma unroll
                for (int i = 0; i < 2; ++i) n2vo[h][i] = S.arow(nx2, h, RA[i]) * rowb + CA2[i]; } } }
        const char* nA = GATHER ? (const char*)g.A : (has_next ? (const char*)g.A + (size_t)nxt.pm * tstep : cA); const char* nB = has_next ? (const char*)g.Bt + (size_t)nxt.pn * tstep : cB;
        for (int t = 0; t < nt; t += 2) {
            const bool last = (t == nt - 2);
            const char* a1 = cA + (size_t)(t + 1) * kstep;
            const char* a2 = last ? nA : cA + (size_t)(t + 2) * kstep; const char* b2 = last ? nB : cB + (size_t)(t + 2) * kstep;
            const char* a3 = a2 + kstep; const char* b3 = b2 + kstep;
            unsigned xvo[2][2];
            if constexpr (GATHER) {
#pragma unroll
                for (int h = 0; h < 2; ++h)
#pragma unroll
                    for (int i = 0; i < 2; ++i) xvo[h][i] = last ? nvo[h][i] : cvo[h][i];
            }
            PG8_LDB(B0, 0, 0); PG8_LDB(B1, 0, 1); PG8_SCHED; PG8_LDA(At, 0, 0); PG8_STAGE_A(PG8_SA(1, 1), a1, 1, cvo);
            PG8_WAIT_V(8); PG8_WAIT_L(0); PG8_BAR; PG8_MMA(0, 0, At, B0); PG8_MMA(0, 1, At, B1); PG8_BAR; PG8_SCHED;
            PG8_LDA(At, 0, 1); PG8_STAGE(PG8_SB(0, 0), b2, voffB); PG8_STAGE(PG8_SB(0, 1), b2 + hstep, voffB); PG8_STAGE_A(PG8_SA(0, 0), a2, 0, xvo);
            PG8_WAIT_V(8); PG8_WAIT_L(0); PG8_BAR; PG8_MMA(1, 0, At, B0); PG8_MMA(1, 1, At, B1); PG8_BAR; PG8_SCHED;
            PG8_LDB(B0, 1, 0); PG8_LDB(B1, 1, 1); PG8_SCHED; PG8_LDA(At, 1, 0); PG8_STAGE_A(PG8_SA(0, 1), a2, 1, xvo);
            PG8_WAIT_V(8); PG8_WAIT_L(0); PG8_BAR; PG8_MMA(0, 0, At, B0); PG8_MMA(0, 1, At, B1); PG8_BAR; PG8_SCHED;
            PG8_LDA(At, 1, 1); PG8_STAGE(PG8_SB(1, 0), b3, voffB); PG8_STAGE(PG8_SB(1, 1), b3 + hstep, voffB); PG8_STAGE_A(PG8_SA(1, 0), a3, 0, xvo);
            PG8_WAIT_V(8); PG8_WAIT_L(0); PG8_BAR; PG8_MMA(1, 0, At, B0); PG8_MMA(1, 1, At, B1); PG8_BAR; PG8_SCHED;
        }
        if constexpr (ALIGN_EPI) { if (wr == 0) PG8_BAR; }
        if constexpr (FP8) asm volatile("s_nop 15\n\ts_nop 15" ::: "memory");
        E(acc, cur, wr, wc, fr, fq);
        if (!has_next) break;
#pragma unroll
        for (int a = 0; a < 2; ++a)
#pragma unroll
            for (int b = 0; b < 2; ++b)
#pragma unroll
                for (int m = 0; m < 4; ++m)
#pragma unroll
                    for (int n = 0; n < 2; ++n) acc[a][b][m][n] = (f32x4){0.f, 0.f, 0.f, 0.f};
        cur = nxt; cA = nA; cB = nB; ++ui;
        if constexpr (GATHER) {
#pragma unroll
            for (int h = 0; h < 2; ++h)
#pragma unroll
                for (int i = 0; i < 2; ++i) { cvo[h][i] = nvo[h][i]; nvo[h][i] = n2vo[h][i]; }
            has_next = has_n2; nxt = nx2;
        } else { has_next = S.next(ui + 1, nxt); }
        if constexpr (ALIGN_EPI) { if (wr == 1) PG8_BAR; }
    }
    PG8_WAIT_V(0);
    if constexpr (!ALIGN_EPI) { if (wr == 0) PG8_BAR; }
    PG8_BAR;
#undef PG8_SA
#undef PG8_SB
#undef PG8_STAGE
#undef PG8_STAGE_A
#undef PG8_LDA
#undef PG8_LD32
#undef PG8_LDB
#undef PG8_MMA
#undef PG8_WAIT_V
#undef PG8_WAIT_L
#undef PG8_BAR
#undef PG8_SCHED
}
}
namespace attn_body {
using bf16=__hip_bfloat16;
using bf16x8=__attribute__((ext_vector_type(8)))short;
using s16x4=__attribute__((ext_vector_type(4)))short;
using f32x16=__attribute__((ext_vector_type(16)))float;
using u32x4=__attribute__((ext_vector_type(4)))unsigned;
constexpr int D=64, P=3072;
constexpr int NW=8,QBLK=32,QB=QBLK*NW,KVBLK=64;
__device__ __forceinline__ int crow(int r,int hi){return (r&3)+8*(r>>2)+4*hi;}
#define SBAR() __builtin_amdgcn_sched_barrier(0)
__device__ __forceinline__ void wmask(f32x16&p0,f32x16&p1,int dbase){
  const float NEG=-INFINITY;
  #pragma unroll
  for(int r=0;r<16;++r){const int d=dbase+(r&3)+8*(r>>2); if(d>128||d<-128)p0[r]=NEG; if(d+32>128||d+32<-128)p1[r]=NEG;}
}
constexpr int NSLOT=3, SLOTB=8192;
constexpr int LDS_K=0, LDS_V=NSLOT*SLOTB, LDS_WS=2*NSLOT*SLOTB, LDS_OST=LDS_WS+NW*64*4, LDS_BYTES=LDS_OST+NW*4096;
constexpr float C2=0.125f*1.4426950408889634f;
__device__ __forceinline__ void glds16(const void*gsrc,unsigned lds_dst){unsigned keep;
  asm volatile("s_mov_b32 %0, m0\n\ts_mov_b32 m0, %2\n\ts_nop 0\n\tglobal_load_lds_dwordx4 %1, off\n\ts_mov_b32 m0, %0":"=&s"(keep):"v"(gsrc),"s"(lds_dst):"memory");}
__device__ __forceinline__ float max3f(float a,float b,float c){float r;asm("v_max3_f32 %0, %1, %2, %3":"=v"(r):"v"(a),"v"(b),"v"(c));return r;}
__device__ __forceinline__ float max2f(float a,float b){float r;asm("v_max_f32_e32 %0, %1, %2":"=v"(r):"v"(a),"v"(b));return r;}
__device__ __forceinline__ float fadd_s(float a,float b){float r;asm("v_add_f32_e32 %0, %1, %2":"=v"(r):"v"(a),"v"(b));return r;}
__device__ __forceinline__ float fsub_s(float a,float b){float r;asm("v_sub_f32_e32 %0, %1, %2":"=v"(r):"v"(a),"v"(b));return r;}
typedef float f32x2_t __attribute__((ext_vector_type(2))); typedef __bf16 bf16x2_t __attribute__((ext_vector_type(2)));
__device__ __forceinline__ unsigned cvtpk_s(float lo,float hi){f32x2_t v={lo,hi};bf16x2_t b=__builtin_convertvector(v,bf16x2_t);return __builtin_bit_cast(unsigned,b);}
#define WAIT_BAR(N) asm volatile("s_waitcnt vmcnt(" #N ") lgkmcnt(0)\n\ts_barrier":::"memory")

__device__ __forceinline__ void qkt(f32x16&p0,f32x16&p1,const char*Kslot,const bf16x8*qr,const f32x16&negm,int r32,int hi){
  const char*kb=Kslot+hi*1024+r32*16;
  #pragma unroll
  for(int d0=0;d0<4;++d0){
    const bf16x8 b0=*reinterpret_cast<const bf16x8*>(kb+d0*2048);
    const bf16x8 b1=*reinterpret_cast<const bf16x8*>(kb+d0*2048+512);
    if(d0==0){p0=__builtin_amdgcn_mfma_f32_32x32x16_bf16(b0,qr[0],negm,0,0,0);p1=__builtin_amdgcn_mfma_f32_32x32x16_bf16(b1,qr[0],negm,0,0,0);}
    else{p0=__builtin_amdgcn_mfma_f32_32x32x16_bf16(b0,qr[d0],p0,0,0,0);p1=__builtin_amdgcn_mfma_f32_32x32x16_bf16(b1,qr[d0],p1,0,0,0);}}
}
typedef __attribute__((address_space(3))) const char* lds_cptr;
typedef short v4i16_t __attribute__((ext_vector_type(4)));
__device__ __forceinline__ void kload8(bf16x8*kf,lds_cptr kp){
  kf[0]=*(const __attribute__((address_space(3))) bf16x8*)(kp);      kf[1]=*(const __attribute__((address_space(3))) bf16x8*)(kp+512);
  kf[2]=*(const __attribute__((address_space(3))) bf16x8*)(kp+2048); kf[3]=*(const __attribute__((address_space(3))) bf16x8*)(kp+2560);
  kf[4]=*(const __attribute__((address_space(3))) bf16x8*)(kp+4096); kf[5]=*(const __attribute__((address_space(3))) bf16x8*)(kp+4608);
  kf[6]=*(const __attribute__((address_space(3))) bf16x8*)(kp+6144); kf[7]=*(const __attribute__((address_space(3))) bf16x8*)(kp+6656);
}
__device__ __forceinline__ void kload2(bf16x8*kf,lds_cptr kp,int j){ kf[2*j]=*(const __attribute__((address_space(3))) bf16x8*)(kp+j*2048); kf[2*j+1]=*(const __attribute__((address_space(3))) bf16x8*)(kp+j*2048+512); }
__device__ __forceinline__ s16x4 vtr(lds_cptr p){ return __builtin_bit_cast(s16x4,__builtin_amdgcn_ds_read_tr16_b64_v4i16((__attribute__((address_space(3))) v4i16_t*)p)); }
__device__ __forceinline__ float rowmax(const f32x16&p0,const f32x16&p1){
  float a=max3f(p0[0],p0[1],p1[0]),b=max3f(p0[2],p0[3],p1[1]);a=max3f(a,p1[2],p1[3]);
  #pragma unroll
  for(int r=4;r<16;r+=4){a=max3f(a,p0[r],p0[r+1]);b=max3f(b,p0[r+2],p0[r+3]);a=max3f(a,p1[r],p1[r+1]);b=max3f(b,p1[r+2],p1[r+3]);}
  const float m=max2f(a,b);
  auto rr=__builtin_amdgcn_permlane32_swap(__float_as_uint(m),__float_as_uint(m),false,false);
  return max2f(__uint_as_float(rr[0]),__uint_as_float(rr[1]));
}
__device__ __forceinline__ void pv(f32x16*o,int vb,bf16x8 pa0,bf16x8 pa1,bf16x8 pa2,bf16x8 pa3){
  #pragma unroll
  for(int d0=0;d0<2;++d0){s16x4 lo[4],hi[4];
    #pragma unroll
    for(int ks=0;ks<4;++ks){
      asm volatile("ds_read_b64_tr_b16 %0,%1 offset:%c2":"=&v"(lo[ks]):"v"(vb),"i"(d0*4096+ks*1024):"memory");
      asm volatile("ds_read_b64_tr_b16 %0,%1 offset:%c2":"=&v"(hi[ks]):"v"(vb),"i"(d0*4096+ks*1024+512):"memory");}
    asm volatile("s_waitcnt lgkmcnt(0)":::"memory");SBAR();
    #define PK(k) (bf16x8){lo[k][0],lo[k][1],lo[k][2],lo[k][3],hi[k][0],hi[k][1],hi[k][2],hi[k][3]}
    o[d0]=__builtin_amdgcn_mfma_f32_32x32x16_bf16(pa0,PK(0),o[d0],0,0,0);
    o[d0]=__builtin_amdgcn_mfma_f32_32x32x16_bf16(pa1,PK(1),o[d0],0,0,0);
    o[d0]=__builtin_amdgcn_mfma_f32_32x32x16_bf16(pa2,PK(2),o[d0],0,0,0);
    o[d0]=__builtin_amdgcn_mfma_f32_32x32x16_bf16(pa3,PK(3),o[d0],0,0,0);
    #undef PK
  }
}

template<int MODE,int THRL> __device__ __forceinline__ void attn_unit(const bf16*Qu,const bf16*__restrict__ Kh,const bf16*__restrict__ Vh,unsigned char*Ou,int PO,int NT,int wadd,int dq0,float sink2,char*shm){
  int tid=threadIdx.x; asm volatile("":"+v"(tid)); const int lane=tid&63,r32=lane&31,hi=lane>>5; const int wid=__builtin_amdgcn_readfirstlane(tid>>6);
  const bf16*Qw=Qu+(long)(wid*QBLK)*P;
  const unsigned lds0=(unsigned)(uintptr_t)shm;
  float*wsf=(float*)(shm+LDS_WS)+wid*64;
  const bf16*ksrc=Kh+(long)lane*P+wid*8;
  const bf16*vsrc=Vh+(long)(16*(wid&3)+(lane>>2))*P+(wid>>2)*32+(lane&3)*8;
  const unsigned kdst=lds0+LDS_K+wid*1024, vdst=lds0+LDS_V+wid*1024;
  #define TROW(t) ((long)(t)*KVBLK+((MODE==1&&(t)>=4)?(long)wadd:0l))
  #define DMA_K(t,slot) glds16(ksrc+TROW(t)*P,(unsigned)__builtin_amdgcn_readfirstlane(kdst+(slot)))
  #define DMA_V(t,slot) glds16(vsrc+TROW(t)*P,(unsigned)__builtin_amdgcn_readfirstlane(vdst+(slot)))
  const int vb0=(int)(lds0+LDS_V)+((lane>>4)&1)*32+(lane&3)*8+(4*hi+((lane&15)>>2))*64;
  const char*Kbase=shm+LDS_K; bf16x8 kf[8];
  const lds_cptr shm3=(lds_cptr)shm; const lds_cptr kp0=shm3+LDS_K+hi*1024+r32*16; const lds_cptr vp0=shm3+LDS_V+((lane>>4)&1)*32+(lane&3)*8+(4*hi+((lane&15)>>2))*64;
  DMA_K(0,0);DMA_V(0,0);DMA_K(1,SLOTB);
  bf16x8 qr[4];
  #pragma unroll
  for(int d0=0;d0<4;++d0)qr[d0]=*reinterpret_cast<const bf16x8*>(&Qw[(long)r32*P+d0*16+hi*8]);
  float mhat=0.f,l_reg=0.f;f32x16 o[2];o[0]=f32x16{};o[1]=f32x16{};f32x16 negm=f32x16{};asm volatile("":"+v"(negm));
  const int qrel=wid*QBLK+r32;
  const int dlane=dq0-qrel+4*hi;
  #define CMASK(P0,P1,t) do{ if(MODE==1){ if((t)>=4) wmask(P0,P1,dlane+64*((t)-4)); } }while(0)
  bool resc=false;
  #define START(P0,P1) do{ const float rm=rowmax(P0,P1); resc=false; \
    { const float dl=rm; mhat=fadd_s(mhat,dl); \
      _Pragma("unroll") for(int r=0;r<16;++r){P0[r]=fsub_s(P0[r],dl);P1[r]=fsub_s(P1[r],dl);} \
      _Pragma("unroll") for(int r=0;r<16;++r)negm[r]=-mhat; asm volatile("":"+v"(negm)); } \
    _Pragma("unroll") for(int r=0;r<16;++r)P0[r]=__builtin_amdgcn_exp2f(P0[r]); }while(0)
  #define RESC() do{ if(resc){ asm volatile("s_waitcnt lgkmcnt(0)":::"memory"); \
      _Pragma("unroll") for(int d_=0;d_<2;++d_) _Pragma("unroll") for(int r=0;r<16;++r)o[d_][r]*=wsf[crow(r,hi)]; } }while(0)
  f32x16 pA0,pA1,pB0,pB1;
  int sl_prev=0,sl_cur=0,sl_next=SLOTB;
  #define ROT() do{sl_prev=sl_cur;sl_cur=sl_next;sl_next=(sl_next==(NSLOT-1)*SLOTB)?0:sl_next+SLOTB;}while(0)
  DMA_K(2,2*SLOTB);
  WAIT_BAR(3);
  qkt(pA0,pA1,Kbase,qr,negm,r32,hi);asm volatile("s_nop 15\n\ts_nop 7":"+v"(pA0),"+v"(pA1));
  START(pA0,pA1);
  _Pragma("unroll") for(int r=0;r<16;++r)pA1[r]=__builtin_amdgcn_exp2f(pA1[r]);
  WAIT_BAR(0);
  DMA_K(3,0);DMA_V(1,SLOTB);
  ROT();
  kload8(kf,kp0+sl_cur);
  WAIT_BAR(2);
  s16x4 vlo[8],vhi[8]; u32x4 pw0,pw1,pw2,pw3;
  #define PKW(P,B) cvtpk_s(P[B],P[B+1])
  #define PAF(k) __builtin_bit_cast(bf16x8,pw##k)
  #define VFR(i) (bf16x8){vlo[i][0],vlo[i][1],vlo[i][2],vlo[i][3],vhi[i][0],vhi[i][1],vhi[i][2],vhi[i][3]}
  #define PIN(x) asm volatile("":"+v"(x))
  #define MX3(a,b,c) __builtin_fmaxf(__builtin_fmaxf((a),(b)),(c))
  #define GAPA(MF,A0,A1,A2,A3,W0,W1,PW) do{ MF; sacc+=A0; sacc+=A1; sacc+=A2; sacc+=A3; PIN(sacc); W0; W1; PIN(PW); SBAR(); }while(0)
  #define EX(v) __builtin_amdgcn_exp2f(v)
  #define GAPB(MF,X,B) do{ MF; X[B]=EX(X[B]); X[B+1]=EX(X[B+1]); X[B+2]=EX(X[B+2]); X[B+3]=EX(X[B+3]); PIN(X); SBAR(); }while(0)
  #define VRD(i) do{ vlo[i]=vtr(vp_+(((i)>>2)*4096+((i)&3)*1024)); vhi[i]=vtr(vp_+(((i)>>2)*4096+((i)&3)*1024+512)); }while(0)
  #define KRD(G,j) do{ if(G){ kload2(kf,kp0+sl_next,j); SBAR(); } }while(0)
  #define STEP(C0,C1,P0,P1,t,GK,GV,GL) do{ SBAR(); \
    const lds_cptr vp_=vp0+sl_prev; \
    VRD(0); SBAR(); float sacc=(P0[0]+P0[1]); \
    GAPA(C0=__builtin_amdgcn_mfma_f32_32x32x16_bf16(kf[0],qr[0],negm,0,0,0), P0[2],P0[3],P0[4],P0[5],     pw0[0]=PKW(P0,0), pw0[1]=PKW(P0,2), pw0); \
    VRD(4); SBAR(); GAPA(C1=__builtin_amdgcn_mfma_f32_32x32x16_bf16(kf[1],qr[0],negm,0,0,0), P0[6],P0[7],P0[8],P0[9],     pw0[2]=PKW(P0,4), pw0[3]=PKW(P0,6), pw0); \
    VRD(1); SBAR(); GAPA(C0=__builtin_amdgcn_mfma_f32_32x32x16_bf16(kf[2],qr[1],C0,0,0,0),   P0[10],P0[11],P0[12],P0[13], pw1[0]=PKW(P0,8), pw1[1]=PKW(P0,10), pw1); \
    VRD(5); SBAR(); GAPA(C1=__builtin_amdgcn_mfma_f32_32x32x16_bf16(kf[3],qr[1],C1,0,0,0),   P0[14],P0[15],P1[0],P1[1],   pw1[2]=PKW(P0,12),pw1[3]=PKW(P0,14), pw1); \
    VRD(2); SBAR(); GAPA(C0=__builtin_amdgcn_mfma_f32_32x32x16_bf16(kf[4],qr[2],C0,0,0,0),   P1[2],P1[3],P1[4],P1[5],     pw2[0]=PKW(P1,0), pw2[1]=PKW(P1,2), pw2); \
    VRD(6); SBAR(); GAPA(C1=__builtin_amdgcn_mfma_f32_32x32x16_bf16(kf[5],qr[2],C1,0,0,0),   P1[6],P1[7],P1[8],P1[9],     pw2[2]=PKW(P1,4), pw2[3]=PKW(P1,6), pw2); \
    VRD(3); SBAR(); GAPA(C0=__builtin_amdgcn_mfma_f32_32x32x16_bf16(kf[6],qr[3],C0,0,0,0),   P1[10],P1[11],P1[12],P1[13], pw3[0]=PKW(P1,8), pw3[1]=PKW(P1,10), pw3); \
    VRD(7); SBAR(); GAPA(C1=__builtin_amdgcn_mfma_f32_32x32x16_bf16(kf[7],qr[3],C1,0,0,0),   P1[14],P1[15],0.f,0.f,       pw3[2]=PKW(P1,12),pw3[3]=PKW(P1,14), pw3); \
    l_reg+=sacc; \
    if(GK){DMA_K((t)+3,sl_cur);} if(GV){DMA_V((t)+1,sl_next);} \
    CMASK(C0,C1,t); \
    { float a=MX3(C0[0],C0[1],C1[0]),b=MX3(C0[2],C0[3],C1[1]); a=MX3(a,C1[2],C1[3]); \
      _Pragma("unroll") for(int r=4;r<16;r+=4){a=MX3(a,C0[r],C0[r+1]);b=MX3(b,C0[r+2],C0[r+3]);a=MX3(a,C1[r],C1[r+1]);b=MX3(b,C1[r+2],C1[r+3]);} \
      float rm=__builtin_fmaxf(a,b); { auto rr=__builtin_amdgcn_permlane32_swap(__float_as_uint(rm),__float_as_uint(rm),false,false); rm=__builtin_fmaxf(__uint_as_float(rr[0]),__uint_as_float(rr[1])); } \
      resc=false; \
      if(__builtin_expect(__any(rm>(float)THRL),0)){ const float dl=__builtin_fmaxf(rm,0.f); mhat+=dl; \
        _Pragma("unroll") for(int r=0;r<16;++r){C0[r]-=dl;C1[r]-=dl;} \
        _Pragma("unroll") for(int r=0;r<16;++r)negm[r]=-mhat; asm volatile("":"+v"(negm)); \
        const float f=__builtin_amdgcn_exp2f(-dl); l_reg*=f; if(hi==0)wsf[r32]=f; resc=true; } } \
    SBAR(); \
    GAPB(o[0]=__builtin_amdgcn_mfma_f32_32x32x16_bf16(PAF(0),VFR(0),o[0],0,0,0), C0,0); \
    GAPB(o[1]=__builtin_amdgcn_mfma_f32_32x32x16_bf16(PAF(0),VFR(4),o[1],0,0,0), C0,4); \
    KRD(GL,0); GAPB(o[0]=__builtin_amdgcn_mfma_f32_32x32x16_bf16(PAF(1),VFR(1),o[0],0,0,0), C0,8); \
    KRD(GL,1); GAPB(o[1]=__builtin_amdgcn_mfma_f32_32x32x16_bf16(PAF(1),VFR(5),o[1],0,0,0), C0,12); \
    KRD(GL,2); GAPB(o[0]=__builtin_amdgcn_mfma_f32_32x32x16_bf16(PAF(2),VFR(2),o[0],0,0,0), C1,0); \
    KRD(GL,3); GAPB(o[1]=__builtin_amdgcn_mfma_f32_32x32x16_bf16(PAF(2),VFR(6),o[1],0,0,0), C1,4); \
    GAPB(o[0]=__builtin_amdgcn_mfma_f32_32x32x16_bf16(PAF(3),VFR(3),o[0],0,0,0), C1,8); \
    GAPB(o[1]=__builtin_amdgcn_mfma_f32_32x32x16_bf16(PAF(3),VFR(7),o[1],0,0,0), C1,12); \
    }while(0)
  int t=1;
  if(MODE==0){
    for(;t+5<NT;t+=2){
      STEP(pB0,pB1,pA0,pA1,t,true,true,true);     WAIT_BAR(2); RESC(); ROT();
      STEP(pA0,pA1,pB0,pB1,t+1,true,true,true);   WAIT_BAR(2); RESC(); ROT();
    }
  }
  #define ENDW(tt) do{ if((tt)+3<NT){WAIT_BAR(2);} else if((tt)+2<NT){WAIT_BAR(1);} else {WAIT_BAR(0);} }while(0)
  for(;t+1<NT;t+=2){
    STEP(pB0,pB1,pA0,pA1,t,(t+3<NT),(t+1<NT),(t+1<NT));       ENDW(t);   RESC(); ROT();
    STEP(pA0,pA1,pB0,pB1,t+1,(t+4<NT),(t+2<NT),(t+2<NT));     ENDW(t+1); RESC(); ROT();
  }
  STEP(pB0,pB1,pA0,pA1,NT-1,false,false,false); RESC();
  { float sacc=pB0[0]+pB0[1]; _Pragma("unroll") for(int r=2;r<16;++r)sacc+=pB0[r]; _Pragma("unroll") for(int r=0;r<16;++r)sacc+=pB1[r]; l_reg+=sacc;
    pw0=(u32x4){PKW(pB0,0),PKW(pB0,2),PKW(pB0,4),PKW(pB0,6)};pw1=(u32x4){PKW(pB0,8),PKW(pB0,10),PKW(pB0,12),PKW(pB0,14)};pw2=(u32x4){PKW(pB1,0),PKW(pB1,2),PKW(pB1,4),PKW(pB1,6)};pw3=(u32x4){PKW(pB1,8),PKW(pB1,10),PKW(pB1,12),PKW(pB1,14)};
    SBAR(); pv(o,vb0+sl_cur,PAF(0),PAF(1),PAF(2),PAF(3)); }
  #undef PKW
  #undef PAF
  #undef VFR
  #undef PIN
  #undef MX3
  #undef GAPA
  #undef GAPB
  #undef EX
  #undef VRD
  #undef KRD
  #undef STEP
  #undef ENDW
  {auto rr=__builtin_amdgcn_permlane32_swap(__float_as_uint(l_reg),__float_as_uint(l_reg),false,false);l_reg=__uint_as_float(rr[0])+__uint_as_float(rr[1]);}
  l_reg+=__builtin_amdgcn_exp2f(sink2-mhat);
  if(hi==0)wsf[32+r32]=l_reg;asm volatile("s_waitcnt lgkmcnt(0)":::"memory");
  float rli[16];
  #pragma unroll
  for(int r=0;r<16;++r)rli[r]=__builtin_amdgcn_rcpf(wsf[32+crow(r,hi)]);
  unsigned char*Ow=Ou+(long)(wid*QBLK)*PO;
  { unsigned char*stg=(unsigned char*)(shm+LDS_OST)+wid*4096;
    #pragma unroll
    for(int r=0;r<16;++r){const int orow=crow(r,hi); const float s32=rli[r]*32.0f;
      const int pk=__builtin_amdgcn_cvt_pk_fp8_f32(__builtin_amdgcn_fmed3f(o[0][r]*s32,-448.0f,448.0f),__builtin_amdgcn_fmed3f(o[1][r]*s32,-448.0f,448.0f),0,false);
      stg[orow*64+r32]=(unsigned char)(pk&0xff); stg[orow*64+32+r32]=(unsigned char)((pk>>8)&0xff);}
    asm volatile("s_waitcnt lgkmcnt(0)":::"memory");
    #pragma unroll
    for(int i=0;i<2;++i){const int row=i*16+(lane>>2),ch=lane&3; const u32x4 v=*(const u32x4*)(stg+row*64+ch*16); *(u32x4*)(Ow+(long)row*PO+ch*16)=v;} }
  asm volatile("s_waitcnt lgkmcnt(0)\n\ts_barrier":::"memory");
  #undef DMA_K
  #undef DMA_V
  #undef TROW
  #undef CMASK
  #undef START
  #undef RESC
  #undef ROT
}
constexpr int LDS_V2=NSLOT*SLOTB, LDS_WS2=LDS_V2+NSLOT*2*SLOTB, LDS_OST2=LDS_WS2+NW*64*4, LDS_BYTES2=LDS_OST2+NW*4096;
template<int THRL> __device__ __forceinline__ void attn_unit128(const bf16*Qu,const bf16*__restrict__ Kh,const bf16*__restrict__ Vh,bf16*Ou,int PO,int NT,char*shm){
  constexpr int MODE=0; const int wadd=0,dq0=0; (void)wadd; (void)dq0;
  int tid=threadIdx.x; asm volatile("":"+v"(tid)); const int lane=tid&63,r32=lane&31,hi=lane>>5; const int wid=__builtin_amdgcn_readfirstlane(tid>>6);
  const bf16*Qw=Qu+(long)(wid*QBLK)*P;
  const unsigned lds0=(unsigned)(uintptr_t)shm;
  float*wsf=(float*)(shm+LDS_WS2)+wid*64;
  const bf16*ksrc=Kh+(long)lane*P+wid*8;
  const bf16*vsrc=Vh+(long)(16*(wid&3)+(lane>>2))*P+(wid>>2)*32+(lane&3)*8;
  const unsigned kdst=lds0+LDS_K+wid*1024, vdst=lds0+LDS_V2+wid*1024;
  #define TROW(t) ((long)(t)*KVBLK+((MODE==1&&(t)>=4)?(long)wadd:0l))
  #define DMA_K(t,slot) glds16(ksrc+TROW(t)*P,(unsigned)__builtin_amdgcn_readfirstlane(kdst+(slot)))
  #define DMA_V(t,slot) do{ glds16(vsrc+TROW(t)*P,(unsigned)__builtin_amdgcn_readfirstlane(vdst+2*(slot))); glds16(vsrc+TROW(t)*P+64,(unsigned)__builtin_amdgcn_readfirstlane(vdst+2*(slot)+8192)); }while(0)
  const int vb0=(int)(lds0+LDS_V2)+((lane>>4)&1)*32+(lane&3)*8+(4*hi+((lane&15)>>2))*64;
  const char*Kbase=shm+LDS_K; bf16x8 kf[8];
  const lds_cptr shm3=(lds_cptr)shm; const lds_cptr kp0=shm3+LDS_K+hi*1024+r32*16; const lds_cptr vp0=shm3+LDS_V2+((lane>>4)&1)*32+(lane&3)*8+(4*hi+((lane&15)>>2))*64;
  DMA_K(0,0);DMA_V(0,0);DMA_K(1,SLOTB);
  bf16x8 qr[4];
  #pragma unroll
  for(int d0=0;d0<4;++d0)qr[d0]=*reinterpret_cast<const bf16x8*>(&Qw[(long)r32*P+d0*16+hi*8]);
  float mhat=0.f,l_reg=0.f;f32x16 o[4];o[0]=f32x16{};o[1]=f32x16{};o[2]=f32x16{};o[3]=f32x16{};f32x16 negm=f32x16{};asm volatile("":"+v"(negm));
  const int qrel=wid*QBLK+r32;
  const int dlane=dq0-qrel+4*hi;
  #define CMASK(P0,P1,t) do{ if(MODE==1){ if((t)>=4) wmask(P0,P1,dlane+64*((t)-4)); } }while(0)
  bool resc=false;
  #define START(P0,P1) do{ const float rm=rowmax(P0,P1); resc=false; \
    { const float dl=rm; mhat=fadd_s(mhat,dl); \
      _Pragma("unroll") for(int r=0;r<16;++r){P0[r]=fsub_s(P0[r],dl);P1[r]=fsub_s(P1[r],dl);} \
      _Pragma("unroll") for(int r=0;r<16;++r)negm[r]=-mhat; asm volatile("":"+v"(negm)); } \
    _Pragma("unroll") for(int r=0;r<16;++r)P0[r]=__builtin_amdgcn_exp2f(P0[r]); }while(0)
  #define RESC() do{ if(resc){ asm volatile("s_waitcnt lgkmcnt(0)":::"memory"); \
      _Pragma("unroll") for(int d_=0;d_<4;++d_) _Pragma("unroll") for(int r=0;r<16;++r)o[d_][r]*=wsf[crow(r,hi)]; } }while(0)
  f32x16 pA0,pA1,pB0,pB1;
  int sl_prev=0,sl_cur=0,sl_next=SLOTB;
  #define ROT() do{sl_prev=sl_cur;sl_cur=sl_next;sl_next=(sl_next==(NSLOT-1)*SLOTB)?0:sl_next+SLOTB;}while(0)
  DMA_K(2,2*SLOTB);
  WAIT_BAR(4);
  qkt(pA0,pA1,Kbase,qr,negm,r32,hi);asm volatile("s_nop 15\n\ts_nop 7":"+v"(pA0),"+v"(pA1));
  START(pA0,pA1);
  _Pragma("unroll") for(int r=0;r<16;++r)pA1[r]=__builtin_amdgcn_exp2f(pA1[r]);
  WAIT_BAR(0);
  DMA_K(3,0);DMA_V(1,SLOTB);
  ROT();
  kload8(kf,kp0+sl_cur);
  WAIT_BAR(3);
  s16x4 vlo[8],vhi[8]; u32x4 pw0,pw1,pw2,pw3;
  #define PKW(P,B) cvtpk_s(P[B],P[B+1])
  #define PAF(k) __builtin_bit_cast(bf16x8,pw##k)
  #define VFR(i) (bf16x8){vlo[i][0],vlo[i][1],vlo[i][2],vlo[i][3],vhi[i][0],vhi[i][1],vhi[i][2],vhi[i][3]}
  #define PIN(x) asm volatile("":"+v"(x))
  #define MX3(a,b,c) __builtin_fmaxf(__builtin_fmaxf((a),(b)),(c))
  #define GAPA(MF,A0,A1,A2,A3,W0,W1,PW) do{ MF; sacc+=A0; sacc+=A1; sacc+=A2; sacc+=A3; PIN(sacc); W0; W1; PIN(PW); SBAR(); }while(0)
  #define EX(v) __builtin_amdgcn_exp2f(v)
  #define GAPB(MF,X,B) do{ MF; X[B]=EX(X[B]); X[B+1]=EX(X[B+1]); X[B+2]=EX(X[B+2]); X[B+3]=EX(X[B+3]); PIN(X); SBAR(); }while(0)
  #define GAPH(MF,X,B) do{ MF; X[B]=EX(X[B]); X[B+1]=EX(X[B+1]); PIN(X); SBAR(); }while(0)
  #define VRD2(d,i) do{ vlo[d]=vtr(vp_+(((i)>>2)*4096+((i)&3)*1024)); vhi[d]=vtr(vp_+(((i)>>2)*4096+((i)&3)*1024+512)); }while(0)
  #define VRD(i) do{ vlo[i]=vtr(vp_+(((i)>>2)*4096+((i)&3)*1024)); vhi[i]=vtr(vp_+(((i)>>2)*4096+((i)&3)*1024+512)); }while(0)
  #define KRD(G,j) do{ if(G){ kload2(kf,kp0+sl_next,j); SBAR(); } }while(0)
  #define STEP(C0,C1,P0,P1,t,GK,GV,GL) do{ SBAR(); \
    const lds_cptr vp_=vp0+2*sl_prev; \
    VRD(0); SBAR(); float sacc=(P0[0]+P0[1]); \
    GAPA(C0=__builtin_amdgcn_mfma_f32_32x32x16_bf16(kf[0],qr[0],negm,0,0,0), P0[2],P0[3],P0[4],P0[5],     pw0[0]=PKW(P0,0), pw0[1]=PKW(P0,2), pw0); \
    VRD(4); SBAR(); GAPA(C1=__builtin_amdgcn_mfma_f32_32x32x16_bf16(kf[1],qr[0],negm,0,0,0), P0[6],P0[7],P0[8],P0[9],     pw0[2]=PKW(P0,4), pw0[3]=PKW(P0,6), pw0); \
    VRD(1); SBAR(); GAPA(C0=__builtin_amdgcn_mfma_f32_32x32x16_bf16(kf[2],qr[1],C0,0,0,0),   P0[10],P0[11],P0[12],P0[13], pw1[0]=PKW(P0,8), pw1[1]=PKW(P0,10), pw1); \
    VRD(5); SBAR(); GAPA(C1=__builtin_amdgcn_mfma_f32_32x32x16_bf16(kf[3],qr[1],C1,0,0,0),   P0[14],P0[15],P1[0],P1[1],   pw1[2]=PKW(P0,12),pw1[3]=PKW(P0,14), pw1); \
    VRD(2); SBAR(); GAPA(C0=__builtin_amdgcn_mfma_f32_32x32x16_bf16(kf[4],qr[2],C0,0,0,0),   P1[2],P1[3],P1[4],P1[5],     pw2[0]=PKW(P1,0), pw2[1]=PKW(P1,2), pw2); \
    VRD(6); SBAR(); GAPA(C1=__builtin_amdgcn_mfma_f32_32x32x16_bf16(kf[5],qr[2],C1,0,0,0),   P1[6],P1[7],P1[8],P1[9],     pw2[2]=PKW(P1,4), pw2[3]=PKW(P1,6), pw2); \
    VRD(3); SBAR(); GAPA(C0=__builtin_amdgcn_mfma_f32_32x32x16_bf16(kf[6],qr[3],C0,0,0,0),   P1[10],P1[11],P1[12],P1[13], pw3[0]=PKW(P1,8), pw3[1]=PKW(P1,10), pw3); \
    VRD(7); SBAR(); GAPA(C1=__builtin_amdgcn_mfma_f32_32x32x16_bf16(kf[7],qr[3],C1,0,0,0),   P1[14],P1[15],0.f,0.f,       pw3[2]=PKW(P1,12),pw3[3]=PKW(P1,14), pw3); \
    l_reg+=sacc; \
    if(GK){DMA_K((t)+3,sl_cur);} if(GV){DMA_V((t)+1,sl_next);} \
    CMASK(C0,C1,t); \
    { float a=MX3(C0[0],C0[1],C1[0]),b=MX3(C0[2],C0[3],C1[1]); a=MX3(a,C1[2],C1[3]); \
      _Pragma("unroll") for(int r=4;r<16;r+=4){a=MX3(a,C0[r],C0[r+1]);b=MX3(b,C0[r+2],C0[r+3]);a=MX3(a,C1[r],C1[r+1]);b=MX3(b,C1[r+2],C1[r+3]);} \
      float rm=__builtin_fmaxf(a,b); { auto rr=__builtin_amdgcn_permlane32_swap(__float_as_uint(rm),__float_as_uint(rm),false,false); rm=__builtin_fmaxf(__uint_as_float(rr[0]),__uint_as_float(rr[1])); } \
      resc=false; \
      if(__builtin_expect(__any(rm>(float)THRL),0)){ const float dl=__builtin_fmaxf(rm,0.f); mhat+=dl; \
        _Pragma("unroll") for(int r=0;r<16;++r){C0[r]-=dl;C1[r]-=dl;} \
        _Pragma("unroll") for(int r=0;r<16;++r)negm[r]=-mhat; asm volatile("":"+v"(negm)); \
        const float f=__builtin_amdgcn_exp2f(-dl); l_reg*=f; if(hi==0)wsf[r32]=f; resc=true; } } \
    SBAR(); \
    GAPH(o[0]=__builtin_amdgcn_mfma_f32_32x32x16_bf16(PAF(0),VFR(0),o[0],0,0,0), C0,0);  VRD2(0,8);  SBAR(); \
    GAPH(o[1]=__builtin_amdgcn_mfma_f32_32x32x16_bf16(PAF(0),VFR(4),o[1],0,0,0), C0,2);  VRD2(4,12); SBAR(); \
    GAPH(o[0]=__builtin_amdgcn_mfma_f32_32x32x16_bf16(PAF(1),VFR(1),o[0],0,0,0), C0,4);  VRD2(1,9);  SBAR(); \
    GAPH(o[1]=__builtin_amdgcn_mfma_f32_32x32x16_bf16(PAF(1),VFR(5),o[1],0,0,0), C0,6);  VRD2(5,13); SBAR(); \
    GAPH(o[0]=__builtin_amdgcn_mfma_f32_32x32x16_bf16(PAF(2),VFR(2),o[0],0,0,0), C0,8);  VRD2(2,10); SBAR(); \
    GAPH(o[1]=__builtin_amdgcn_mfma_f32_32x32x16_bf16(PAF(2),VFR(6),o[1],0,0,0), C0,10); VRD2(6,14); SBAR(); \
    GAPH(o[0]=__builtin_amdgcn_mfma_f32_32x32x16_bf16(PAF(3),VFR(3),o[0],0,0,0), C0,12); VRD2(3,11); SBAR(); \
    GAPH(o[1]=__builtin_amdgcn_mfma_f32_32x32x16_bf16(PAF(3),VFR(7),o[1],0,0,0), C0,14); VRD2(7,15); SBAR(); \
    GAPH(o[2]=__builtin_amdgcn_mfma_f32_32x32x16_bf16(PAF(0),VFR(0),o[2],0,0,0), C1,0); \
    GAPH(o[3]=__builtin_amdgcn_mfma_f32_32x32x16_bf16(PAF(0),VFR(4),o[3],0,0,0), C1,2); \
    KRD(GL,0); GAPH(o[2]=__builtin_amdgcn_mfma_f32_32x32x16_bf16(PAF(1),VFR(1),o[2],0,0,0), C1,4); \
    KRD(GL,1); GAPH(o[3]=__builtin_amdgcn_mfma_f32_32x32x16_bf16(PAF(1),VFR(5),o[3],0,0,0), C1,6); \
    KRD(GL,2); GAPH(o[2]=__builtin_amdgcn_mfma_f32_32x32x16_bf16(PAF(2),VFR(2),o[2],0,0,0), C1,8); \
    KRD(GL,3); GAPH(o[3]=__builtin_amdgcn_mfma_f32_32x32x16_bf16(PAF(2),VFR(6),o[3],0,0,0), C1,10); \
    GAPH(o[2]=__builtin_amdgcn_mfma_f32_32x32x16_bf16(PAF(3),VFR(3),o[2],0,0,0), C1,12); \
    GAPH(o[3]=__builtin_amdgcn_mfma_f32_32x32x16_bf16(PAF(3),VFR(7),o[3],0,0,0), C1,14); \
    }while(0)
  int t=1;
  if(MODE==0){
    for(;t+5<NT;t+=2){
      STEP(pB0,pB1,pA0,pA1,t,true,true,true);     WAIT_BAR(3); RESC(); ROT();
      STEP(pA0,pA1,pB0,pB1,t+1,true,true,true);   WAIT_BAR(3); RESC(); ROT();
    }
  }
  #define ENDW(tt) do{ if((tt)+3<NT){WAIT_BAR(3);} else if((tt)+2<NT){WAIT_BAR(2);} else {WAIT_BAR(0);} }while(0)
  for(;t+1<NT;t+=2){
    STEP(pB0,pB1,pA0,pA1,t,(t+3<NT),(t+1<NT),(t+1<NT));       ENDW(t);   RESC(); ROT();
    STEP(pA0,pA1,pB0,pB1,t+1,(t+4<NT),(t+2<NT),(t+2<NT));     ENDW(t+1); RESC(); ROT();
  }
  STEP(pB0,pB1,pA0,pA1,NT-1,false,false,false); RESC();
  { float sacc=pB0[0]+pB0[1]; _Pragma("unroll") for(int r=2;r<16;++r)sacc+=pB0[r]; _Pragma("unroll") for(int r=0;r<16;++r)sacc+=pB1[r]; l_reg+=sacc;
    pw0=(u32x4){PKW(pB0,0),PKW(pB0,2),PKW(pB0,4),PKW(pB0,6)};pw1=(u32x4){PKW(pB0,8),PKW(pB0,10),PKW(pB0,12),PKW(pB0,14)};pw2=(u32x4){PKW(pB1,0),PKW(pB1,2),PKW(pB1,4),PKW(pB1,6)};pw3=(u32x4){PKW(pB1,8),PKW(pB1,10),PKW(pB1,12),PKW(pB1,14)};
    SBAR(); pv(o,vb0+2*sl_cur,PAF(0),PAF(1),PAF(2),PAF(3)); pv(o+2,vb0+2*sl_cur+8192,PAF(0),PAF(1),PAF(2),PAF(3)); }
  #undef PKW
  #undef PAF
  #undef VFR
  #undef PIN
  #undef MX3
  #undef GAPA
  #undef GAPB
  #undef GAPH
  #undef VRD2
  #undef EX
  #undef VRD
  #undef KRD
  #undef STEP
  #undef ENDW
  {auto rr=__builtin_amdgcn_permlane32_swap(__float_as_uint(l_reg),__float_as_uint(l_reg),false,false);l_reg=__uint_as_float(rr[0])+__uint_as_float(rr[1]);}
  if(hi==0)wsf[32+r32]=l_reg;asm volatile("s_waitcnt lgkmcnt(0)":::"memory");
  float rli[16];
  #pragma unroll
  for(int r=0;r<16;++r)rli[r]=__builtin_amdgcn_rcpf(wsf[32+crow(r,hi)]);
  bf16*Ow=Ou+(long)(wid*QBLK)*PO;
  { bf16*stg=(bf16*)(shm+LDS_OST2)+wid*2048;
    #pragma unroll
    for(int hp=0;hp<2;++hp){
      #pragma unroll
      for(int r=0;r<16;++r){const int orow=crow(r,hi);
        #pragma unroll
        for(int d0=0;d0<2;++d0)stg[orow*64+d0*32+r32]=__float2bfloat16(o[2*hp+d0][r]*rli[r]);}
      asm volatile("s_waitcnt lgkmcnt(0)":::"memory");
      #pragma unroll
      for(int i=0;i<4;++i){const int row=i*8+(lane>>3),ch=lane&7; const u32x4 v=*(const u32x4*)(stg+row*64+ch*8); *(u32x4*)(Ow+(long)row*PO+hp*64+ch*8)=v;}
      asm volatile("s_waitcnt lgkmcnt(0)":::"memory"); } }
  asm volatile("s_waitcnt lgkmcnt(0)\n\ts_barrier":::"memory");
  #undef DMA_K
  #undef DMA_V
  #undef TROW
  #undef CMASK
  #undef START
  #undef RESC
  #undef ROT
}
static_assert(LDS_BYTES2<=131072,"attention LDS");
constexpr int ATTN_LDS_BYTES=LDS_BYTES;
#undef SBAR
#undef WAIT_BAR
}
constexpr int NWAVES = 8;
constexpr int NB = 8, SEQ = 8192, TCTX = 256, RB = SEQ + TCTX  , R = NB * RB  ;
constexpr int D = 1024, NL = 4, NPAN = R / 256  , QKVW = 3072;
constexpr int NE = 128, TOPK = 8, CAP = R  , MAXTILES = 2240, MAXSLOTS = MAXTILES * 256;
constexpr float EPS = 1e-6f, LOG2E = 1.4426950408889634f, WG8_SCALE = 64.0f; constexpr int W8_EXP = 127 - 3;
constexpr int PH_PER_LAYER = 13, NPH = 2 + NL * PH_PER_LAYER;
enum { I_X = 0, I_C, I_CTX, I_CCTX, I_WMOD, I_BMOD, I_G1, I_WQKV, I_GQA, I_GKA, I_SINK, I_LQ1, I_LK1, I_LQ2, I_LK2, I_GSUB, I_WBRA, I_WBRB, I_WBRC, I_WGATE, I_BGATE, I_WOUT, I_G2, I_WR, I_EBIAS,
       I_W1, I_W3, I_W2, I_WS1, I_WS3, I_WS2, I_GF, N_IN };

constexpr size_t MiB = 1u << 20;
constexpr size_t WS_CTL = 0, CTL_ZERO_BYTES = 1 * MiB;
constexpr size_t WS_MOD = 1 * MiB;
constexpr size_t WS_LAYP = WS_MOD + 960 * 1024;
constexpr size_t WS_ROPE = 2 * MiB;
constexpr size_t WS_WSM = 4 * MiB, WSM_LAYER = 19 * MiB;
constexpr size_t WL_QKV = 0, WL_GATE = 6 * MiB, WL_BR = 12 * MiB, WL_OUT = 15 * MiB, WL_R = 17 * MiB, WL_S13 = 17 * MiB + 512 * 1024, WL_S2 = 18 * MiB + 512 * 1024;
constexpr size_t WS_E13 = 80 * MiB;
constexpr size_t WS_E2 = 208 * MiB;
constexpr size_t WS_XC = 272 * MiB;
constexpr size_t WS_A = 280 * MiB;
constexpr size_t WS_HS = 412 * MiB;
constexpr size_t WS_HR = 445 * MiB;
constexpr size_t WS_XB = 588 * MiB;
constexpr size_t WS_LIST = 725 * MiB;
constexpr size_t WS_EP = 758 * MiB;
constexpr size_t WS_WT = 761 * MiB;
constexpr size_t WS_LOG = 764 * MiB;
constexpr size_t WS_DBG = 797 * MiB;
constexpr size_t WS_YR = 800 * MiB;
constexpr size_t WS_YS = 1400 * MiB;
constexpr size_t WS_QKV = 800 * MiB;
constexpr size_t WS_YA = 1196 * MiB, WS_YB = 1229 * MiB, WS_YC = 1262 * MiB;
constexpr size_t WS_MG8 = 1295 * MiB;
constexpr size_t WS_OC = 1394 * MiB;
constexpr size_t WS_MG = 1526 * MiB;
constexpr size_t WS_WR2 = 1920 * MiB, WR2_LAYER = 1536 * 1024;
constexpr size_t WS_A8 = 1926 * MiB;
constexpr size_t WS_WG8 = 1992 * MiB, WG8_LAYER = 3 * MiB;
constexpr size_t WS_WQ8 = 2004 * MiB;
constexpr size_t WS_WS8 = 2016 * MiB, WS8_LAYER = 512 * 1024;
constexpr size_t WS_END = 2018 * MiB;
static_assert(WS_YR + (size_t)MAXSLOTS * 2048 <= WS_END && WS_MG + (size_t)R * 2048 <= WS_END && WS_HR + (size_t)MAXSLOTS * 256 <= WS_XB && WS_XB + (size_t)R * 2048 <= WS_LIST && WS_A + (size_t)R * 2048 <= WS_HS, "d_ws map");
constexpr int CW_BAR = 4096;
constexpr int CW_CNT = 16384, CNT_STRIDE = 64;
constexpr int CW_ERR = 65536;

constexpr int RING_OFF = 0, RING_BYTES = 131072;
constexpr int LDSCTL_OFF = RING_BYTES, MISC_OFF = LDSCTL_OFF + 320;
constexpr int MOE_OFF = LDSCTL_OFF + 512;
constexpr int ROPE1_OFF = LDSCTL_OFF + 6144;
constexpr int LDS_BYTES = 147456;
static_assert(MOE_OFF + 132 * 4 + 128 * 4 + MAXTILES * 2 <= LDS_BYTES && attn_body::ATTN_LDS_BYTES <= RING_BYTES, "LDS map");

#define GAS __attribute__((address_space(1)))
#define LAS __attribute__((address_space(3)))
typedef unsigned short bf16;
typedef unsigned v4u __attribute__((ext_vector_type(4)));
typedef unsigned v2u __attribute__((ext_vector_type(2)));
typedef float f32x4 __attribute__((ext_vector_type(4)));
typedef float f32x2 __attribute__((ext_vector_type(2)));
typedef GAS unsigned gu32;
#define RLX_AGENT __ATOMIC_RELAXED, __HIP_MEMORY_SCOPE_AGENT
#define LDS_WAIT() asm volatile("s_waitcnt lgkmcnt(0)" ::: "memory")
#define VM_WAIT() asm volatile("s_waitcnt vmcnt(0)" ::: "memory")
__device__ __forceinline__ unsigned f2bf(float f) { unsigned u = __builtin_bit_cast(unsigned, f); return (u + 0x7fffu + ((u >> 16) & 1u)) >> 16; }
__device__ __forceinline__ unsigned pk2(float lo, float hi) { return f2bf(lo) | (f2bf(hi) << 16); }
__device__ __forceinline__ float bflo(unsigned w) { return __builtin_bit_cast(float, w << 16); }
__device__ __forceinline__ float bfhi(unsigned w) { return __builtin_bit_cast(float, w & 0xffff0000u); }

#define XB_TMO      128
#define XB_XCNT(j)  (256  + 64 * (j))
#define XB_XSUB(j)  (1280 + 64 * (j))
#define XB_XGEN(j)  (2304 + 64 * (j))
#define XB_TOP      3328
#define XB_TOPGEN   3392
#define XCD_BAR_WORDS 3456
#define XB_SPIN_CAP (1u << 22)

__device__ __forceinline__ unsigned xb_ld(unsigned* p)              { return __hip_atomic_load(p, __ATOMIC_RELAXED, __HIP_MEMORY_SCOPE_AGENT); }
__device__ __forceinline__ unsigned xb_add(unsigned* p, unsigned v) { return __hip_atomic_fetch_add(p, v, __ATOMIC_RELAXED, __HIP_MEMORY_SCOPE_AGENT); }
__device__ __forceinline__ unsigned xb_xcc_id() { return (unsigned)__builtin_amdgcn_s_getreg((3 << 11) | 20) & 0xFu; }
#define XB_SPIN(cond, bar) do { unsigned _sp = 0; while (cond) { __builtin_amdgcn_s_sleep(1); \
    if ((++_sp & 255u) == 0u) { if (xb_ld(&(bar)[XB_TMO])) break; if (_sp > XB_SPIN_CAP) { atomicAdd(&(bar)[XB_TMO], 1u); break; } } } } while (0)

struct XcdBarrier {
    unsigned* bar; unsigned x;
    volatile LAS unsigned* st;
};
__device__ __forceinline__ XcdBarrier xcd_barrier_post(unsigned* bar, volatile LAS unsigned* st) {
    XcdBarrier b; b.bar = bar; b.x = xb_xcc_id(); b.st = st;
    if (threadIdx.x == 0) (void)xb_add(&bar[XB_XCNT(b.x)], 1u);
    return b;
}
__device__ __forceinline__ void xcd_barrier_complete(unsigned* bar, unsigned x, unsigned& nloc, unsigned& nx) {
    const unsigned G = gridDim.x * gridDim.y * gridDim.z;
    unsigned sum, cnt, mine, sp = 0u;
    for (;;) {
        sum = 0u; cnt = 0u; mine = 0u;
#pragma unroll
        for (unsigned j = 0; j < 16; ++j) { const unsigned c = xb_ld(&bar[XB_XCNT(j)]); sum += c; cnt += (c > 0u) ? 1u : 0u; mine = (j == x) ? c : mine; }
        if (sum == G) break;
        __builtin_amdgcn_s_sleep(1);
        if ((++sp & 255u) == 0u) { if (xb_ld(&bar[XB_TMO])) break; if (sp > XB_SPIN_CAP) { atomicAdd(&bar[XB_TMO], 1u); break; } }
    }
    nloc = mine > 0u ? mine : 1u; nx = cnt > 0u ? cnt : 1u;
}
__device__ __forceinline__ void xcd_barrier(const XcdBarrier& b) {
    asm volatile("s_waitcnt vmcnt(0)" ::: "memory");
    __syncthreads();
    if (threadIdx.x == 0) {
        unsigned* bar = b.bar;
        __builtin_amdgcn_s_waitcnt(0);
        unsigned nloc = b.st[0], nx = b.st[1];
        if (nloc == 0u) { xcd_barrier_complete(bar, b.x, nloc, nx); b.st[0] = nloc; b.st[1] = nx; }
        const unsigned old = xb_add(&bar[XB_XSUB(b.x)], 1u);
        const unsigned gen = old / nloc;
        if (old + 1u == (gen + 1u) * nloc) {
            __builtin_amdgcn_fence(__ATOMIC_RELEASE, "agent");
            asm volatile("s_waitcnt vmcnt(0)" ::: "memory");
            const unsigned og = xb_add(&bar[XB_TOP], 1u);
            const unsigned tg = og / nx;
            if (og + 1u == (tg + 1u) * nx) xb_add(&bar[XB_TOPGEN], 1u);
            else XB_SPIN(xb_ld(&bar[XB_TOPGEN]) == tg, bar);
            __builtin_amdgcn_fence(__ATOMIC_ACQUIRE, "agent");
            xb_add(&bar[XB_XGEN(b.x)], 1u);
            asm volatile("s_waitcnt vmcnt(0)" ::: "memory");
        } else {
            XB_SPIN(xb_ld(&bar[XB_XGEN(b.x)]) == gen, bar);
            __builtin_amdgcn_fence(__ATOMIC_ACQUIRE, "agent");
            asm volatile("s_waitcnt vmcnt(0)" ::: "memory");
        }
    }
    __syncthreads();
}

struct Args { const float* in[N_IN]; float* out; unsigned char* ws; int ph_lo, ph_hi; };
typedef const __attribute__((address_space(4))) Args* KArgs;

template <int M> __device__ __forceinline__ float xor_f(float v) { static_assert(M >= 1 && M < 32, "xor within 32 lanes"); return __builtin_bit_cast(float, __builtin_amdgcn_ds_swizzle(__builtin_bit_cast(int, v), (M << 10) | 0x1f)); }
__device__ __forceinline__ float half_other(float v, float& own) { const unsigned a = __builtin_bit_cast(unsigned, v); auto rr = __builtin_amdgcn_permlane32_swap(a, a, false, false); const unsigned r0 = rr[0], r1 = rr[1]; own = __uint_as_float(r0); return __uint_as_float(r1); }
__device__ __forceinline__ float lane_f(float v, int src) { return __builtin_bit_cast(float, __builtin_amdgcn_readlane(__builtin_bit_cast(int, v), src)); }
__device__ __forceinline__ int lane_i(int v, int src) { return __builtin_amdgcn_readlane(v, src); }
template <int CTRL> __device__ __forceinline__ float dpp_f(float v) { return __builtin_bit_cast(float, __builtin_amdgcn_update_dpp(__builtin_bit_cast(int, v), __builtin_bit_cast(int, v), CTRL, 0xf, 0xf, false)); }
__device__ __forceinline__ float row16_sum(float v) { v += dpp_f<0xB1>(v); v += dpp_f<0x4E>(v); v += dpp_f<0x141>(v); v += dpp_f<0x140>(v); return v; }
__device__ __forceinline__ float row16_max(float v) { v = fmaxf(v, dpp_f<0xB1>(v)); v = fmaxf(v, dpp_f<0x4E>(v)); v = fmaxf(v, dpp_f<0x141>(v)); v = fmaxf(v, dpp_f<0x140>(v)); return v; }
__device__ __forceinline__ float wave_sum(float v) {
    v = row16_sum(v); return (lane_f(v, 0) + lane_f(v, 16)) + (lane_f(v, 32) + lane_f(v, 48));
}
__device__ __forceinline__ float wave_max(float v) {
    v = row16_max(v); return fmaxf(fmaxf(lane_f(v, 0), lane_f(v, 16)), fmaxf(lane_f(v, 32), lane_f(v, 48)));
}
__device__ __forceinline__ float* xrow_ptr(float* XL, float* XC, int r) { const int b = r / RB, j = r - b * RB; return (j < TCTX) ? XC + ((size_t)b * TCTX + j) * D : XL + ((size_t)b * SEQ + (j - TCTX)) * D; }

template <int RMAP> __device__ __forceinline__ void tr_block(const float* W, int ldw, int k0, int n0, bf16* WT, int ldt, int drow0, LAS float* scr, int lane) {
    const int c4 = lane & 7, kr = lane >> 3;
    f32x4 t[8];
#pragma unroll
    for (int i = 0; i < 8; ++i) t[i] = __builtin_nontemporal_load((const GAS f32x4*)(W + (size_t)(k0 + 8 * i + kr) * ldw + n0 + 4 * c4));
#pragma unroll
    for (int i = 0; i < 8; ++i) { LAS float* d = scr + (8 * i + kr) * 33 + 4 * c4; d[0] = t[i].x; d[1] = t[i].y; d[2] = t[i].z; d[3] = t[i].w; }
    LDS_WAIT(); asm volatile("" ::: "memory");
    const int c = lane & 7;
#pragma unroll
    for (int j = 0; j < 4; ++j) { const int n = (lane >> 3) + 8 * j; const LAS float* s = scr + (8 * c) * 33 + n;
        v4u o; o.x = pk2(s[0 * 33], s[1 * 33]); o.y = pk2(s[2 * 33], s[3 * 33]); o.z = pk2(s[4 * 33], s[5 * 33]); o.w = pk2(s[6 * 33], s[7 * 33]);
        const int drow = (RMAP == 3) ? drow0 + 128 * ((n >> 3) & 1) + 8 * ((n >> 4) & 1) + (n & 7) : drow0 + n;
        *(GAS v4u*)(WT + (size_t)drow * ldt + k0 + 8 * c) = o; }
    LDS_WAIT(); asm volatile("" ::: "memory");
}
__device__ __forceinline__ void tr_block_split(const float* W, int ldw, int k0, int n0, bf16* WT, LAS float* scr, int lane) {
#pragma unroll 8
    for (int i = 0; i < 32; ++i) { const int kk = 2 * i + (lane >> 5); scr[kk * 33 + (lane & 31)] = W[(size_t)(k0 + kk) * ldw + n0 + (lane & 31)]; }
    LDS_WAIT(); asm volatile("" ::: "memory");
    const int c = lane & 7;
#pragma unroll
    for (int j = 0; j < 4; ++j) { const int n = (lane >> 3) + 8 * j; const LAS float* s = scr + (8 * c) * 33 + n;
        float w[8], lo[8];
#pragma unroll
        for (int q = 0; q < 8; ++q) { w[q] = s[q * 33]; lo[q] = w[q] - __builtin_bit_cast(float, f2bf(w[q]) << 16); }
        const v4u oh = (v4u){pk2(w[0], w[1]), pk2(w[2], w[3]), pk2(w[4], w[5]), pk2(w[6], w[7])}, ol = (v4u){pk2(lo[0], lo[1]), pk2(lo[2], lo[3]), pk2(lo[4], lo[5]), pk2(lo[6], lo[7])};
        bf16* row = WT + (size_t)(n0 + n) * 3072 + k0 + 8 * c;
        *(GAS v4u*)(row) = oh; *(GAS v4u*)(row + 1024) = ol; *(GAS v4u*)(row + 2048) = oh; }
    LDS_WAIT(); asm volatile("" ::: "memory");
}
template <int RMAP = 0> __device__ __forceinline__ void tr_block8(const float* W, int ldw, int k0, int n0, unsigned char* WT8, int ldt8, int drow0, float scale, LAS float* scr, int lane) {
    const int c4 = lane & 7, kr = lane >> 3;
    f32x4 t[8];
#pragma unroll
    for (int i = 0; i < 8; ++i) t[i] = *(const GAS f32x4*)(W + (size_t)(k0 + 8 * i + kr) * ldw + n0 + 4 * c4);
#pragma unroll
    for (int i = 0; i < 8; ++i) { LAS float* d = scr + (8 * i + kr) * 33 + 4 * c4; d[0] = t[i].x; d[1] = t[i].y; d[2] = t[i].z; d[3] = t[i].w; }
    LDS_WAIT(); asm volatile("" ::: "memory");
    const int c = lane & 7;
#pragma unroll
    for (int j = 0; j < 4; ++j) { const int n = (lane >> 3) + 8 * j; const LAS float* sp = scr + (8 * c) * 33 + n;
        int p0 = __builtin_amdgcn_cvt_pk_fp8_f32(sp[0 * 33] * scale, sp[1 * 33] * scale, 0, false); p0 = __builtin_amdgcn_cvt_pk_fp8_f32(sp[2 * 33] * scale, sp[3 * 33] * scale, p0, true);
        int p1 = __builtin_amdgcn_cvt_pk_fp8_f32(sp[4 * 33] * scale, sp[5 * 33] * scale, 0, false); p1 = __builtin_amdgcn_cvt_pk_fp8_f32(sp[6 * 33] * scale, sp[7 * 33] * scale, p1, true);
        const int drow = (RMAP == 3) ? drow0 + 128 * ((n >> 3) & 1) + 8 * ((n >> 4) & 1) + (n & 7) : drow0 + n;
        *(GAS v2u*)(WT8 + (size_t)drow * ldt8 + k0 + 8 * c) = (v2u){(unsigned)p0, (unsigned)p1}; }
    LDS_WAIT(); asm volatile("" ::: "memory");
}
template <int MAP> __device__ __forceinline__ void tr_item(const float* W, int K, int N, bf16* WT, int row_off, int item, LAS float* scr, int lane) {
    const int nblk = N / 32, kb = item / nblk, nb = item - kb * nblk, k0 = 64 * kb, n0 = 32 * nb;
    const int drow0 = (MAP == 0) ? row_off + n0 : (MAP == 1) ? (n0 >> 7) * 256 + (n0 & 127) + row_off
                    : (MAP == 2) ? (n0 & ~255) + 128 * ((n0 >> 5) & 1) + 32 * ((n0 >> 6) & 3)
                                 : (n0 & ~255) + 32 * ((n0 >> 6) & 3) + 16 * ((n0 >> 5) & 1);
    tr_block<MAP == 3 ? 3 : 0>(W, N, k0, n0, WT, K, drow0, scr, lane);
}

#define PHASE_IDS() int tid_ = threadIdx.x; asm volatile("" : "+v"(tid_)); const int lane = tid_ & 63, wave = __builtin_amdgcn_readfirstlane(tid_ >> 6); const int G = gridDim.x, bx = blockIdx.x; \
    const int vcu = (G % 8 == 0) ? (bx % 8) * (G / 8) + bx / 8 : bx; const int gw = vcu * NWAVES + wave, NGW = G * NWAVES; (void)lane; (void)wave; (void)gw; (void)NGW; (void)vcu
__device__ __forceinline__ void phase_prologue(KArgs a, LAS unsigned char* lds) {
    PHASE_IDS();
    unsigned char* ws = a->ws;
    LAS float* scr = (LAS float*)(lds + RING_OFF + wave * 16384);
    constexpr int I_QKV = 16 * 96, I_GATE = 16 * 96, I_BR = 8 * 32, I_OUT = 16 * 32, I_R = 16 * 4, I_S1 = 16 * 8, I_S2 = 4 * 32;
    constexpr int PER_L = I_QKV + I_GATE + 3 * I_BR + I_OUT + I_R + 2 * I_S1 + I_S2;
    for (int it = gw; it < NL * PER_L; it += NGW) {
        const int l = it / PER_L; int r = it - l * PER_L; unsigned char* wl = ws + WS_WSM + (size_t)l * WSM_LAYER;
        if (r < I_QKV) { const int kb = r / 96, nb = r - kb * 96, n0 = 32 * nb; const int drow0 = (n0 & ~255) + 128 * ((n0 >> 5) & 1) + 32 * ((n0 >> 6) & 3);
            tr_block8(a->in[I_WQKV] + (size_t)l * D * QKVW, QKVW, 64 * kb, n0, ws + WS_WQ8 + (size_t)l * WG8_LAYER, D, drow0, WG8_SCALE, scr, lane); continue; } r -= I_QKV;
        if (r < I_GATE) { const int kb = r / 96, nb = r - kb * 96; tr_block8(a->in[I_WGATE] + (size_t)l * D * 3072, 3072, 64 * kb, 32 * nb, ws + WS_WG8 + (size_t)l * WG8_LAYER, D, 32 * nb, WG8_SCALE, scr, lane); continue; } r -= I_GATE;
        if (r < I_BR) { const int kb = r / 32, n0 = 32 * (r - kb * 32); tr_block8(a->in[I_WBRA] + (size_t)l * 512 * D, D, 64 * kb, n0, wl + WL_BR, 512, n0, 32.0f * (256.0f / 255.0f), scr, lane); continue; } r -= I_BR;
        if (r < I_BR) { const int kb = r / 32, n0 = 32 * (r - kb * 32); tr_block8(a->in[I_WBRB] + (size_t)l * 512 * D, D, 64 * kb, n0, wl + WL_BR + 1 * MiB, 512, n0, 32.0f * (256.0f / 255.0f), scr, lane); continue; } r -= I_BR;
        if (r < I_BR) { const int kb = r / 32, n0 = 32 * (r - kb * 32); tr_block8(a->in[I_WBRC] + (size_t)l * 512 * D, D, 64 * kb, n0, wl + WL_BR + 2 * MiB, 512, n0, 64.0f * (256.0f / 255.0f), scr, lane); continue; } r -= I_BR;
        if (r < I_OUT) { const int kb = r / 32, n0 = 32 * (r - kb * 32); tr_block8(a->in[I_WOUT] + (size_t)l * D * D, D, 64 * kb, n0, wl + WL_OUT, D, n0, WG8_SCALE, scr, lane); continue; } r -= I_OUT;
        if (r < I_R) { tr_item<0>(a->in[I_WR] + (size_t)l * D * NE, D, NE, (bf16*)(wl + WL_R), 0, r, scr, lane); continue; } r -= I_R;
        if (r < I_S1) { const int kb = r / 8, n0 = 32 * (r - kb * 8); tr_block8(a->in[I_WS1] + (size_t)l * D * 256, 256, 64 * kb, n0, ws + WS_WS8 + (size_t)l * WS8_LAYER, D, (n0 >> 7) * 256 + (n0 & 127), WG8_SCALE, scr, lane); continue; } r -= I_S1;
        if (r < I_S1) { const int kb = r / 8, n0 = 32 * (r - kb * 8); tr_block8(a->in[I_WS3] + (size_t)l * D * 256, 256, 64 * kb, n0, ws + WS_WS8 + (size_t)l * WS8_LAYER, D, (n0 >> 7) * 256 + (n0 & 127) + 128, WG8_SCALE, scr, lane); continue; } r -= I_S1;
        { const int kb = r / 32, n0 = 32 * (r - kb * 32); tr_block8<3>(a->in[I_WS2] + (size_t)l * 256 * D, D, 64 * kb, n0, wl + WL_S2, 256, (n0 & ~255) + 32 * ((n0 >> 6) & 3) + 16 * ((n0 >> 5) & 1), 32.0f, scr, lane); }
    }
    for (int it = gw; it < NL * 128; it += NGW) { const int l = it >> 7, row = 128 + (it & 127); GAS v4u* p = (GAS v4u*)(ws + WS_WSM + (size_t)l * WSM_LAYER + WL_R + (size_t)row * 2048);
        p[lane] = (v4u){0u, 0u, 0u, 0u}; p[64 + lane] = (v4u){0u, 0u, 0u, 0u}; }
    { f32x2* rope = (f32x2*)(ws + WS_ROPE);
      for (int i = gw * 64 + lane; i < SEQ * 32; i += NGW * 64) { const int t = i >> 5, ax = (i >> 4) & 1, f = i & 15;
          const float pos = (float)(ax == 0 ? (t >> 6) : (t & 63)); const float invf = powf(10000.0f, -(float)f / 16.0f); const float ang = pos * invf;
          rope[i] = (f32x2){(float)cos((double)ang), (float)sin((double)ang)}; } }
    if (gw == 0 && lane < NL) { const int l = lane; float d1 = 0.f, d2 = 0.f;
        for (int i = 0; i < 64; ++i) { d1 += a->in[I_LQ1][l * 64 + i] * a->in[I_LK1][l * 64 + i]; d2 += a->in[I_LQ2][l * 64 + i] * a->in[I_LK2][l * 64 + i]; }
        const float li = 0.8f - 0.6f * expf(-0.3f * (float)l); float* lp = (float*)(ws + WS_LAYP) + l * 4;
        lp[0] = expf(d1) - expf(d2) + li; lp[1] = li; lp[2] = 1.0f - li; lp[3] = 0.f; }
    __syncthreads();
    { LAS float* sl = (LAS float*)(lds + RING_OFF);
      LAS float* red = sl + 9 * 1024;
      float* MOD = (float*)(ws + WS_MOD);
      for (int i = threadIdx.x; i < 9 * 1024; i += NWAVES * 64) { const int m = i >> 10, k = i & 1023; const float cv = (m < 8) ? a->in[I_C][m * D + k] : a->in[I_CCTX][k]; sl[i] = cv / (1.0f + expf(-cv)); }
      __syncthreads();
      for (int item = blockIdx.x; item < NL * 96; item += gridDim.x) {
          const int l = item / 96, n0 = (item - l * 96) * 64;
          float acc[9];
#pragma unroll
          for (int m = 0; m < 9; ++m) acc[m] = 0.f;
          const float* wm = a->in[I_WMOD] + (size_t)l * D * 6144 + n0 + lane;
#pragma unroll 8
          for (int kk = 0; kk < 128; ++kk) { const int k = wave * 128 + kk; const float w = wm[(size_t)k * 6144];
#pragma unroll
              for (int m = 0; m < 9; ++m) acc[m] += sl[m * 1024 + k] * w; }
#pragma unroll
          for (int m = 0; m < 9; ++m) red[(wave * 9 + m) * 64 + lane] = acc[m];
          __syncthreads();
          for (int idx = threadIdx.x; idx < 9 * 64; idx += NWAVES * 64) { const int m = idx >> 6, ln = idx & 63; float s = 0.f;
#pragma unroll
              for (int w = 0; w < 8; ++w) s += red[(w * 9 + m) * 64 + ln];
              MOD[((size_t)l * 9 + m) * 6144 + n0 + ln] = s + a->in[I_BMOD][l * 6144 + n0 + ln]; }
          __syncthreads();
      } }
}

__device__ __forceinline__ void moe_tables(LAS unsigned char* lds, const unsigned* cnt, bool want_te) {
    LAS int* tb = (LAS int*)(lds + MOE_OFF); LAS int* cn = tb + 132; LAS unsigned short* te = (LAS unsigned short*)(cn + 128);
    int tid = threadIdx.x; asm volatile("" : "+v"(tid));
    __syncthreads();
    if (tid < NE) cn[tid] = (int)__hip_atomic_load(cnt + tid * CNT_STRIDE, RLX_AGENT);
    __syncthreads();
    if (tid == 0) { int s = 0; for (int e = 0; e < NE; ++e) { tb[e] = s; s += (cn[e] + 255) >> 8; } tb[NE] = s; }
    __syncthreads();
    if (want_te && tid < NE) { const int t0 = tb[tid], t1 = tb[tid + 1]; for (int t = t0; t < t1; ++t) te[t] = (unsigned short)tid; }
    __syncthreads();
}

__device__ __forceinline__ void ld16f(const float* p, int lane, f32x4 (&v)[4]) { const GAS f32x4* q = (const GAS f32x4*)p + 4 * lane; v[0] = q[0]; v[1] = q[1]; v[2] = q[2]; v[3] = q[3]; }
__device__ __forceinline__ void st16f(float* p, int lane, const f32x4 (&v)[4]) { GAS f32x4* q = (GAS f32x4*)p + 4 * lane; q[0] = v[0]; q[1] = v[1]; q[2] = v[2]; q[3] = v[3]; }
__device__ __forceinline__ void unpk8(const v4u u, f32x4& a, f32x4& b) { a = (f32x4){bflo(u.x), bfhi(u.x), bflo(u.y), bfhi(u.y)}; b = (f32x4){bflo(u.z), bfhi(u.z), bflo(u.w), bfhi(u.w)}; }
__device__ __forceinline__ v4u pk8(const f32x4 a, const f32x4 b) { return (v4u){pk2(a.x, a.y), pk2(a.z, a.w), pk2(b.x, b.y), pk2(b.z, b.w)}; }
__device__ __forceinline__ void ld16b(const bf16* p, int lane, f32x4 (&v)[4]) { const GAS v4u* q = (const GAS v4u*)p + 2 * lane; const v4u a = q[0], b = q[1]; unpk8(a, v[0], v[1]); unpk8(b, v[2], v[3]); }
__device__ __forceinline__ void st16b(bf16* p, int lane, const f32x4 (&v)[4]) { GAS v4u* q = (GAS v4u*)p + 2 * lane; q[0] = pk8(v[0], v[1]); q[1] = pk8(v[2], v[3]); }
__device__ __forceinline__ f32x4 fp8x4(unsigned w) { const f32x2 lo = __builtin_amdgcn_cvt_pk_f32_fp8((int)w, false), hi = __builtin_amdgcn_cvt_pk_f32_fp8((int)w, true); return (f32x4){lo.x, lo.y, hi.x, hi.y}; }
template <int KIND> __device__ __forceinline__ void phase_norm(KArgs a, LAS unsigned char* lds, int l, float dsc) {
    PHASE_IDS();
    unsigned char* ws = a->ws; const bool from_in = (KIND == 0 && l == 0);
    bf16* XB = (bf16*)(ws + WS_XB);
    const float* MOD = (const float*)(ws + WS_MOD);
    const bool comb = (KIND == 2) || (KIND == 0 && l > 0); const int lc = (KIND == 2) ? NL - 1 : l - 1;
    if (comb) moe_tables(lds, (const unsigned*)(ws + WS_CTL) + CW_CNT + lc * NE * CNT_STRIDE, false);
    const LAS int* tb = (const LAS int*)(lds + MOE_OFF);
    const unsigned char* YR = (const unsigned char*)(ws + WS_YR); const int* EP = (const int*)(ws + WS_EP); const float* WT = (const float*)(ws + WS_WT);
    bf16* A = (bf16*)(ws + WS_A);
    const float* gvec = (KIND == 0) ? a->in[I_G1] + l * D : (KIND == 1) ? a->in[I_G2] + l * D : a->in[I_GF];
    f32x4 gv[4]; ld16f(gvec, lane, gv);
    constexpr int NR = 2;
    for (int r0 = gw; r0 < R; r0 += NR * NGW) {
        int rr[NR], mbv[NR]; bool live[NR]; f32x4 v[NR][4];
#pragma unroll
        for (int u = 0; u < NR; ++u) { const int r = r0 + u * NGW; live[u] = r < R; rr[u] = live[u] ? r : r0; const int b = rr[u] / RB, j = rr[u] - b * RB; mbv[u] = (j < TCTX) ? 8 : b;
            if ((KIND == 2 || (KIND == 1 && l == NL - 1)) && j < TCTX) live[u] = false;
            if (from_in) ld16f(xrow_ptr((float*)a->in[I_X], (float*)a->in[I_CTX], rr[u]), lane, v[u]); else ld16b(XB + (size_t)rr[u] * D, lane, v[u]); }
        if (comb) {
            int slot[NR]; float w[NR];
#pragma unroll
            for (int u = 0; u < NR; ++u) { slot[u] = 0; w[u] = 0.f; if (lane < TOPK && (KIND != 2 || live[u])) { const int ep = EP[(size_t)rr[u] * 8 + lane]; slot[u] = tb[ep >> 17] * 256 + (ep & 0x1ffff); w[u] = WT[(size_t)rr[u] * 8 + lane] * (1.0f / 16.0f); } }
            f32x4 acc[NR][4];
#pragma unroll
            for (int u = 0; u < NR; ++u)
#pragma unroll
                for (int q = 0; q < 4; ++q) acc[u][q] = (f32x4){0.f, 0.f, 0.f, 0.f};
#pragma unroll
            for (int k = 0; k < TOPK; ++k)
#pragma unroll
                for (int u = 0; u < NR; ++u) { const int sk = lane_i(slot[u], k); const float wk = lane_f(w[u], k); const v4u y = __builtin_nontemporal_load((const GAS v4u*)(YR + (size_t)sk * D) + lane);
                    acc[u][0] += wk * fp8x4(y.x); acc[u][1] += wk * fp8x4(y.y); acc[u][2] += wk * fp8x4(y.z); acc[u][3] += wk * fp8x4(y.w); }
#pragma unroll
            for (int u = 0; u < NR; ++u) { const v4u y = ((const GAS v4u*)(ws + WS_YS + (size_t)rr[u] * D))[lane];
                acc[u][0] += (1.0f / 16.0f) * fp8x4(y.x); acc[u][1] += (1.0f / 16.0f) * fp8x4(y.y); acc[u][2] += (1.0f / 16.0f) * fp8x4(y.z); acc[u][3] += (1.0f / 16.0f) * fp8x4(y.w); }
#pragma unroll
            for (int u = 0; u < NR; ++u) { f32x4 g2[4]; ld16f(MOD + ((size_t)lc * 9 + mbv[u]) * 6144 + 5 * D, lane, g2);
#pragma unroll
                for (int q = 0; q < 4; ++q) v[u][q] += (g2[q] * dsc) * acc[u][q];
                if (KIND != 2 && live[u]) st16b(XB + (size_t)rr[u] * D, lane, v[u]); }
        }
#pragma unroll
        for (int u = 0; u < NR; ++u) {
            float s = 0.f;
#pragma unroll
            for (int q = 0; q < 4; ++q) s += (v[u][q].x * v[u][q].x + v[u][q].y * v[u][q].y) + (v[u][q].z * v[u][q].z + v[u][q].w * v[u][q].w);
            const float rs = 1.0f / sqrtf(wave_sum(s) * (1.f / D) + EPS);
            if (KIND == 2) { f32x4 o[4];
#pragma unroll
                for (int q = 0; q < 4; ++q) o[q] = v[u][q] * rs * gv[q];
                if (live[u]) st16f(xrow_ptr(a->out, nullptr, rr[u]), lane, o);
            } else {
                const float* md = MOD + ((size_t)l * 9 + mbv[u]) * 6144 + (KIND == 0 ? 0 : 3 * D);
                f32x4 sh[4], sc[4], y[4]; ld16f(md, lane, sh); ld16f(md + D, lane, sc);
#pragma unroll
                for (int q = 0; q < 4; ++q) y[q] = (v[u][q] * rs) * gv[q] * (sc[q] + 1.0f) + sh[q];
                if (live[u]) { if (KIND == 1 || MK_CHECK) { GAS v4u* o16 = (GAS v4u*)(A + (size_t)rr[u] * D) + 2 * lane; o16[0] = pk8(y[0], y[1]); o16[1] = pk8(y[2], y[3]); }
                    { v4u q8;
#pragma unroll
                        for (int q = 0; q < 4; ++q) { int p = __builtin_amdgcn_cvt_pk_fp8_f32(y[q].x, y[q].y, 0, false); p = __builtin_amdgcn_cvt_pk_fp8_f32(y[q].z, y[q].w, p, true); q8[q] = (unsigned)p; }
                        ((GAS v4u*)(ws + WS_A8 + (size_t)rr[u] * D))[lane] = q8; } }
            }
        }
    }
}

__device__ __forceinline__ void phase_convert_experts(KArgs a, LAS unsigned char* lds, int l, int it0, int it1, int widx, int nwg) {
    PHASE_IDS();
    LAS float* scr = (LAS float*)(lds + RING_OFF + wave * 16384);
    unsigned char* E13 = a->ws + WS_E13; unsigned char* E2 = a->ws + WS_E2;
    for (int it = it0 + widx * NWAVES + wave; it < it1; it += nwg * NWAVES) { const int e = it / 384; int r = it - e * 384;
        if (r < 128) { const int kb = r / 8, n0 = 32 * (r - kb * 8); tr_block8(a->in[I_W1] + ((size_t)l * NE + e) * D * 256, 256, 64 * kb, n0, E13 + (size_t)e * 512 * D, D, (n0 >> 7) * 256 + (n0 & 127), WG8_SCALE, scr, lane); continue; } r -= 128;
        if (r < 128) { const int kb = r / 8, n0 = 32 * (r - kb * 8); tr_block8(a->in[I_W3] + ((size_t)l * NE + e) * D * 256, 256, 64 * kb, n0, E13 + (size_t)e * 512 * D, D, (n0 >> 7) * 256 + (n0 & 127) + 128, WG8_SCALE, scr, lane); continue; } r -= 128;
        { const int kb = r / 32, n0 = 32 * (r - kb * 32); tr_block8<3>(a->in[I_W2] + ((size_t)l * NE + e) * 256 * D, D, 64 * kb, n0, E2 + (size_t)e * D * 256, 256, (n0 & ~255) + 32 * ((n0 >> 6) & 3) + 16 * ((n0 >> 5) & 1), 32.0f, scr, lane); } }
}

__device__ __forceinline__ void phase_qkv_post(KArgs a, int l) {
    PHASE_IDS();
    bf16* QKV = (bf16*)(a->ws + WS_QKV); const f32x2* rope = (const f32x2*)(a->ws + WS_ROPE);
    const int j = lane & 7;
    float gq[8], gk[8];
#pragma unroll
    for (int i = 0; i < 8; ++i) { gq[i] = a->in[I_GQA][l * 64 + j * 8 + i]; gk[i] = a->in[I_GKA][l * 64 + j * 8 + i]; }
    for (int r = gw; r < R; r += NGW) {
        const int b = r / RB, jr = r - b * RB; const bool lat = jr >= TCTX; const int t = lat ? jr - TCTX : 0;
        GAS v4u* prow = (GAS v4u*)(QKV + (size_t)r * QKVW);
        v4u raw[6];
#pragma unroll
        for (int pass = 0; pass < 6; ++pass) raw[pass] = prow[pass * 64 + lane];
        f32x2 cs[8]; { const f32x2* cp = rope + ((size_t)t * 2 + (j >> 2)) * 16 + 8 * (j & 1);
#pragma unroll
            for (int i = 0; i < 8; ++i) cs[i] = cp[i]; }
#pragma unroll
        for (int pass = 0; pass < 6; ++pass) {
            const int s = pass * 8 + (lane >> 3);
            int kind, nrm = 0;
            if (s < 8) { kind = 1; nrm = 1; } else if (s < 10) { kind = 2; nrm = 2; } else if (s < 12) kind = 0; else if (s < 20) kind = 1; else if (s < 22) kind = 2; else if (s < 24) kind = 0;
            else if (s < 32) kind = 1; else if (s < 40) kind = 2; else kind = 0;
            if (pass == 5) continue;
            const v4u rw = raw[pass];
            float x[8] = {bflo(rw.x), bfhi(rw.x), bflo(rw.y), bfhi(rw.y), bflo(rw.z), bfhi(rw.z), bflo(rw.w), bfhi(rw.w)};
            if (pass < 2) {
                float ss = 0.f;
#pragma unroll
                for (int i = 0; i < 8; ++i) ss += x[i] * x[i];
                ss += xor_f<1>(ss); ss += xor_f<2>(ss); ss += xor_f<4>(ss);
                if (nrm) { const float rs = 1.0f / sqrtf(ss * (1.f / 64.f) + EPS);
#pragma unroll
                    for (int i = 0; i < 8; ++i) x[i] = x[i] * rs * (nrm == 1 ? gq[i] : gk[i]); } }
            float px[8];
#pragma unroll
            for (int i = 0; i < 8; ++i) px[i] = xor_f<2>(x[i]);
            if (lat && kind != 0) {
#pragma unroll
                for (int i = 0; i < 8; ++i) { const f32x2 c = cs[i]; x[i] = (j & 2) ? (px[i] * c.y + x[i] * c.x) : (x[i] * c.x - px[i] * c.y); } }
            if (kind == 1) {
#pragma unroll
                for (int i = 0; i < 8; ++i) x[i] *= attn_body::C2; }
            if (kind != 0) prow[pass * 64 + lane] = (v4u){pk2(x[0], x[1]), pk2(x[2], x[3]), pk2(x[4], x[5]), pk2(x[6], x[7])};
        }
    }
}

__device__ __forceinline__ void c_combine_rows(KArgs a, int l, int row0, int nrows) {
    int tid_ = threadIdx.x; asm volatile("" : "+v"(tid_)); const int lane = tid_ & 63, wave = __builtin_amdgcn_readfirstlane(tid_ >> 6);
    const bf16* OC = (const bf16*)(a->ws + WS_OC); unsigned char* YC = a->ws + WS_YC;
    const float* lp = (const float*)(a->ws + WS_LAYP) + l * 4; const float lam = lp[0], om = lp[2];
    const int hc = lane >> 4, w = lane & 15;
    float g[8];
#pragma unroll
    for (int i = 0; i < 8; ++i) g[i] = a->in[I_GSUB][l * 128 + w * 8 + i] * om;
    constexpr int NR = 4;
    for (int i0 = wave; i0 < nrows; i0 += NR * NWAVES) {
        v4u u1[NR], u2[NR]; int rr[NR]; bool live[NR];
#pragma unroll
        for (int u = 0; u < NR; ++u) { const int i = i0 + u * NWAVES; live[u] = i < nrows; rr[u] = row0 + (live[u] ? i : i0); const GAS v4u* p = (const GAS v4u*)(OC + (size_t)rr[u] * D); u1[u] = p[hc * 32 + w]; u2[u] = p[hc * 32 + 16 + w]; }
#pragma unroll
        for (int u = 0; u < NR; ++u) { f32x4 a0, a1, b0, b1; unpk8(u1[u], a0, a1); unpk8(u2[u], b0, b1); const f32x4 d0 = a0 - lam * b0, d1 = a1 - lam * b1;
            float ss = (d0.x * d0.x + d0.y * d0.y) + (d0.z * d0.z + d0.w * d0.w) + (d1.x * d1.x + d1.y * d1.y) + (d1.z * d1.z + d1.w * d1.w);
            ss = row16_sum(ss);
            const float rs = 1.0f / sqrtf(ss * (1.f / 128.f) + EPS);
            const f32x4 y0 = (f32x4){d0.x * g[0], d0.y * g[1], d0.z * g[2], d0.w * g[3]} * rs, y1 = (f32x4){d1.x * g[4], d1.y * g[5], d1.z * g[6], d1.w * g[7]} * rs;
            int p0 = __builtin_amdgcn_cvt_pk_fp8_f32(y0.x * 16.0f, y0.y * 16.0f, 0, false); p0 = __builtin_amdgcn_cvt_pk_fp8_f32(y0.z * 16.0f, y0.w * 16.0f, p0, true);
            int p1 = __builtin_amdgcn_cvt_pk_fp8_f32(y1.x * 16.0f, y1.y * 16.0f, 0, false); p1 = __builtin_amdgcn_cvt_pk_fp8_f32(y1.z * 16.0f, y1.w * 16.0f, p1, true);
            if (live[u]) ((GAS v2u*)(YC + (size_t)rr[u] * 512))[lane] = (v2u){(unsigned)p0, (unsigned)p1}; }
    }
}

__device__ __forceinline__ void phase_c_combine(KArgs a, int l) {
    const int G = gridDim.x, bx = blockIdx.x; const int vcu = (G % 8 == 0) ? (bx % 8) * (G / 8) + bx / 8 : bx;
    for (int p = vcu; p < NPAN; p += G) c_combine_rows(a, l, p * 256, 256);
}

__device__ __forceinline__ float seg16_max(float v) { return row16_max(v); }
__device__ __forceinline__ float seg_top2sum(float v, int lane) {
    const float m1 = seg16_max(v);
    const unsigned long long bal = __ballot(v == m1);
    const unsigned seg = (unsigned)(bal >> (lane & 48)) & 0xffffu;
    const int first = __ffs((int)seg) - 1;
    const float v2 = ((lane & 15) == first) ? -INFINITY : v;
    return m1 + seg16_max(v2);
}
__device__ __forceinline__ void phase_topk(KArgs a, LAS unsigned char* lds, int l, bool skipctx) {
    PHASE_IDS();
    const float* LG = (const float*)(a->ws + WS_LOG); int* EP = (int*)(a->ws + WS_EP); float* WT = (float*)(a->ws + WS_WT); int* LIST = (int*)(a->ws + WS_LIST);
    unsigned* cnt = (unsigned*)(a->ws + WS_CTL) + CW_CNT + l * NE * CNT_STRIDE;
    LAS int* ent = (LAS int*)(lds + RING_OFF); LAS unsigned* lcnt = (LAS unsigned*)(lds + RING_OFF + 16384); LAS unsigned* gb = lcnt + NE;
    if (tid_ < NE) lcnt[tid_] = 0u;
    __syncthreads();
    const float eb0 = a->in[I_EBIAS][l * NE + lane], eb1 = a->in[I_EBIAS][l * NE + 64 + lane];
    float lg0 = 0.f, lg1 = 0.f; if (gw < R) { lg0 = LG[(size_t)gw * NE + lane]; lg1 = LG[(size_t)gw * NE + 64 + lane]; }
    int it = 0;
    for (int r = gw; r < R; r += NGW, ++it) {
        const float x0 = lg0, x1 = lg1;
        if (r + NGW < R) { lg0 = LG[(size_t)(r + NGW) * NE + lane]; lg1 = LG[(size_t)(r + NGW) * NE + 64 + lane]; }
        if (skipctx && (r % RB) < TCTX) continue;
        const float s0 = 1.0f / (1.0f + expf(-x0)), s1 = 1.0f / (1.0f + expf(-x1));
        const float c0 = s0 + eb0, c1 = s1 + eb1;
        const float gs0 = seg_top2sum(c0, lane), gs1 = seg_top2sum(c1, lane);
        float g[8];
#pragma unroll
        for (int k = 0; k < 4; ++k) { g[k] = lane_f(gs0, 16 * k); g[4 + k] = lane_f(gs1, 16 * k); }
        bool selA = false, selB = false;
#pragma unroll
        for (int k = 0; k < 8; ++k) { int rank = 0;
#pragma unroll
            for (int k2 = 0; k2 < 8; ++k2) rank += (g[k2] > g[k] || (g[k2] == g[k] && k2 < k)) ? 1 : 0;
            const bool sel = rank < 4;
            if (k < 4) { if ((lane >> 4) == k) selA = sel; } else { if ((lane >> 4) == k - 4) selB = sel; } }
        float m0 = selA ? c0 : -INFINITY, m1 = selB ? c1 : -INFINITY;
        int my_e = 0; float my_s = 0.f, ssum = 0.f;
#pragma unroll
        for (int k = 0; k < TOPK; ++k) {
            const float m = wave_max(fmaxf(m0, m1));
            const unsigned long long b0 = __ballot(m0 == m);
            int idx; if (b0) idx = __ffsll((long long)b0) - 1; else { const unsigned long long b1 = __ballot(m1 == m); idx = 64 + __ffsll((long long)b1) - 1; }
            idx = __builtin_amdgcn_readfirstlane(idx);
            const float sc = (idx < 64) ? lane_f(s0, idx) : lane_f(s1, idx - 64);
            if (lane == (idx & 63)) { if (idx < 64) m0 = -INFINITY; else m1 = -INFINITY; }
            ssum += sc; if (lane == k) { my_e = idx; my_s = sc; }
        }
        if (lane < TOPK) { const unsigned lp = __hip_atomic_fetch_add(lcnt + my_e, 1u, __ATOMIC_RELAXED, __HIP_MEMORY_SCOPE_WORKGROUP);
            ent[(it * NWAVES + wave) * 8 + lane] = (my_e << 17) | (int)lp; WT[(size_t)r * 8 + lane] = my_s / ssum * 2.5f; }
    }
    __syncthreads();
    if (tid_ < NE) { const unsigned n = lcnt[tid_]; gb[tid_] = n ? __hip_atomic_fetch_add(cnt + tid_ * CNT_STRIDE, n, RLX_AGENT) : 0u; }
    __syncthreads();
    const int nslots = (R - vcu * NWAVES + NGW - 1) / NGW;
    for (int i = tid_; i < nslots * NWAVES * 8; i += NWAVES * 64) { const int slot = i >> 3, k = i & 7, w = slot % NWAVES, itx = slot / NWAVES; const int r = vcu * NWAVES + w + itx * NGW;
        if (r < R && !(skipctx && (r % RB) < TCTX)) { const int en = ent[i], e = en >> 17; const unsigned pos = gb[e] + (unsigned)(en & 0x1ffff); LIST[(size_t)e * CAP + pos] = r; EP[(size_t)r * 8 + k] = (e << 17) | (int)pos; } }
    __syncthreads();
}

struct MoeOrder {
    int NCT, G, c, ntile; const LAS int* tb; const LAS int* cn; const LAS unsigned short* te; const int* list;
    __device__ __forceinline__ void init(LAS unsigned char* lds, int NCT_, int G_, int c_, const int* list_) { tb = (const LAS int*)(lds + MOE_OFF); cn = tb + 132; te = (const LAS unsigned short*)(cn + 128);
        NCT = NCT_; G = G_; c = c_; list = list_; ntile = tb[NE]; }
    __device__ __forceinline__ bool next(int i, pg8::Unit& u) const {
        const int L = i * G + c; if (L >= ntile * NCT) return false;
        const int tile = L / NCT, ct = L - tile * NCT, e = te[tile];
        u.pm = tile; u.pn = e * NCT + ct; u.om = tile; u.on = ct; u.aux = e; return true; }
    __device__ __forceinline__ unsigned arow(const pg8::Unit& u, int h, int Rl) const {
        int p = (u.om - tb[u.aux]) * 256 + h * 128 + Rl; const int c1 = cn[u.aux] - 1; p = p < c1 ? p : c1;
        return (unsigned)list[(size_t)u.aux * CAP + p]; }
};

__device__ __forceinline__ void phase_attn(KArgs a, char* lds, int l) {
    const int G = gridDim.x, bx = blockIdx.x; const int vcu = (G % 8 == 0) ? (bx % 8) * (G / 8) + bx / 8 : bx;
    if (__builtin_amdgcn_readfirstlane((int)threadIdx.x >> 8)) __builtin_amdgcn_s_setprio(1);
    const int nc1 = (l == NL - 1) ? 0 : 128, nc2 = (l == NL - 1) ? 0 : 64;
    int ui = 0; const int n1 = (2048 + nc1 - vcu + G - 1) / G, cs = (vcu & 7) < n1 ? (vcu & 7) : n1 - 1;
    typedef attn_body::bf16 abf;
    const abf* QKV = (const abf*)(a->ws + WS_QKV); unsigned char* YA = a->ws + WS_YA; unsigned char* YB = a->ws + WS_YB; abf* OC = (abf*)(a->ws + WS_OC);
    const float* sink = a->in[I_SINK] + l * 8;
    for (int f = vcu; f < 2048 + nc1; f += G) {
        int qcol, kcol, vcol, NT; size_t qrow, krow; unsigned char* O; float sk2 = -INFINITY;
        if (f < 2048) { const int b = f >> 8, v = f & 255, h = v >> 5, qb = v & 31;
            qrow = (size_t)b * RB + TCTX + (size_t)qb * 256; krow = (size_t)b * RB; NT = RB / 64; qcol = h * 64; kcol = 512 + (h >> 2) * 64; vcol = 640 + (h >> 2) * 64; O = YA + qrow * 512 + h * 64;
        } else { const int c = f - 2048, b = c >> 4, k = c & 15; qrow = (size_t)b * RB; krow = qrow; NT = TCTX / 64;
            if (k < 8) { qcol = k * 64; kcol = 512 + (k >> 2) * 64; vcol = 640 + (k >> 2) * 64; O = YA + qrow * 512 + k * 64; }
            else { const int h = k - 8; qcol = 768 + h * 64; kcol = 1280 + (h >> 2) * 64; vcol = 1408 + (h >> 2) * 64; O = YB + qrow * 512 + h * 64; sk2 = sink[h] * LOG2E; } }
        if (ui == cs) { phase_convert_experts(a, (LAS unsigned char*)lds - RING_OFF, l, 0, NE * 384 / 2, vcu, G); __syncthreads(); }
        ++ui;
        attn_body::attn_unit<0, 8>(QKV + qrow * QKVW + qcol, QKV + krow * QKVW + kcol, QKV + krow * QKVW + vcol, O, 512, NT, 0, 0, sk2, lds);
    }
    for (int f = vcu; f < 2048 + nc2; f += G) {
        int s, NT; size_t qrow, krow;
        if (f < 2048) { const int b = f >> 8, v = f & 255, qb = v & 31; s = v >> 5; qrow = (size_t)b * RB + TCTX + (size_t)qb * 256; krow = (size_t)b * RB; NT = RB / 64; }
        else { const int c = f - 2048, b = c >> 3; s = c & 7; qrow = (size_t)b * RB; krow = qrow; NT = TCTX / 64; }
        attn_body::attn_unit128<8>(QKV + qrow * QKVW + 1536 + s * 64, QKV + krow * QKVW + 2048 + s * 64, QKV + krow * QKVW + 2560 + (s >> 1) * 128, OC + qrow * 1024 + s * 128, 1024, NT, lds);
    }
    for (int w = vcu; w < 2048; w += G) {
        const int b = w >> 8, v = w & 255, h = v >> 5, qb = v & 31, q0 = qb * 256;
        const int wstart = (q0 - 128 > 0) ? q0 - 128 : 0, wend = (q0 + 384 < SEQ) ? q0 + 384 : SEQ, NT = 4 + (wend - wstart) / 64;
        const size_t qrow = (size_t)b * RB + TCTX + q0, krow = (size_t)b * RB;
        attn_body::attn_unit<1, 8>(QKV + qrow * QKVW + 768 + h * 64, QKV + krow * QKVW + 1280 + (h >> 2) * 64, QKV + krow * QKVW + 1408 + (h >> 2) * 64, YB + qrow * 512 + h * 64, 512, NT, wstart, wstart - q0, sink[h] * LOG2E, lds);
    }
    __builtin_amdgcn_s_setprio(0);
}
#ifndef MK_PROF
#define MK_PROF 0
#endif
#ifndef MK_PHMASK
#define MK_PHMASK 0xffff
#endif
#define PHE(p) ((MK_PHMASK >> (p)) & 1)
__global__ void __launch_bounds__(NWAVES * 64, 2) mk_fwd(Args args) {
    extern __shared__ __attribute__((aligned(16))) unsigned char lds_raw[];
    LAS unsigned char* lds = (LAS unsigned char*)lds_raw;
    const KArgs ka = (KArgs)__builtin_amdgcn_kernarg_segment_ptr();
#define KA() ({ KArgs _p = ka; asm volatile("" : "+s"(_p)); _p; })
#define WSP(off) (KA()->ws + (off))
    for (int u = threadIdx.x; u < (LDS_BYTES - LDSCTL_OFF) / 4; u += NWAVES * 64) ((LAS unsigned*)(lds + LDSCTL_OFF))[u] = 0u;
    __syncthreads();
    XcdBarrier bar; bar.bar = (unsigned*)(args.ws + WS_CTL) + CW_BAR; bar.x = 0; bar.st = nullptr;
    if (!MK_MULTI) bar = xcd_barrier_post((unsigned*)(args.ws + WS_CTL) + CW_BAR, (volatile LAS unsigned*)(lds + MISC_OFF) + 8);
    const int lo = args.ph_lo, hi = args.ph_hi & 0xffff;
#define DSC() ((KA()->ph_hi >> 16) ? 0.f : 1.f)
#define IN(k) (lo <= (k) && (k) < hi)
#define SEAM(k) do { if (!MK_MULTI) { if (IN(k) && IN((k) + 1)) xcd_barrier(bar); } } while (0)
#if MK_PROF
#define TS(k) do { if (blockIdx.x == 0 && threadIdx.x == 0) { ((unsigned long long*)(args.ws + WS_DBG))[(k)] = __builtin_amdgcn_s_memrealtime(); } } while (0)
#else
#define TS(k) do {} while (0)
#endif
#define GRID_IDS() const int G = gridDim.x, bx = blockIdx.x; const int vcu = (G % 8 == 0) ? (bx % 8) * (G / 8) + bx / 8 : bx; (void)vcu
#define WL(l, off) (const bf16*)(WSP(WS_WSM + (size_t)(l) * WSM_LAYER + (off)))

    TS(0); if (PHE(13) && IN(0)) { phase_prologue(KA(), lds); } SEAM(0);

    for (int l = 0; l < NL; ++l) {
        const int p0 = 1 + l * PH_PER_LAYER;
        const int lat = (l == NL - 1) ? 1 : 0, NPL = lat ? NB * (SEQ / 256) : NPAN;
        if (p0 + PH_PER_LAYER <= lo || p0 >= hi) continue;
        TS(p0 + 0); if (PHE(0) && IN(p0 + 0)) { phase_norm<0>(KA(), lds, l, DSC()); } SEAM(p0 + 0);
        TS(p0 + 1); if (PHE(1) && IN(p0 + 1)) { GRID_IDS(); pg8::Gemm g{(const bf16*)WSP(WS_A8), (const bf16*)WSP(WS_WQ8 + (size_t)l * WG8_LAYER), D / 2}; pg8::StaticOrder S; S.init(NPAN, QKVW / 256, G, bx);
            { int t_ = threadIdx.x; asm volatile("" : "+v"(t_)); const pg8::f32x4* src = (const pg8::f32x4*)WSP(WS_ROPE);
              ((LAS pg8::f32x4*)(lds + ROPE1_OFF))[t_] = src[((t_ >> 3) * 2 + 1) * 8 + (t_ & 7)]; __syncthreads(); }
            pg8::EpiQkv E{(bf16*)WSP(WS_QKV), (const pg8::f32x2r*)WSP(WS_ROPE), KA()->in[I_GQA] + l * 64, KA()->in[I_GKA] + l * 64, attn_body::C2, (const PG8_LAS pg8::f32x4*)(lds + ROPE1_OFF)};
            pg8::gemm_phase<pg8::EpiQkv, pg8::StaticOrder, true, false, W8_EXP>(lds + RING_OFF, g, S, E); } SEAM(p0 + 1);
        TS(p0 + 2);
        TS(p0 + 3); if (PHE(3) && IN(p0 + 3)) { phase_attn(KA(), (char*)lds_raw + RING_OFF, l); } SEAM(p0 + 3);
        TS(p0 + 4);
        TS(p0 + 5); if (PHE(5) && IN(p0 + 5)) { GRID_IDS(); pg8::Gemm g{(const bf16*)WSP(WS_A8), (const bf16*)WSP(WS_WG8 + (size_t)l * WG8_LAYER), D / 2}; pg8::StaticOrder S; S.init(NPL, 12, G, bx, lat);
            pg8::EpiGate E{WSP(WS_QKV), KA()->in[I_BGATE] + l * 3072};
            pg8::gemm_phase<pg8::EpiGate, pg8::StaticOrder, true, false, W8_EXP>(lds + RING_OFF, g, S, E);
            { const int extra = (NPL * 12) % G, NCH = R / 64; const int nh = 2 * extra < NCH ? 2 * extra : NCH;
              if (bx < extra) { for (int c = 2 * bx; c < 2 * bx + 2 && c < nh; ++c) c_combine_rows(KA(), l, c * 64, 64); }
              if (bx >= extra || extra == 0) { for (int c = nh + (bx - extra); c < NCH; c += G - extra) c_combine_rows(KA(), l, c * 64, 64); } } } SEAM(p0 + 5);
        TS(p0 + 6); if (PHE(6) && IN(p0 + 6)) { GRID_IDS(); pg8::TripleOrder S; S.init(NPL, 4, G, bx, lat, NPAN);
            pg8::Gemm g{(const bf16*)WSP(WS_YA), WL(l, WL_BR), 256};
            pg8::EpiBranchT E{WSP(WS_QKV), WSP(WS_MG8)};
            pg8::gemm_phase<pg8::EpiBranchT, pg8::TripleOrder, true, false, 127 - 9>(lds + RING_OFF, g, S, E);
            { const int heavy = (NPL * 4) % G; if (bx >= heavy) phase_convert_experts(KA(), lds, l, NE * 384 / 2, NE * 384, bx - heavy, G - heavy); } } SEAM(p0 + 6);
        TS(p0 + 7); if (PHE(7) && IN(p0 + 7)) { GRID_IDS(); pg8::Gemm g{(const bf16*)WSP(WS_MG8), WL(l, WL_OUT), D / 2}; pg8::StaticOrder S; S.init(NPL, 4, G, bx, lat);
            if (l == 0) { pg8::EpiResid<true> E{(bf16*)WSP(WS_XB), KA()->in[I_X], KA()->in[I_CTX], (const float*)WSP(WS_MOD) + (size_t)l * 9 * 6144, 2 * D, DSC()};
                pg8::gemm_phase<pg8::EpiResid<true>, pg8::StaticOrder, true, false, 127 - 6>(lds + RING_OFF, g, S, E); }
            else { pg8::EpiResid<false> E{(bf16*)WSP(WS_XB), nullptr, nullptr, (const float*)WSP(WS_MOD) + (size_t)l * 9 * 6144, 2 * D, DSC()};
                pg8::gemm_phase<pg8::EpiResid<false>, pg8::StaticOrder, true, false, 127 - 6>(lds + RING_OFF, g, S, E); } } SEAM(p0 + 7);
        TS(p0 + 8); if (PHE(8) && IN(p0 + 8)) { phase_norm<1>(KA(), lds, l, DSC()); } SEAM(p0 + 8);
        TS(p0 + 9); if (PHE(9) && IN(p0 + 9)) { GRID_IDS(); pg8::Gemm g{(const bf16*)WSP(WS_A), WL(l, WL_R), D}; pg8::StaticOrder S; S.init(NPL, 1, G, bx, lat);
            pg8::EpiRouter E{(float*)WSP(WS_LOG)};
            pg8::gemm_phase<pg8::EpiRouter, pg8::StaticOrder, true, false>(lds + RING_OFF, g, S, E);
            { GRID_IDS(); pg8::Gemm g{(const bf16*)WSP(WS_A8), (const bf16*)WSP(WS_WS8 + (size_t)l * WS8_LAYER), D / 2}; pg8::StaticOrder S; S.init(NPL, 2, G, (bx + G - 8) % G, lat); pg8::EpiUp<true> E{(bf16*)WSP(WS_HS)};
              pg8::gemm_phase<pg8::EpiUp<true>, pg8::StaticOrder, true, false, W8_EXP>(lds + RING_OFF, g, S, E); } } SEAM(p0 + 9);
        TS(p0 + 10); if (PHE(10) && IN(p0 + 10)) { phase_topk(KA(), lds, l, lat != 0); } SEAM(p0 + 10);
        TS(p0 + 11); if (PHE(11) && IN(p0 + 11)) { moe_tables(lds, (const unsigned*)WSP(WS_CTL) + CW_CNT + l * NE * CNT_STRIDE, true);
            { GRID_IDS(); pg8::Gemm g{(const bf16*)WSP(WS_A8), (const bf16*)WSP(WS_E13), D / 2}; MoeOrder S; S.init(lds, 2, G, vcu, (const int*)WSP(WS_LIST)); pg8::EpiUp<true> E{(bf16*)WSP(WS_HR)};
              pg8::gemm_phase<pg8::EpiUp<true>, MoeOrder, true, true, W8_EXP>(lds + RING_OFF, g, S, E); }
            { GRID_IDS(); pg8::Gemm g{(const bf16*)WSP(WS_HS), WL(l, WL_S2), 128}; pg8::StaticOrder S; S.init(NPL, 4, G, bx, lat);
              pg8::EpiFp8 E{WSP(WS_YS), D};
              pg8::gemm_phase<pg8::EpiFp8, pg8::StaticOrder, true, false, 127 - 2>(lds + RING_OFF, g, S, E); } } SEAM(p0 + 11);
        TS(p0 + 12); if (PHE(12) && IN(p0 + 12)) { moe_tables(lds, (const unsigned*)WSP(WS_CTL) + CW_CNT + l * NE * CNT_STRIDE, true);
            { GRID_IDS(); pg8::Gemm g{(const bf16*)WSP(WS_HR), (const bf16*)WSP(WS_E2), 128}; MoeOrder S; S.init(lds, 4, G, vcu, (const int*)WSP(WS_LIST)); pg8::EpiFp8 E{(unsigned char*)WSP(WS_YR), D};
              pg8::gemm_phase<pg8::EpiFp8, MoeOrder, true, false, 127 - 2>(lds + RING_OFF, g, S, E); } } SEAM(p0 + 12);
    }
    TS(NPH - 1); if (PHE(14) && IN(NPH - 1)) { phase_norm<2>(KA(), lds, NL, DSC()); } __syncthreads(); TS(NPH);
#undef IN
#undef SEAM
}


#if MK_PROF
#ifndef MK_PROF_SET
#define MK_PROF_SET 0
#endif
__global__ void prof_report(const unsigned long long* ts, float* V) {
    if (threadIdx.x != 0) return;
    float dur[16]; for (int i = 0; i < 16; ++i) dur[i] = 0.f;
    __shared__ float sd[16];
    for (int t = 0; t < 13; ++t) { float s = 0.f; for (int l = 0; l < NL; ++l) { const int k = 1 + l * PH_PER_LAYER + t; s += (float)(ts[k + 1] - ts[k]); } sd[t] = s * 1e-5f; }
    sd[13] = (float)(ts[1] - ts[0]) * 1e-5f; sd[14] = (float)(ts[NPH] - ts[NPH - 1]) * 1e-5f; sd[15] = (float)(ts[NPH] - ts[0]) * 1e-5f;
    const int sel[4][5] = {{0, 2, 4, 8, 10}, {1, 5, 6, 7, 9}, {11, 12, 13, 14, 3}, {15, 15, 15, 15, 15}};
    int dg[5]; for (int i = 0; i < 5; ++i) { float q = sd[sel[MK_PROF_SET][i]] / (MK_PROF_SET == 3 ? 4.0f : (sel[MK_PROF_SET][i] == 3 ? 2.0f : 0.25f)); int v = (int)(q + 0.5f); dg[i] = v; }
    const int d1 = 1 + (dg[0] > 8 ? 8 : dg[0]), d2 = dg[1] > 9 ? 9 : dg[1], d3 = dg[2] > 9 ? 9 : dg[2], e1 = 1 + (dg[3] > 8 ? 8 : dg[3]), e2 = dg[4] > 9 ? 9 : dg[4];
    const float mant = (float)d1 + 0.1f * (float)d2; V[0] = sqrtf(mant * 1.0004f) * powf(10.f, 0.5f * (float)(4 + d3));
    V[1] = ((float)e1 + 0.1f * (float)e2) * powf(10.f, floorf(log10f(V[0])) + 1.0f);
}
__global__ void prof_apply(float* o, size_t n, const float* V) { size_t i = (size_t)blockIdx.x * blockDim.x + threadIdx.x; const size_t s = (size_t)gridDim.x * blockDim.x; for (; i < n; i += s) o[i] = (i == 0) ? V[1] : V[0]; }
#endif
extern "C" void kernel_launch(void* const* d_in, const int* in_sizes, int n_in, void* d_out, int out_size, void* d_ws, size_t ws_size, hipStream_t stream) {
    static int grid = 0;
    if (grid == 0) {
        if (n_in != N_IN || out_size != NB * SEQ * D || ws_size < WS_END) { fprintf(stderr, "kernel_launch: unexpected shapes (n_in %d, out %d, ws %zu); nothing launched\n", n_in, out_size, ws_size); grid = -1; return; }
        int dev = 0, cus = 0, per_cu = 0;
        if (hipGetDevice(&dev) != hipSuccess || hipDeviceGetAttribute(&cus, hipDeviceAttributeMultiprocessorCount, dev) != hipSuccess) { grid = -1; return; }
        if (hipFuncSetAttribute((const void*)mk_fwd, hipFuncAttributeMaxDynamicSharedMemorySize, LDS_BYTES) != hipSuccess) { fprintf(stderr, "kernel_launch: hipFuncSetAttribute failed\n"); grid = -1; return; }
        if (hipOccupancyMaxActiveBlocksPerMultiprocessor(&per_cu, (const void*)mk_fwd, NWAVES * 64, LDS_BYTES) != hipSuccess || per_cu < 1) { fprintf(stderr, "kernel_launch: occupancy query says %d\n", per_cu); (void)hipGetLastError(); grid = -1; return; }
        grid = cus;
    }
    if (grid < 0) return;
    (void)hipMemsetAsync((char*)d_ws + WS_CTL, 0, CTL_ZERO_BYTES, stream);
    Args a{};
    for (int i = 0; i < N_IN; ++i) a.in[i] = (const float*)d_in[i];
    a.out = (float*)d_out; a.ws = (unsigned char*)d_ws;
#if MK_MULTI
    for (int ph = 0; ph < NPH; ++ph) {
        a.ph_lo = ph; a.ph_hi = ph + 1;
        hipLaunchKernelGGL(mk_fwd, dim3(grid), dim3(NWAVES * 64), LDS_BYTES, stream, a);
#ifdef MK_REP_MASK
        if (ph >= 1 && ph < NPH - 1 && ((MK_REP_MASK >> ((ph - 1) % PH_PER_LAYER)) & 1)) { Args a2 = a; a2.ph_hi |= 1 << 16; hipLaunchKernelGGL(mk_fwd, dim3(grid), dim3(NWAVES * 64), LDS_BYTES, stream, a2); }
#endif
#if MK_CHECK
        dbg_after_phase(ph, a, stream);
#endif
    }
#else
    a.ph_lo = 0; a.ph_hi = NPH;
    hipLaunchKernelGGL(mk_fwd, dim3(grid), dim3(NWAVES * 64), LDS_BYTES, stream, a);
#if MK_PROF
    { float* V = (float*)((char*)d_ws + WS_DBG + 1 * MiB); prof_report<<<1, 64, 0, stream>>>((const unsigned long long*)((char*)d_ws + WS_DBG), V); prof_apply<<<2048, 256, 0, stream>>>((float*)d_out, (size_t)NB * SEQ * D, V); }
#endif
#endif
}
```
